# Optimizing an MI355X kernel written in HIP

```python
import jax, jax.numpy as jnp
from jax import lax
import numpy as np

D_MODEL = 2048
BATCH = 2
SEQ = 16384
DEPTH = 2

HEAD_DIM = 128
ROPE_THETA = 10000.0
EPS = 1e-6
Q_BLOCK = 128
D_FF = 4 * D_MODEL
NEG_INF = -1e30
POS_INF = 1e30

NSA_HEADS = 8
NSA_KV_GROUPS = 2
NSA_CMP_LEN = 32
NSA_CMP_STRIDE = 16
NSA_SEL_LEN = 64
NSA_SEL_TOPK = 16
NSA_WINDOW = 512
NSA_CMP_HIDDEN = HEAD_DIM

MLA_HEADS = 8
MLA_Q_RANK = 512
MLA_KV_RANK = 256
MLA_NOPE = 128
MLA_ROPE = 64
MLA_V = 128

DIL_PATTERNS = ((128, 1), (512, 4), (2048, 16))
DIL_HEADS = 8

A_Q_COLS = NSA_HEADS * HEAD_DIM
A_KV_COLS = 3 * 2 * NSA_KV_GROUPS * HEAD_DIM
A_GATE_COLS = 3 * NSA_HEADS
B_COLS = MLA_Q_RANK + MLA_KV_RANK + MLA_ROPE
EVEN_IN = A_Q_COLS + A_KV_COLS + A_GATE_COLS + B_COLS
EVEN_OUT = NSA_HEADS * HEAD_DIM + MLA_HEADS * MLA_V
ODD_IN = len(DIL_PATTERNS) * 3 * DIL_HEADS * HEAD_DIM
ODD_OUT = DIL_HEADS * HEAD_DIM

kernel_name = "hybrid_nsa_mla_dilated_trunk"


def rms_norm(x, g):
    xf = x.astype(jnp.float32)
    y = xf * lax.rsqrt(jnp.mean(xf * xf, axis=-1, keepdims=True) + EPS)
    return (y * g.astype(jnp.float32)).astype(x.dtype)


def rope_tables(seq, dim):
    inv = 1.0 / (ROPE_THETA ** (jnp.arange(0, dim, 2, dtype=jnp.float32) / dim))
    ang = jnp.arange(seq, dtype=jnp.float32)[:, None] * inv[None, :]
    return jnp.cos(ang), jnp.sin(ang)


def apply_rope(x, cos, sin):
    half = x.shape[-1] // 2
    c = cos[None, :, None, :].astype(x.dtype)
    s = sin[None, :, None, :].astype(x.dtype)
    x1, x2 = x[..., :half], x[..., half:]
    return jnp.concatenate([x1 * c - x2 * s, x1 * s + x2 * c], axis=-1)


def masked_softmax(s, mask):
    return jax.nn.softmax(jnp.where(mask, s, NEG_INF), axis=-1) * mask


def nsa_compress(k, pe, w1, w2):
    B, S, G, d = k.shape
    n_cmp = (S - NSA_CMP_LEN) // NSA_CMP_STRIDE + 1
    idx = jnp.arange(n_cmp)[:, None] * NSA_CMP_STRIDE + jnp.arange(NSA_CMP_LEN)[None, :]
    blocks = k[:, idx] + pe[None, None, :, None, :].astype(k.dtype)
    flat = blocks.transpose(0, 1, 3, 2, 4).reshape(B, n_cmp, G, NSA_CMP_LEN * d)
    return jax.nn.gelu(flat @ w1) @ w2


def nsa_attention(q, k_cmp, v_cmp, k_slc, v_slc, k_win, v_win, gate):
    B, S, H, d = q.shape
    G = k_slc.shape[2]
    Hg = H // G
    n_cmp = k_cmp.shape[1]
    n_slc = S // NSA_SEL_LEN
    top_k = min(NSA_SEL_TOPK, n_slc)
    scale = d ** -0.5
    cmp_last = jnp.arange(n_cmp) * NSA_CMP_STRIDE + (NSA_CMP_LEN - 1)
    ratio = NSA_SEL_LEN // NSA_CMP_STRIDE
    offs = np.arange(1 - NSA_CMP_LEN // NSA_CMP_STRIDE, ratio)
    ov = np.arange(n_slc)[:, None] * ratio + offs[None, :]
    ov_ok = jnp.asarray((ov >= 0) & (ov < n_cmp))
    ov = jnp.asarray(np.clip(ov, 0, n_cmp - 1))
    ks_b = k_slc.reshape(B, n_slc, NSA_SEL_LEN, G, d).transpose(0, 3, 1, 2, 4)
    vs_b = v_slc.reshape(B, n_slc, NSA_SEL_LEN, G, d).transpose(0, 3, 1, 2, 4)
    kw_p = jnp.pad(k_win, ((0, 0), (NSA_WINDOW, 0), (0, 0), (0, 0)))
    vw_p = jnp.pad(v_win, ((0, 0), (NSA_WINDOW, 0), (0, 0), (0, 0)))
    b_ix = jnp.arange(B)[:, None, None, None]
    g_ix = jnp.arange(G)[None, :, None, None]
    blk = jnp.arange(n_slc)
    sel_tok = jnp.arange(NSA_SEL_LEN)
    win_off = jnp.arange(Q_BLOCK + NSA_WINDOW) - NSA_WINDOW

    def one_block(s0):
        t = s0 + jnp.arange(Q_BLOCK)
        qb = lax.dynamic_slice_in_dim(q, s0, Q_BLOCK, 1).reshape(B, Q_BLOCK, G, Hg, d)
        gb = lax.dynamic_slice_in_dim(gate, s0, Q_BLOCK, 1).reshape(B, Q_BLOCK, G, Hg, 3)
        s_c = jnp.einsum('bqghd,bngd->bghqn', qb, k_cmp).astype(jnp.float32) * scale
        p_c = masked_softmax(s_c, cmp_last[None, :] <= t[:, None])
        o_c = jnp.einsum('bghqn,bngd->bqghd', p_c.astype(v_cmp.dtype), v_cmp)
        imp = jnp.sum(jnp.where(ov_ok, p_c[..., ov], 0.0), axis=(2, 5))
        cur = (t // NSA_SEL_LEN)[:, None]
        forced = (blk[None, :] == 0) | (blk[None, :] == cur) | (blk[None, :] == cur - 1)
        causal = blk[None, :] * NSA_SEL_LEN <= t[:, None]
        score = jnp.where(forced, POS_INF, jnp.where(causal, imp, NEG_INF))
        top_val, top_idx = lax.top_k(score, top_k)
        sel_ok = top_val > 0.5 * NEG_INF
        kg = ks_b[b_ix, g_ix, top_idx]
        vg = vs_b[b_ix, g_ix, top_idx]
        s_s = jnp.einsum('bqghd,bgqkld->bghqkl', qb, kg).astype(jnp.float32) * scale
        tok = top_idx[..., None] * NSA_SEL_LEN + sel_tok
        m_s = (tok <= t[None, None, :, None, None]) & sel_ok[..., None]
        p_s = masked_softmax(s_s.reshape(B, G, Hg, Q_BLOCK, -1), m_s.reshape(B, G, 1, Q_BLOCK, -1))
        o_s = jnp.einsum('bghqm,bgqmd->bqghd', p_s.astype(vg.dtype), vg.reshape(B, G, Q_BLOCK, -1, d))
        kw = lax.dynamic_slice_in_dim(kw_p, s0, Q_BLOCK + NSA_WINDOW, 1)
        vw = lax.dynamic_slice_in_dim(vw_p, s0, Q_BLOCK + NSA_WINDOW, 1)
        pos = s0 + win_off
        rel = t[:, None] - pos[None, :]
        m_w = (rel >= 0) & (rel < NSA_WINDOW) & (pos[None, :] >= 0)
        s_w = jnp.einsum('bqghd,bkgd->bghqk', qb, kw).astype(jnp.float32) * scale
        p_w = masked_softmax(s_w, m_w)
        o_w = jnp.einsum('bghqk,bkgd->bqghd', p_w.astype(vw.dtype), vw)
        o = gb[..., 0:1] * o_c + gb[..., 1:2] * o_s + gb[..., 2:3] * o_w
        return o.reshape(B, Q_BLOCK, H, d)

    out = lax.map(one_block, jnp.arange(S // Q_BLOCK) * Q_BLOCK)
    return out.transpose(1, 0, 2, 3, 4).reshape(B, S, H, d)


def mla_attention(c_q, c_kv, k_rope, q_norm, w_uq, kv_norm, w_ukv):
    B, S, _ = c_q.shape
    cos_r, sin_r = rope_tables(S, MLA_ROPE)
    q = (rms_norm(c_q, q_norm) @ w_uq).reshape(B, S, MLA_HEADS, MLA_NOPE + MLA_ROPE)
    q_nope = q[..., :MLA_NOPE]
    q_pe = apply_rope(q[..., MLA_NOPE:], cos_r, sin_r)
    kv = (rms_norm(c_kv, kv_norm) @ w_ukv).reshape(B, S, MLA_HEADS, MLA_NOPE + MLA_V)
    k_nope, v = kv[..., :MLA_NOPE], kv[..., MLA_NOPE:]
    k_pe = apply_rope(k_rope[:, :, None, :], cos_r, sin_r)[:, :, 0]
    scale = (MLA_NOPE + MLA_ROPE) ** -0.5
    key_pos = jnp.arange(S)

    def one_block(s0):
        t = s0 + jnp.arange(Q_BLOCK)
        qn = lax.dynamic_slice_in_dim(q_nope, s0, Q_BLOCK, 1)
        qp = lax.dynamic_slice_in_dim(q_pe, s0, Q_BLOCK, 1)
        s = (jnp.einsum('bqhd,bkhd->bhqk', qn, k_nope)
             + jnp.einsum('bqhd,bkd->bhqk', qp, k_pe)).astype(jnp.float32) * scale
        p = masked_softmax(s, key_pos[None, :] <= t[:, None])
        return jnp.einsum('bhqk,bkhd->bqhd', p.astype(v.dtype), v)

    out = lax.map(one_block, jnp.arange(S // Q_BLOCK) * Q_BLOCK)
    return out.transpose(1, 0, 2, 3, 4).reshape(B, S, MLA_HEADS, MLA_V)


def dilated_attention(qs, ks, vs):
    B, S, H, d = qs[0].shape
    scale = d ** -0.5
    kps = [jnp.pad(k, ((0, 0), (w, 0), (0, 0), (0, 0))) for k, (w, r) in zip(ks, DIL_PATTERNS)]
    vps = [jnp.pad(v, ((0, 0), (w, 0), (0, 0), (0, 0))) for v, (w, r) in zip(vs, DIL_PATTERNS)]

    def one_block(s0):
        t = s0 + jnp.arange(Q_BLOCK)
        outs, lses = [], []
        for (w, r), q, kp, vp in zip(DIL_PATTERNS, qs, kps, vps):
            dist = jnp.arange(w // r + 1) * r
            idx = t[:, None] + w - dist[None, :]
            kg = kp[:, idx]
            vg = vp[:, idx]
            qb = lax.dynamic_slice_in_dim(q, s0, Q_BLOCK, 1)
            s = jnp.einsum('bqhd,bqnhd->bhqn', qb, kg).astype(jnp.float32) * scale
            s = jnp.where((t[:, None] - dist[None, :]) >= 0, s, NEG_INF)
            m = jnp.max(s, axis=-1, keepdims=True)
            e = jnp.exp(s - m)
            den = jnp.sum(e, axis=-1, keepdims=True)
            outs.append(jnp.einsum('bhqn,bqnhd->bqhd', (e / den).astype(vg.dtype), vg))
            lses.append((m + jnp.log(den))[..., 0])
        alpha = jax.nn.softmax(jnp.stack(lses), axis=0).transpose(0, 1, 3, 2)[..., None]
        o = jnp.stack(outs)
        return jnp.sum(alpha.astype(o.dtype) * o, axis=0)

    out = lax.map(one_block, jnp.arange(S // Q_BLOCK) * Q_BLOCK)
    return out.transpose(1, 0, 2, 3, 4).reshape(B, S, H, d)


def even_mixer(h, w_in, cmp_pe_k, cmp_w1_k, cmp_w2_k, cmp_pe_v, cmp_w1_v, cmp_w2_v,
               mla_q_norm, mla_w_uq, mla_kv_norm, mla_w_ukv, w_out):
    B, S, _ = h.shape
    cos, sin = rope_tables(S, HEAD_DIM)
    z = h @ w_in
    o1 = A_Q_COLS
    o2 = o1 + A_KV_COLS
    o3 = o2 + A_GATE_COLS
    o4 = o3 + MLA_Q_RANK
    o5 = o4 + MLA_KV_RANK
    q_a = apply_rope(z[..., :o1].reshape(B, S, NSA_HEADS, HEAD_DIM), cos, sin)
    kv_a = z[..., o1:o2].reshape(B, S, 3, 2, NSA_KV_GROUPS, HEAD_DIM)
    gate = jax.nn.sigmoid(z[..., o2:o3]).reshape(B, S, NSA_HEADS, 3)
    k_cmp = nsa_compress(apply_rope(kv_a[:, :, 0, 0], cos, sin), cmp_pe_k, cmp_w1_k, cmp_w2_k)
    v_cmp = nsa_compress(kv_a[:, :, 0, 1], cmp_pe_v, cmp_w1_v, cmp_w2_v)
    k_slc = apply_rope(kv_a[:, :, 1, 0], cos, sin)
    k_win = apply_rope(kv_a[:, :, 2, 0], cos, sin)
    o_a = nsa_attention(q_a, k_cmp, v_cmp, k_slc, kv_a[:, :, 1, 1], k_win, kv_a[:, :, 2, 1], gate)
    o_b = mla_attention(z[..., o3:o4], z[..., o4:o5], z[..., o5:],
                        mla_q_norm, mla_w_uq, mla_kv_norm, mla_w_ukv)
    o = jnp.concatenate([o_a.reshape(B, S, -1), o_b.reshape(B, S, -1)], axis=-1)
    return o @ w_out


def odd_mixer(h, w_in, w_out):
    B, S, _ = h.shape
    cos, sin = rope_tables(S, HEAD_DIM)
    z = (h @ w_in).reshape(B, S, len(DIL_PATTERNS), 3, DIL_HEADS, HEAD_DIM)
    qs = [apply_rope(z[:, :, g, 0], cos, sin) for g in range(len(DIL_PATTERNS))]
    ks = [apply_rope(z[:, :, g, 1], cos, sin) for g in range(len(DIL_PATTERNS))]
    vs = [z[:, :, g, 2] for g in range(len(DIL_PATTERNS))]
    o = dilated_attention(qs, ks, vs)
    return o.reshape(B, S, ODD_OUT) @ w_out


def sq_relu_mlp(h, w1, w2):
    return jnp.square(jax.nn.relu(h @ w1)) @ w2


def setup_inputs(seed: int = 0) -> dict:
    key = jax.random.key(seed)
    it = iter(list(jax.random.split(key, 40)))

    def dense(shape, fan_in):
        return jax.random.normal(next(it), shape, jnp.float32) * fan_in ** -0.5

    def gain(n):
        return 1.0 + 0.05 * jax.random.normal(next(it), (n,), jnp.float32)

    def small(shape):
        return 0.1 * jax.random.normal(next(it), shape, jnp.float32)

    x = jax.random.normal(next(it), (BATCH, SEQ, D_MODEL), jnp.float32)
    cmp_in = NSA_CMP_LEN * HEAD_DIM
    return {
        "x": x,
        "l0_norm_mix_pre": gain(D_MODEL),
        "l0_w_in": dense((D_MODEL, EVEN_IN), D_MODEL),
        "l0_cmp_pe_k": small((NSA_CMP_LEN, HEAD_DIM)),
        "l0_cmp_w1_k": dense((cmp_in, NSA_CMP_HIDDEN), cmp_in),
        "l0_cmp_w2_k": dense((NSA_CMP_HIDDEN, HEAD_DIM), NSA_CMP_HIDDEN),
        "l0_cmp_pe_v": small((NSA_CMP_LEN, HEAD_DIM)),
        "l0_cmp_w1_v": dense((cmp_in, NSA_CMP_HIDDEN), cmp_in),
        "l0_cmp_w2_v": dense((NSA_CMP_HIDDEN, HEAD_DIM), NSA_CMP_HIDDEN),
        "l0_mla_q_norm": gain(MLA_Q_RANK),
        "l0_mla_w_uq": dense((MLA_Q_RANK, MLA_HEADS * (MLA_NOPE + MLA_ROPE)), MLA_Q_RANK),
        "l0_mla_kv_norm": gain(MLA_KV_RANK),
        "l0_mla_w_ukv": dense((MLA_KV_RANK, MLA_HEADS * (MLA_NOPE + MLA_V)), MLA_KV_RANK),
        "l0_w_out": dense((EVEN_OUT, D_MODEL), EVEN_OUT),
        "l0_norm_mix_post": gain(D_MODEL),
        "l0_norm_ffn_pre": gain(D_MODEL),
        "l0_w_ff1": dense((D_MODEL, D_FF), D_MODEL),
        "l0_w_ff2": dense((D_FF, D_MODEL), D_FF),
        "l0_norm_ffn_post": gain(D_MODEL),
        "l1_norm_mix_pre": gain(D_MODEL),
        "l1_w_in": dense((D_MODEL, ODD_IN), D_MODEL),
        "l1_w_out": dense((ODD_OUT, D_MODEL), ODD_OUT),
        "l1_norm_mix_post": gain(D_MODEL),
        "l1_norm_ffn_pre": gain(D_MODEL),
        "l1_w_ff1": dense((D_MODEL, D_FF), D_MODEL),
        "l1_w_ff2": dense((D_FF, D_MODEL), D_FF),
        "l1_norm_ffn_post": gain(D_MODEL),
    }


def reference(x, l0_norm_mix_pre, l0_w_in, l0_cmp_pe_k, l0_cmp_w1_k, l0_cmp_w2_k,
              l0_cmp_pe_v, l0_cmp_w1_v, l0_cmp_w2_v, l0_mla_q_norm, l0_mla_w_uq,
              l0_mla_kv_norm, l0_mla_w_ukv, l0_w_out, l0_norm_mix_post, l0_norm_ffn_pre,
              l0_w_ff1, l0_w_ff2, l0_norm_ffn_post, l1_norm_mix_pre, l1_w_in, l1_w_out,
              l1_norm_mix_post, l1_norm_ffn_pre, l1_w_ff1, l1_w_ff2, l1_norm_ffn_post):
    even_mix = (l0_w_in, l0_cmp_pe_k, l0_cmp_w1_k, l0_cmp_w2_k, l0_cmp_pe_v, l0_cmp_w1_v,
                l0_cmp_w2_v, l0_mla_q_norm, l0_mla_w_uq, l0_mla_kv_norm, l0_mla_w_ukv, l0_w_out)
    odd_mix = (l1_w_in, l1_w_out)
    norms = ((l0_norm_mix_pre, l0_norm_mix_post, l0_norm_ffn_pre, l0_norm_ffn_post),
             (l1_norm_mix_pre, l1_norm_mix_post, l1_norm_ffn_pre, l1_norm_ffn_post))
    ffns = ((l0_w_ff1, l0_w_ff2), (l1_w_ff1, l1_w_ff2))
    h = x
    for layer in range(DEPTH):
        g_mix_pre, g_mix_post, g_ffn_pre, g_ffn_post = norms[layer]
        u = rms_norm(h, g_mix_pre)
        if layer % 2 == 0:
            m = even_mixer(u, *even_mix)
        else:
            m = odd_mixer(u, *odd_mix)
        h = h + rms_norm(m, g_mix_post)
        f = sq_relu_mlp(rms_norm(h, g_ffn_pre), *ffns[layer])
        h = h + rms_norm(f, g_ffn_post)
    return h
```

```cpp
#include <hip/hip_runtime.h>
#include <hip/hip_bf16.h>
#include <hip/hip_cooperative_groups.h>
#include <cstdio>
#include <cstdint>
namespace cg = cooperative_groups;
namespace pg8 {
#define PG8_LAS __attribute__((address_space(3)))
typedef unsigned short bf16_t;
typedef short bf16x8 __attribute__((ext_vector_type(8)));
typedef float f32x4 __attribute__((ext_vector_type(4)));
typedef unsigned u32x4 __attribute__((ext_vector_type(4)));
constexpr int BM = 256, BK = 64, HALF = 128, HTB = HALF * BK * 2  , STAGE_BYTES = 8 * HTB, NXCD = 8, WGM = 8;

__host__ __device__ __forceinline__ int lds_byte(int r, int c) { const int st = (r >> 4) * 2 + (c >> 5), rr = r & 15, cc = c & 31, ob = rr * 64 + cc * 2; return st * 1024 + (ob ^ (((ob >> 9) & 1) << 5)); }
__host__ __device__ __forceinline__ void stage_rc(int b, int& R, int& C) { const int st = b / 1024, sb = b % 1024, swz = sb ^ (((sb >> 9) & 1) << 5); R = (st >> 1) * 16 + swz / 64; C = (st & 1) * 32 + (swz % 64) / 2; }
__host__ __device__ __forceinline__ int perm32(int rho) { const int n = rho >> 4, i = rho & 15; return 8 * (i >> 2) + 4 * n + (i & 3); }

struct Unit { int pm, pn; };
struct Gemm { const bf16_t* A; const bf16_t* Bt; int M, N, K, lda; };

struct StaticOrder {
    int nM, nN, nwg, G, c;
    __host__ __device__ void init(int M, int N, int G_, int c_) { nM = M / BM; nN = N / BM; nwg = nM * nN; G = G_; c = c_; }
    __host__ __device__ bool next(int i, Unit& u) const {
        const long L = (long)i * G + c; if (L >= nwg) return false;
        int wgid = (int)L; { const int q = nwg / NXCD, r = nwg % NXCD, xcd = wgid % NXCD, off = wgid / NXCD; wgid = (xcd < r ? xcd * (q + 1) : r * (q + 1) + (xcd - r) * q) + off; }
        const int nig = WGM * nN, gid = wgid / nig, fm = gid * WGM, gsz = (nM - fm) < WGM ? (nM - fm) : WGM;
        u.pm = fm + ((wgid % nig) % gsz); u.pn = (wgid % nig) / gsz; return true;
    }
    __device__ __forceinline__ void a_ready(const Unit&) const {}
    __device__ __forceinline__ void done(const Unit&) const {}
};

template <class Epi, class Sched, bool ALIGN_EPI = false, bool SP2 = false>
__device__ __forceinline__ void gemm_phase(PG8_LAS unsigned char* lds, const Gemm g, const Sched& S, const Epi& E) {
    int tid_ = threadIdx.x; asm volatile("" : "+v"(tid_)); const int tid = tid_, wid = __builtin_amdgcn_readfirstlane(tid >> 6), lane = tid & 63, wr = wid >> 2, wc = wid & 3, fr = lane & 15, fq = lane >> 4;
    const int K = g.K, nt = K / BK;
    unsigned voffA[2], voffB[2];
#pragma unroll
    for (int i = 0; i < 2; ++i) { int R, C; stage_rc(tid * 16 + i * 8192, R, C); const int Rb = Epi::PERM ? ((R & ~31) + perm32(R & 31)) : R;
        voffA[i] = (unsigned)(R * g.lda + C) * 2u; voffB[i] = (unsigned)(Rb * K + C) * 2u; }
    const size_t kstep = (size_t)(BK * 2);
    const size_t hstepA = (size_t)HALF * g.lda * 2, hstepB = (size_t)HALF * K * 2;
    const size_t tstepA = 2 * hstepA, tstepB = 2 * hstepB;
    const unsigned ldsw = (unsigned)wid * 1024u;
    const int aoff = lds_byte(wr * 64 + fr, fq * 8), boff = lds_byte(wc * 32 + fr, fq * 8);
#define PG8_SA(b, h) (((b) * 2 + (h)) * HTB)
#define PG8_SB(b, h) ((4 + (b) * 2 + (h)) * HTB)
#define PG8_STAGE(bufoff, gbase, voff) do { _Pragma("unroll") for (int _i = 0; _i < 2; ++_i) \
        __builtin_amdgcn_global_load_lds((const unsigned*)((const char*)(gbase) + (voff)[_i]), (PG8_LAS unsigned*)(lds + (bufoff) + ldsw + _i * 8192), 16, 0, 0); } while (0)
#define PG8_LDA(dst, b, h) do { _Pragma("unroll") for (int m = 0; m < 4; ++m) _Pragma("unroll") for (int k = 0; k < 2; ++k) dst[m][k] = *(const PG8_LAS bf16x8*)(lds + PG8_SA(b, h) + aoff + m * 2048 + k * 1024); } while (0)
#define PG8_LDB(dst, b, h) do { _Pragma("unroll") for (int n = 0; n < 2; ++n) _Pragma("unroll") for (int k = 0; k < 2; ++k) dst[n][k] = *(const PG8_LAS bf16x8*)(lds + PG8_SB(b, h) + boff + n * 2048 + k * 1024); } while (0)
#define PG8_MMA(ai, bj, At, Bt) do { __builtin_amdgcn_s_setprio(1); _Pragma("unroll") for (int m = 0; m < 4; ++m) _Pragma("unroll") for (int n = 0; n < 2; ++n) _Pragma("unroll") for (int k = 0; k < 2; ++k) \
        acc[ai][bj][m][n] = __builtin_amdgcn_mfma_f32_16x16x32_bf16(Bt[n][k], At[m][k], acc[ai][bj][m][n], 0, 0, 0); __builtin_amdgcn_s_setprio(0); } while (0)
#define PG8_WAIT_V(n) asm volatile("s_waitcnt vmcnt(" #n ")" ::: "memory")
#define PG8_WAIT_L(n) asm volatile("s_waitcnt lgkmcnt(" #n ")" ::: "memory")
#define PG8_BAR __builtin_amdgcn_s_barrier()
#define PG8_SCHED __builtin_amdgcn_sched_barrier(0)
    Unit cur, nxt; int ui = 0;
    if (!S.next(0, cur)) return;
    f32x4 acc[2][2][4][2];
#pragma unroll
    for (int a = 0; a < 2; ++a)
#pragma unroll
        for (int b = 0; b < 2; ++b)
#pragma unroll
            for (int m = 0; m < 4; ++m)
#pragma unroll
                for (int n = 0; n < 2; ++n) acc[a][b][m][n] = (f32x4){0.f, 0.f, 0.f, 0.f};
    bf16x8 At[4][2], B0[2][2], B1[2][2];
    const char* cA = (const char*)g.A + (size_t)cur.pm * tstepA; const char* cB = (const char*)g.Bt + (size_t)cur.pn * tstepB;
    S.a_ready(cur);
    if constexpr (SP2) {
        PG8_STAGE(PG8_SB(0, 0), cB, voffB); PG8_STAGE(PG8_SB(0, 1), cB + hstepB, voffB); PG8_STAGE(PG8_SA(0, 0), cA, voffA); PG8_STAGE(PG8_SA(0, 1), cA + hstepA, voffA);
        if (wr == 1) PG8_BAR;
        PG8_WAIT_V(2); PG8_BAR;
        PG8_STAGE(PG8_SB(1, 0), cB + kstep, voffB); PG8_STAGE(PG8_SA(1, 0), cA + kstep, voffA); PG8_STAGE(PG8_SB(1, 1), cB + hstepB + kstep, voffB);
        PG8_WAIT_V(6); PG8_BAR;
    } else {
        PG8_STAGE(PG8_SB(0, 0), cB, voffB); PG8_STAGE(PG8_SA(0, 0), cA, voffA); PG8_STAGE(PG8_SB(0, 1), cB + hstepB, voffB); PG8_STAGE(PG8_SA(0, 1), cA + hstepA, voffA);
        if (wr == 1) PG8_BAR;
        PG8_WAIT_V(4); PG8_BAR;
        PG8_STAGE(PG8_SB(1, 0), cB + kstep, voffB); PG8_STAGE(PG8_SA(1, 0), cA + kstep, voffA); PG8_STAGE(PG8_SB(1, 1), cB + hstepB + kstep, voffB);
        PG8_WAIT_V(6); PG8_BAR;
    }
    for (;;) {
        const bool has_next = S.next(ui + 1, nxt);
        const char* nA = has_next ? (const char*)g.A + (size_t)nxt.pm * tstepA : cA; const char* nB = has_next ? (const char*)g.Bt + (size_t)nxt.pn * tstepB : cB;
        for (int t = 0; t < nt; t += 2) {
            const bool last = (t == nt - 2);
            const char* a1 = cA + (size_t)(t + 1) * kstep;
            const char* a2 = last ? nA : cA + (size_t)(t + 2) * kstep; const char* b2 = last ? nB : cB + (size_t)(t + 2) * kstep;
            const char* a3 = a2 + kstep; const char* b3 = b2 + kstep;
            if (last && has_next) S.a_ready(nxt);
            if constexpr (SP2) {
            PG8_LDB(B0, 0, 0); PG8_LDB(B1, 0, 1); PG8_SCHED; PG8_LDA(At, 0, 0); PG8_STAGE(PG8_SA(1, 1), a1 + hstepA, voffA);
            PG8_WAIT_V(8); PG8_WAIT_L(0); PG8_BAR; PG8_MMA(0, 0, At, B0); PG8_MMA(0, 1, At, B1); PG8_BAR; PG8_SCHED;
            PG8_LDA(At, 0, 1); PG8_STAGE(PG8_SB(0, 0), b2, voffB); PG8_STAGE(PG8_SB(0, 1), b2 + hstepB, voffB); PG8_STAGE(PG8_SA(0, 0), a2, voffA);
            PG8_WAIT_V(8); PG8_WAIT_L(0); PG8_BAR; PG8_MMA(1, 0, At, B0); PG8_MMA(1, 1, At, B1); PG8_BAR; PG8_SCHED;
            PG8_LDB(B0, 1, 0); PG8_LDB(B1, 1, 1); PG8_SCHED; PG8_LDA(At, 1, 0); PG8_STAGE(PG8_SA(0, 1), a2 + hstepA, voffA);
            PG8_WAIT_V(8); PG8_WAIT_L(0); PG8_BAR; PG8_MMA(0, 0, At, B0); PG8_MMA(0, 1, At, B1); PG8_BAR; PG8_SCHED;
            PG8_LDA(At, 1, 1); PG8_STAGE(PG8_SB(1, 0), b3, voffB); PG8_STAGE(PG8_SB(1, 1), b3 + hstepB, voffB); PG8_STAGE(PG8_SA(1, 0), a3, voffA);
            PG8_WAIT_V(8); PG8_WAIT_L(0); PG8_BAR; PG8_MMA(1, 0, At, B0); PG8_MMA(1, 1, At, B1); PG8_BAR; PG8_SCHED;
            } else {
            PG8_LDB(B0, 0, 0); PG8_SCHED; PG8_LDA(At, 0, 0); PG8_STAGE(PG8_SA(1, 1), a1 + hstepA, voffA);
            PG8_WAIT_L(8); PG8_BAR; PG8_WAIT_L(0); PG8_MMA(0, 0, At, B0); PG8_BAR; PG8_SCHED;
            PG8_LDB(B1, 0, 1); PG8_STAGE(PG8_SB(0, 0), b2, voffB);
            PG8_BAR; PG8_WAIT_L(0); PG8_MMA(0, 1, At, B1); PG8_BAR;
            PG8_LDA(At, 0, 1); PG8_STAGE(PG8_SA(0, 0), a2, voffA);
            PG8_BAR; PG8_WAIT_L(0); PG8_MMA(1, 0, At, B0); PG8_BAR; PG8_SCHED;
            PG8_STAGE(PG8_SB(0, 1), b2 + hstepB, voffB);
            PG8_WAIT_V(6); PG8_BAR; PG8_MMA(1, 1, At, B1); PG8_BAR;
            PG8_LDB(B0, 1, 0); PG8_SCHED; PG8_LDA(At, 1, 0); PG8_STAGE(PG8_SA(0, 1), a2 + hstepA, voffA);
            PG8_WAIT_L(8); PG8_BAR; PG8_WAIT_L(0); PG8_MMA(0, 0, At, B0); PG8_BAR; PG8_SCHED;
            PG8_LDB(B1, 1, 1); PG8_STAGE(PG8_SB(1, 0), b3, voffB);
            PG8_BAR; PG8_WAIT_L(0); PG8_MMA(0, 1, At, B1); PG8_BAR;
            PG8_LDA(At, 1, 1); PG8_STAGE(PG8_SA(1, 0), a3, voffA);
            PG8_BAR; PG8_WAIT_L(0); PG8_MMA(1, 0, At, B0); PG8_BAR; PG8_SCHED;
            PG8_STAGE(PG8_SB(1, 1), b3 + hstepB, voffB);
            PG8_WAIT_V(6); PG8_BAR; PG8_MMA(1, 1, At, B1); PG8_BAR;
            }
        }
        if constexpr (ALIGN_EPI) { if (wr == 0) PG8_BAR; }
        if constexpr (!Epi::AFTER_DRAIN) { E(acc, cur, wr, wc, fr, fq); S.done(cur); }
        if (!has_next) break;
#pragma unroll
        for (int a = 0; a < 2; ++a)
#pragma unroll
            for (int b = 0; b < 2; ++b)
#pragma unroll
                for (int m = 0; m < 4; ++m)
#pragma unroll
                    for (int n = 0; n < 2; ++n) acc[a][b][m][n] = (f32x4){0.f, 0.f, 0.f, 0.f};
        cur = nxt; cA = nA; cB = nB; ++ui;
        if constexpr (ALIGN_EPI) { if (wr == 1) PG8_BAR; }
    }
    PG8_WAIT_V(0);
    if constexpr (!ALIGN_EPI) { if (wr == 0) PG8_BAR; }
    PG8_BAR;
    if constexpr (Epi::AFTER_DRAIN) { E.fused(acc, cur, wr, wc, fr, fq, lds, wid, lane); S.done(cur); }
#undef PG8_SA
#undef PG8_SB
#undef PG8_STAGE
#undef PG8_LDA
#undef PG8_LDB
#undef PG8_MMA
#undef PG8_WAIT_V
#undef PG8_WAIT_L
#undef PG8_BAR
#undef PG8_SCHED
}
}

namespace fa {
constexpr int D = 128;
constexpr int NW = 8, QBLK = 32, KVBLK = 64, QB = NW * QBLK;
constexpr int SHM_V = KVBLK * D * 2, SHM_K = KVBLK * D * 2, SHM_KP = KVBLK * 64 * 2;
constexpr int LDS_WS = 2 * SHM_V + 2 * SHM_K;
constexpr int LDS_KP = LDS_WS + NW * 64 * 4;
constexpr int LDS_BYTES = LDS_KP + 2 * SHM_KP;
constexpr float THR = 8.f;

using bf16 = __hip_bfloat16;
typedef short bf16x8 __attribute__((ext_vector_type(8)));
typedef short s16x4 __attribute__((ext_vector_type(4)));
typedef float f32x16 __attribute__((ext_vector_type(16)));
typedef float f32x4 __attribute__((ext_vector_type(4)));
typedef unsigned u32x4 __attribute__((ext_vector_type(4)));

#define KSWZ(row, colB) ((row) * 256 + ((colB) ^ (((row) & 7) << 4)))
#define KPSWZ(row, colB) ((row) * 128 + ((colB) ^ (((row) & 7) << 4)))
#define SBAR() __builtin_amdgcn_sched_barrier(0)
__device__ __forceinline__ int v_st(int k, int c) { const int kk = (k & ~0xC) | ((k & 4) << 1) | ((k & 8) >> 1); return ((kk >> 3) * 4 + (c >> 5)) * 512 + ((kk & 7) * 32 + (c & 31)) * 2; }
__device__ __forceinline__ int v_rd_base(int lane) { return ((lane & 3) << 3) | (((lane >> 2) & 3) << 6) | (((lane >> 4) & 1) << 5) | (((lane >> 5) & 1) << 8); }
constexpr int v_rd_off(int d0, int ks, int half) { return d0 * 512 + ks * 4096 + half * 2048; }
__device__ __forceinline__ int crow(int r, int hi) { return (r & 3) + 8 * (r >> 2) + 4 * hi; }
__device__ __forceinline__ unsigned cvtpk(float lo, float hi) {
    unsigned r; asm volatile("v_cvt_pk_bf16_f32 %0, %1, %2" : "=v"(r) : "v"(lo), "v"(hi)); return r;
}
__device__ __forceinline__ bf16x8 load8(const bf16* p) { return *reinterpret_cast<const bf16x8*>(p); }
__device__ __forceinline__ void mask_tile(f32x16& p0, f32x16& p1, int dq, unsigned W) {
    const float NEG = -__builtin_inff();
#pragma unroll
    for (int r = 0; r < 16; ++r) {
        const int c = (r & 3) + 8 * (r >> 2);
        if ((unsigned)(dq - c) >= W) p0[r] = NEG;
        if ((unsigned)(dq - c - 32) >= W) p1[r] = NEG;
    }
}
template <class C>
__device__ __forceinline__ void partialSM(f32x16& p0, f32x16& p1, float& m_reg, float& mn, float& alpha) {
    float pmax = p0[0]; for (int r = 1; r < 16; ++r) pmax = fmaxf(pmax, p0[r]); for (int r = 0; r < 16; ++r) pmax = fmaxf(pmax, p1[r]);
    { auto rr = __builtin_amdgcn_permlane32_swap(__float_as_uint(pmax), __float_as_uint(pmax), false, false);
      pmax = fmaxf(__uint_as_float(rr[0]), __uint_as_float(rr[1])); }
    constexpr float C2 = 1.4426950408889634f * C::SCALE;
    if (__builtin_expect(__all((pmax - m_reg) * C::SCALE <= THR), 1)) { mn = m_reg; alpha = 1.f; }
    else { mn = fmaxf(m_reg, pmax); alpha = __builtin_amdgcn_exp2f((m_reg - mn) * C2); m_reg = mn; }
    const float mnL = -mn * C2;
    for (int r = 0; r < 16; ++r) p0[r] = fmaf(p0[r], C2, mnL); for (int r = 0; r < 16; ++r) p1[r] = fmaf(p1[r], C2, mnL);
    for (int r = 0; r < 16; ++r) p0[r] = __builtin_amdgcn_exp2f(p0[r]);
}
#define FA_PK4(P, B_, OUT) do { unsigned a0 = cvtpk(P[B_+0], P[B_+1]), a1 = cvtpk(P[B_+2], P[B_+3]);                          \
        unsigned b0 = cvtpk(P[B_+4], P[B_+5]), b1 = cvtpk(P[B_+6], P[B_+7]);                                             \
        auto r0 = __builtin_amdgcn_permlane32_swap(a0, b0, false, false); auto r1 = __builtin_amdgcn_permlane32_swap(a1, b1, false, false); \
        u32x4 w = {r0[0], r1[0], r0[1], r1[1]}; OUT = *reinterpret_cast<bf16x8*>(&w); } while (0)
__device__ __forceinline__ void finishSM(f32x16& p0, f32x16& p1, float alpha, float& l_reg, bf16x8& pa0, bf16x8& pa1, bf16x8& pa2, bf16x8& pa3) {
    for (int r = 0; r < 16; ++r) p1[r] = __builtin_amdgcn_exp2f(p1[r]);
    float ps = 0; for (int r = 0; r < 16; ++r) ps += p0[r]; for (int r = 0; r < 16; ++r) ps += p1[r];
    { auto rr = __builtin_amdgcn_permlane32_swap(__float_as_uint(ps), __float_as_uint(ps), false, false);
      ps = __uint_as_float(rr[0]) + __uint_as_float(rr[1]); }
    l_reg = l_reg * alpha + ps;
    FA_PK4(p0, 0, pa0); FA_PK4(p0, 8, pa1); FA_PK4(p1, 0, pa2); FA_PK4(p1, 8, pa3);
}
__device__ __forceinline__ void packP(f32x16& p0, f32x16& p1, bf16x8& pa0, bf16x8& pa1, bf16x8& pa2, bf16x8& pa3) {
    FA_PK4(p0, 0, pa0); FA_PK4(p0, 8, pa1); FA_PK4(p1, 0, pa2); FA_PK4(p1, 8, pa3);
}
template <int KB, bool SK, bool PE>
__device__ __forceinline__ void qkt(f32x16& p0, f32x16& p1, const char* K_lds, const char* KP_lds, int r32, int hi, const bf16x8* qr, bool act) {
    if (SK && !act) { const float NEG = -__builtin_inff();
#pragma unroll
        for (int r = 0; r < 16; ++r) { p0[r] = NEG; p1[r] = NEG; } return; }
    p0 = f32x16{}; p1 = f32x16{};
    const char* kb[4];
#pragma unroll
    for (int dd = 0; dd < 4; ++dd) kb[dd] = K_lds + KB * SHM_K + KSWZ(r32, (dd * 16 + hi * 8) * 2);
#pragma unroll
    for (int d0 = 0; d0 < 8; ++d0) { const char* a = kb[d0 & 3] + (d0 >> 2) * 128;
        bf16x8 b0 = *reinterpret_cast<const bf16x8*>(a);
        bf16x8 b1 = *reinterpret_cast<const bf16x8*>(a + 32 * 256);
        p0 = __builtin_amdgcn_mfma_f32_32x32x16_bf16(b0, qr[d0], p0, 0, 0, 0);
        p1 = __builtin_amdgcn_mfma_f32_32x32x16_bf16(b1, qr[d0], p1, 0, 0, 0); }
    if constexpr (PE) {
#pragma unroll
        for (int d0 = 0; d0 < 4; ++d0) { const char* a = KP_lds + KB * SHM_KP + KPSWZ(r32, (d0 * 16 + hi * 8) * 2);
            bf16x8 b0 = *reinterpret_cast<const bf16x8*>(a);
            bf16x8 b1 = *reinterpret_cast<const bf16x8*>(a + 32 * 128);
            p0 = __builtin_amdgcn_mfma_f32_32x32x16_bf16(b0, qr[8 + d0], p0, 0, 0, 0);
            p1 = __builtin_amdgcn_mfma_f32_32x32x16_bf16(b1, qr[8 + d0], p1, 0, 0, 0); }
    }
}
template <int VB, bool SK>
__device__ __forceinline__ void pv_tile(f32x16* o, int vb0, bf16x8 pa0, bf16x8 pa1, bf16x8 pa2, bf16x8 pa3, bool act) {
    if (SK && !act) return;
#define TRRD(dst, off) asm volatile("ds_read_b64_tr_b16 %0, %1 offset:%2" : "=&v"(dst) : "v"(vb0), "i"(off) : "memory")
#define PV_D0(d0) do { s16x4 l0, l1, l2, l3, h0, h1, h2, h3; constexpr int b_ = VB * SHM_V + v_rd_off(d0, 0, 0);     \
        TRRD(l0, b_); TRRD(h0, b_ + 2048); TRRD(l1, b_ + 4096); TRRD(h1, b_ + 6144); TRRD(l2, b_ + 8192); TRRD(h2, b_ + 10240); TRRD(l3, b_ + 12288); TRRD(h3, b_ + 14336); \
        asm volatile("s_waitcnt lgkmcnt(0)" ::: "memory"); SBAR();   \
        o[d0] = __builtin_amdgcn_mfma_f32_32x32x16_bf16(pa0, (bf16x8){l0[0], l0[1], l0[2], l0[3], h0[0], h0[1], h0[2], h0[3]}, o[d0], 0, 0, 0);   \
        o[d0] = __builtin_amdgcn_mfma_f32_32x32x16_bf16(pa1, (bf16x8){l1[0], l1[1], l1[2], l1[3], h1[0], h1[1], h1[2], h1[3]}, o[d0], 0, 0, 0);   \
        o[d0] = __builtin_amdgcn_mfma_f32_32x32x16_bf16(pa2, (bf16x8){l2[0], l2[1], l2[2], l2[3], h2[0], h2[1], h2[2], h2[3]}, o[d0], 0, 0, 0);   \
        o[d0] = __builtin_amdgcn_mfma_f32_32x32x16_bf16(pa3, (bf16x8){l3[0], l3[1], l3[2], l3[3], h3[0], h3[1], h3[2], h3[3]}, o[d0], 0, 0, 0); } while (0)
    PV_D0(0); PV_D0(1); PV_D0(2); PV_D0(3);
#undef PV_D0
#undef TRRD
}

template <int QS_, int OS_, bool PE_, bool SK_, int SCALE_NUM> struct Cfg {
    static constexpr int QS = QS_, OS = OS_; static constexpr bool PE = PE_, SK = SK_;
    static constexpr float SCALE = SCALE_NUM == 128 ? 0.08838834764831845f : 0.07216878364870323f;
    static constexpr int NQ = PE_ ? 12 : 8;
};
struct BlockRef { const bf16* Q; const bf16* K; const bf16* V; const bf16* KP; bf16* O; float* L; int P0; };
template <class C> struct Seam { bf16x8 qr[C::NQ]; bf16x8 st_v0, st_v1, st_k0, st_k1, st_p; };
__device__ __forceinline__ int swa_jlo(int P0, int W) { const int lowk = P0 - W + 1; return lowk > 0 ? lowk / KVBLK : 0; }
#define ROW(p, k0, rr) ((p) + (size_t)((k0) + (rr)) * D + sc)
#define VMW() asm volatile("s_waitcnt vmcnt(0)" ::: "memory")
#define VMWN(n) asm volatile("s_waitcnt vmcnt(%0)" :: "i"(n) : "memory")
#define SLOAD_H(Kp, Vp, KPp, k0) do { S.st_v0 = load8(ROW(Vp, k0, sr)); S.st_v1 = load8(ROW(Vp, k0, 32 + sr));              \
                         S.st_k0 = load8(ROW(Kp, k0, sr)); S.st_k1 = load8(ROW(Kp, k0, 32 + sr));                           \
                         if constexpr (C::PE) S.st_p = load8((KPp) + (size_t)((k0) + pr) * 64 + pc); } while (0)
#define SWRITE_HK(bf) do { *(bf16x8*)(K_lds + (bf) * SHM_K + kws) = S.st_k0; *(bf16x8*)(K_lds + (bf) * SHM_K + kws + 32 * 256) = S.st_k1; \
                           if constexpr (C::PE) *(bf16x8*)(KP_lds + (bf) * SHM_KP + pws) = S.st_p; } while (0)
#define SWRITE_HV(bf) do { *(bf16x8*)(V_lds + (bf) * SHM_V + vst0) = S.st_v0; *(bf16x8*)(V_lds + (bf) * SHM_V + vst1) = S.st_v1; } while (0)
#define SWRITE_H(bf) do { SWRITE_HV(bf); SWRITE_HK(bf); } while (0)
#define QLOADS(ref) do { _Pragma("unroll") for (int d0 = 0; d0 < 8; ++d0) S.qr[d0] = load8((ref).Q + (size_t)(wid * QBLK + r32) * C::QS + d0 * 16 + hi * 8); \
        if constexpr (C::PE) { _Pragma("unroll") for (int d0 = 0; d0 < 4; ++d0) S.qr[8 + d0] = load8((ref).Q + (size_t)(wid * QBLK + r32) * C::QS + 128 + d0 * 16 + hi * 8); } } while (0)
template <class C>
__device__ __forceinline__ void prime(const BlockRef& cur, int W, char* lds, Seam<C>& S) {
    int tid_ = threadIdx.x; asm volatile("" : "+v"(tid_)); const int tid = tid_, wid = __builtin_amdgcn_readfirstlane(tid >> 6), lane = tid & 63, r32 = lane & 31, hi = lane >> 5;
    const int sr = tid >> 4, sc = (tid & 15) * 8, kws = KSWZ(sr, sc * 2); char* K_lds = lds + 2 * SHM_V; char* KP_lds = lds + LDS_KP;
    const int pr = tid >> 3, pc = (tid & 7) * 8, pws = KPSWZ(pr, pc * 2);
    const int kb0 = swa_jlo(cur.P0, W) * KVBLK;
    QLOADS(cur);
    SLOAD_H(cur.K, cur.V, cur.KP, kb0); VMW(); SWRITE_HK(0);
    __syncthreads();
}
template <class C>
__device__ __forceinline__ void block(const BlockRef& cur, const BlockRef& nxt, int skv, int W, char* lds, Seam<C>& S) {
    constexpr bool SK = C::SK, PE = C::PE;
    int tid_ = threadIdx.x; asm volatile("" : "+v"(tid_)); const int tid = tid_, wid = __builtin_amdgcn_readfirstlane(tid >> 6), lane = tid & 63, r32 = lane & 31, hi = lane >> 5;
    const int j_lo = swa_jlo(cur.P0, W);
    int j_hi = (cur.P0 + QB - 1) / KVBLK + 1; if (j_hi > skv / KVBLK) j_hi = skv / KVBLK;
    const int NT = j_hi - j_lo;
    const int kbn = swa_jlo(nxt.P0, W) * KVBLK;
    const int qlo = cur.P0 + wid * QBLK, qm = qlo + r32 - 4 * hi;
    char* V_lds = lds; char* K_lds = lds + 2 * SHM_V; char* KP_lds = lds + LDS_KP;
    float* ws = (float*)(lds + LDS_WS) + wid * 64; float* li_l = ws, * al_l = ws + 32;
    float m_reg = -1e30f, l_reg = 0; f32x16 o[4] = {};
    const int sr = tid >> 4, sc = (tid & 15) * 8, vst0 = v_st(sr, sc), vst1 = v_st(32 + sr, sc), kws = KSWZ(sr, sc * 2);
    const int pr = tid >> 3, pc = (tid & 7) * 8, pws = KPSWZ(pr, pc * 2);
    const int vb0 = (int)(uintptr_t)V_lds + v_rd_base(lane);
    const bf16* Kh = cur.K; const bf16* Vh = cur.V; const bf16* KPh = cur.KP;
#define RESC(a) do { if (__any((a) < 1.f)) { if (hi == 0) al_l[r32] = (a); asm volatile("s_waitcnt lgkmcnt(0)" ::: "memory");              \
                     for (int d_ = 0; d_ < 4; ++d_) for (int r = 0; r < 16; ++r) o[d_][r] *= al_l[crow(r, hi)]; } } while (0)
#define KBASE(t) ((j_lo + (t)) * KVBLK)
#define ACT(t) (KBASE(t) <= qlo + QBLK - 1 && KBASE(t) + KVBLK - 1 >= qlo - W + 1)
#define MASKT(P0_, P1_, t) do { const int kb_ = KBASE(t); if ((!SK || ACT(t)) && (kb_ + KVBLK - 1 > qlo || kb_ <= qlo + QBLK - 1 - W)) mask_tile(P0_, P1_, qm - kb_, (unsigned)W); } while (0)
    constexpr int NQL = C::NQ;
#define SEAM_K0() do { VMWN(NQL); SWRITE_HK(0); SBAR(); } while (0)
    f32x16 pA0, pA1, pB0, pB1; float mnA, mnB, alA, alB; bf16x8 pa0, pa1, pa2, pa3;
    SWRITE_HV(0); SBAR();
    if (NT > 1) { SLOAD_H(Kh, Vh, KPh, KBASE(1)); }
    SBAR(); qkt<0, SK, PE>(pA0, pA1, K_lds, KP_lds, r32, hi, S.qr, ACT(0));
    MASKT(pA0, pA1, 0); partialSM<C>(pA0, pA1, m_reg, mnA, alA);
    if (NT > 1) { VMW(); SWRITE_H(1); }
    __syncthreads();
#define HALF_STEP(PX0, PX1, mnX, alX, PY0, PY1, alY, t, KB, VB, SB) do {                                                      \
        SBAR(); qkt<KB, SK, PE>(PX0, PX1, K_lds, KP_lds, r32, hi, S.qr, ACT(t));                                             \
        finishSM(PY0, PY1, alY, l_reg, pa0, pa1, pa2, pa3); SBAR();                                                           \
        if ((t) + 1 < NT) { SLOAD_H(Kh, Vh, KPh, KBASE((t) + 1)); SBAR(); }                                               \
        pv_tile<VB, SK>(o, vb0, pa0, pa1, pa2, pa3, ACT((t) - 1)); MASKT(PX0, PX1, (t)); partialSM<C>(PX0, PX1, m_reg, mnX, alX);                                        \
        __syncthreads();                                                                                                      \
        if ((t) + 1 < NT) { VMW(); SWRITE_H(SB); }                                                                          \
        RESC(alX); __syncthreads(); } while (0)
    for (int t = 1; t + 1 < NT; t += 2) {
        HALF_STEP(pB0, pB1, mnB, alB, pA0, pA1, alA, t, 1, 0, 0);
        HALF_STEP(pA0, pA1, mnA, alA, pB0, pB1, alB, t + 1, 0, 1, 1);
    }
    const bool even = (NT & 1) == 0;
    if (even) { SBAR(); qkt<1, SK, PE>(pB0, pB1, K_lds, KP_lds, r32, hi, S.qr, ACT(NT - 1)); SBAR(); }
    SLOAD_H(nxt.K, nxt.V, nxt.KP, kbn); SBAR();
    QLOADS(nxt);
    SBAR();
    finishSM(pA0, pA1, alA, l_reg, pa0, pa1, pa2, pa3); SBAR();
    pv_tile<0, SK>(o, vb0, pa0, pa1, pa2, pa3, ACT(even ? NT - 2 : NT - 1));
    if (even) { MASKT(pB0, pB1, NT - 1); partialSM<C>(pB0, pB1, m_reg, mnB, alB); __syncthreads(); RESC(alB);
        finishSM(pB0, pB1, alB, l_reg, pa0, pa1, pa2, pa3); SBAR(); pv_tile<1, SK>(o, vb0, pa0, pa1, pa2, pa3, ACT(NT - 1)); }
    SBAR(); SEAM_K0();
    if (hi == 0) li_l[r32] = l_reg; asm volatile("s_waitcnt lgkmcnt(0)" ::: "memory");
    if (cur.L != nullptr && hi == 0) cur.L[wid * QBLK + r32] = m_reg * C::SCALE + __logf(l_reg);
    float rli[16];
#pragma unroll
    for (int r = 0; r < 16; ++r) rli[r] = __builtin_amdgcn_rcpf(li_l[crow(r, hi)]);
    bf16* Ow = cur.O + (size_t)(wid * QBLK) * C::OS;
#pragma unroll
    for (int r = 0; r < 16; ++r) { const int orow = crow(r, hi);
#pragma unroll
        for (int d0 = 0; d0 < 4; ++d0) { const float v = o[d0][r] * rli[r];
            const float vn = __shfl_xor(v, 1);
            if ((r32 & 1) == 0) *(unsigned*)(Ow + (size_t)orow * C::OS + d0 * 32 + r32) = cvtpk(v, vn); } }
    __syncthreads();
#undef RESC
#undef KBASE
#undef ACT
#undef MASKT
#undef SEAM_K0
#undef HALF_STEP
}

template <class C>
__device__ __forceinline__ void block_simple(const BlockRef& cur, int skv, int W, char* lds) {
    constexpr bool SK = C::SK, PE = C::PE;
    Seam<C> S;
    int tid_ = threadIdx.x; asm volatile("" : "+v"(tid_)); const int tid = tid_, wid = __builtin_amdgcn_readfirstlane(tid >> 6), lane = tid & 63, r32 = lane & 31, hi = lane >> 5;
    const int j_lo = swa_jlo(cur.P0, W);
    int j_hi = (cur.P0 + QB - 1) / KVBLK + 1; if (j_hi > skv / KVBLK) j_hi = skv / KVBLK;
    const int NT = j_hi - j_lo;
    const int qlo = cur.P0 + wid * QBLK, qm = qlo + r32 - 4 * hi;
    char* V_lds = lds; char* K_lds = lds + 2 * SHM_V; char* KP_lds = lds + LDS_KP;
    float* ws = (float*)(lds + LDS_WS) + wid * 64; float* li_l = ws, * al_l = ws + 32;
    float m_reg = -1e30f, l_reg = 0; f32x16 o[4] = {};
    const int sr = tid >> 4, sc = (tid & 15) * 8, vst0 = v_st(sr, sc), vst1 = v_st(32 + sr, sc), kws = KSWZ(sr, sc * 2);
    const int pr = tid >> 3, pc = (tid & 7) * 8, pws = KPSWZ(pr, pc * 2);
    const int vb0 = (int)(uintptr_t)V_lds + v_rd_base(lane);
    const bf16* Kh = cur.K; const bf16* Vh = cur.V; const bf16* KPh = cur.KP;
#define KBASE(t) ((j_lo + (t)) * KVBLK)
#define ACT(t) (KBASE(t) <= qlo + QBLK - 1 && KBASE(t) + KVBLK - 1 >= qlo - W + 1)
#define MASKT(P0_, P1_, t) do { const int kb_ = KBASE(t); if ((!SK || ACT(t)) && (kb_ + KVBLK - 1 > qlo || kb_ <= qlo + QBLK - 1 - W)) mask_tile(P0_, P1_, qm - kb_, (unsigned)W); } while (0)
#define RESC(a) do { if (__any((a) < 1.f)) { if (hi == 0) al_l[r32] = (a); asm volatile("s_waitcnt lgkmcnt(0)" ::: "memory");              \
                     for (int d_ = 0; d_ < 4; ++d_) for (int r = 0; r < 16; ++r) o[d_][r] *= al_l[crow(r, hi)]; } } while (0)
    QLOADS(cur);
    SLOAD_H(Kh, Vh, KPh, KBASE(0)); VMW(); SWRITE_H(0);
    __syncthreads();
    f32x16 p0, p1; float mn, al; bf16x8 pa0, pa1, pa2, pa3;
#define STEP(t, BUF) do { \
        if ((t) + 1 < NT) { SLOAD_H(Kh, Vh, KPh, KBASE((t) + 1)); SBAR(); } \
        qkt<BUF, SK, PE>(p0, p1, K_lds, KP_lds, r32, hi, S.qr, ACT(t)); \
        MASKT(p0, p1, (t)); partialSM<C>(p0, p1, m_reg, mn, al); finishSM(p0, p1, al, l_reg, pa0, pa1, pa2, pa3); RESC(al); SBAR(); \
        pv_tile<BUF, SK>(o, vb0, pa0, pa1, pa2, pa3, ACT(t)); \
        if ((t) + 1 < NT) { VMW(); SWRITE_H(1 - BUF); } \
        __syncthreads(); } while (0)
    for (int t = 0; t < NT; t += 2) {
        STEP(t, 0);
        if (t + 1 < NT) STEP(t + 1, 1);
    }
#undef STEP
    if (hi == 0) li_l[r32] = l_reg; asm volatile("s_waitcnt lgkmcnt(0)" ::: "memory");
    if (cur.L != nullptr && hi == 0) cur.L[wid * QBLK + r32] = m_reg * C::SCALE + __logf(l_reg);
    float rli[16];
#pragma unroll
    for (int r = 0; r < 16; ++r) rli[r] = __builtin_amdgcn_rcpf(li_l[crow(r, hi)]);
    bf16* Ow = cur.O + (size_t)(wid * QBLK) * C::OS;
#pragma unroll
    for (int r = 0; r < 16; ++r) { const int orow = crow(r, hi);
#pragma unroll
        for (int d0 = 0; d0 < 4; ++d0) { const float v = o[d0][r] * rli[r];
            const float vn = __shfl_xor(v, 1);
            if ((r32 & 1) == 0) *(unsigned*)(Ow + (size_t)orow * C::OS + d0 * 32 + r32) = cvtpk(v, vn); } }
    __syncthreads();
#undef RESC
#undef KBASE
#undef ACT
#undef MASKT
}
#undef ROW
#undef VMW
#undef VMWN
#undef SLOAD_H
#undef SWRITE_HK
#undef SWRITE_HV
#undef SWRITE_H
#undef QLOADS
}
constexpr int BATCH = 2, SEQ = 16384, DM = 2048, MTOK = BATCH * SEQ, DFF = 8192;
constexpr float EPS = 1e-6f;
constexpr int NWAVES = 8, NTHREADS = 512;
constexpr int LDS_BYTES = 159744;
constexpr size_t MiB = 1u << 20;
typedef unsigned short bf16_t;
typedef float f32x4 __attribute__((ext_vector_type(4)));
typedef unsigned u32x4 __attribute__((ext_vector_type(4)));
typedef unsigned u32x2 __attribute__((ext_vector_type(2)));

constexpr size_t W_L1_WIN = 0;
constexpr size_t W_L1_WOUT = W_L1_WIN + (size_t)9216 * 2048 * 2;
constexpr size_t W_L1_FF1 = W_L1_WOUT + (size_t)2048 * 1024 * 2;
constexpr size_t W_L1_FF2 = W_L1_FF1 + (size_t)8192 * 2048 * 2;
constexpr size_t W_L0_WIN = W_L1_FF2 + (size_t)2048 * 8192 * 2;
constexpr size_t W_L0_WOUT = W_L0_WIN + (size_t)3584 * 2048 * 2;
constexpr size_t W_L0_FF1 = W_L0_WOUT + (size_t)2048 * 2048 * 2;
constexpr size_t W_L0_FF2 = W_L0_FF1 + (size_t)8192 * 2048 * 2;
constexpr size_t W_UQ = W_L0_FF2 + (size_t)2048 * 8192 * 2;
constexpr size_t W_UKV = W_UQ + (size_t)1536 * 512 * 2;
constexpr size_t W_C1 = W_UKV + (size_t)2048 * 256 * 2;
constexpr size_t W_C2 = W_C1 + (size_t)256 * 4096 * 2;
constexpr size_t W_END = W_C2 + (size_t)256 * 256 * 2;
constexpr size_t SM_BASE = 196 * MiB;
static_assert(W_END <= SM_BASE, "weights");
constexpr size_t SM_ROPE_C = SM_BASE;
constexpr size_t SM_ROPE_S = SM_ROPE_C + (size_t)SEQ * 64 * 4;
constexpr size_t SM_ROPE2_C = SM_ROPE_S + (size_t)SEQ * 64 * 4;
constexpr size_t SM_ROPE2_S = SM_ROPE2_C + (size_t)SEQ * 32 * 4;
constexpr size_t SM_ROWSQ = SM_ROPE2_S + (size_t)SEQ * 32 * 4;
enum { RS_X = 0, RS_H1, RS_H2, RS_H3, RS_CQ = 4  , RS_CKV = 6  , RS_N = 8 };
constexpr size_t SM_CBIAS = SM_ROWSQ + (size_t)RS_N * MTOK * 4;
constexpr size_t SM_GATE = SM_CBIAS + 1024;
constexpr size_t SM_LSE = SM_GATE + (size_t)MTOK * 24 * 4;
constexpr size_t SM_END = SM_LSE + (size_t)3 * MTOK * 8 * 4;
constexpr size_t ACT_BASE = 216 * MiB;
static_assert(SM_END <= ACT_BASE, "small");
constexpr size_t A_HB = ACT_BASE;
constexpr size_t A_QN = A_HB + 128 * MiB;
constexpr size_t A_KV = A_QN + 64 * MiB;
constexpr size_t A_KVPAD = A_KV + 96 * MiB;
constexpr size_t A_VST = A_KVPAD + 1 * MiB;
constexpr size_t A_CQ = A_VST + 16 * MiB;
constexpr size_t A_CKV = A_CQ + 32 * MiB;
constexpr size_t A_KPE = A_CKV + 16 * MiB;
constexpr size_t A_HC = A_KPE + 4 * MiB;
constexpr size_t A_KCMP = A_HC + 4 * MiB;
constexpr size_t A_VCMP = A_KCMP + 1 * MiB;
constexpr size_t A_OW = A_VCMP + 1 * MiB;
constexpr size_t A_O = A_OW + 64 * MiB;
constexpr size_t A_MM = A_O + 128 * MiB;
constexpr size_t A_L0_END = A_MM + 128 * MiB;
static_assert(A_L0_END <= 1024 * MiB, "layer-0 map");
constexpr size_t DO_MQ = 0, DO_MK = 96 * MiB, DO_MV = 160 * MiB;
constexpr size_t A_F = A_HB + 128 * MiB;
constexpr size_t A_HID = A_F + 128 * MiB;
static_assert(A_HID + 512 * MiB <= 1024 * MiB, "ffn map");
constexpr size_t A_Z1 = A_HB + 128 * MiB;
constexpr size_t A_OG0 = A_Z1 + 576 * MiB;
constexpr size_t A_OG1 = W_L0_WIN;
constexpr size_t A_OG2 = A_HB;
static_assert(A_OG0 + 64 * MiB <= 1024 * MiB && A_OG1 + 64 * MiB <= SM_BASE, "OG map");
constexpr size_t A_O1 = A_HB + 64 * MiB;
constexpr size_t A_MM1 = A_Z1;
static_assert(A_Z1 + 576 * MiB <= 1024 * MiB, "layer-1 map");
namespace nsa {
using namespace fa;
constexpr int IMP_STRIDE = 257;
constexpr int LDS_IMP = 84992;
constexpr int LDS_SEL = LDS_IMP + 64 * IMP_STRIDE * 4;
constexpr int LDS_CNT = LDS_SEL + 64 * 16 * 2;
constexpr int LDS_END = LDS_CNT + 64 * 4;
constexpr float C2 = 1.4426950408889634f * 0.08838834764831845f;
typedef float f32x4v __attribute__((ext_vector_type(4)));
using CN = Cfg<128, 128, false, false, 128>;

struct Tensors {
    const bf16* QN;
    const bf16* KC;
    const bf16* VC;
    const bf16* KS;
    const bf16* VST;
    bf16* OW;
    const float* GATE;
    bf16* O;
};

__device__ __forceinline__ unsigned long long wave_max_u64(unsigned long long v) {
#pragma unroll
    for (int o = 1; o < 64; o <<= 1) { const unsigned long long w = __shfl_xor(v, o); v = w > v ? w : v; }
    return v;
}

__device__ __forceinline__ void slc_row(const Tensors& T, int b, int g, int t, const short* selrow, int cnt, int lane) {
    constexpr int S = 16384;
    const int col = lane & 15, q4 = lane >> 4;
    const size_t bg = (size_t)(b * 2 + g);
    bf16x8 Bq[4];
    { const bf16* qp = T.QN + (((size_t)(b * 8 + 4 * g + (col & 3)) * S + t) * 128) + 8 * q4;
#pragma unroll
      for (int ks = 0; ks < 4; ++ks) { bf16x8 v = load8(qp + 32 * ks); if (col >= 4) v = (bf16x8){0, 0, 0, 0, 0, 0, 0, 0}; Bq[ks] = v; } }
    float m_run = -1e30f, l_run = 0.f;
    f32x4v oacc[8];
#pragma unroll
    for (int i = 0; i < 8; ++i) oacc[i] = (f32x4v){0.f, 0.f, 0.f, 0.f};
    for (int i = 0; i < cnt; ++i) {
        const int jb = __builtin_amdgcn_readfirstlane((int)selrow[i]);
        const bf16* Kb = T.KS + (bg * S + (size_t)64 * jb) * 128 + (size_t)col * 128 + 8 * q4;
        const bf16* Vb = T.VST + ((bg * 256 + jb) * 128) * 64 + (size_t)col * 64 + 8 * q4;
        f32x4v sacc[4];
#pragma unroll
        for (int kg = 0; kg < 4; ++kg) { sacc[kg] = (f32x4v){0.f, 0.f, 0.f, 0.f};
#pragma unroll
            for (int ks = 0; ks < 4; ++ks) { const bf16x8 a = load8(Kb + kg * 16 * 128 + 32 * ks);
                sacc[kg] = __builtin_amdgcn_mfma_f32_16x16x32_bf16(a, Bq[ks], sacc[kg], 0, 0, 0); } }
        bf16x8 Va[8][2];
#pragma unroll
        for (int dg = 0; dg < 8; ++dg)
#pragma unroll
            for (int kp = 0; kp < 2; ++kp) Va[dg][kp] = load8(Vb + dg * 16 * 64 + 32 * kp);
        const int kbase = 64 * jb + 4 * q4;
        float mx = -__builtin_inff();
#pragma unroll
        for (int kg = 0; kg < 4; ++kg)
#pragma unroll
            for (int r = 0; r < 4; ++r) { if (kbase + 16 * kg + r > t) sacc[kg][r] = -__builtin_inff(); mx = fmaxf(mx, sacc[kg][r]); }
        mx = fmaxf(mx, __shfl_xor(mx, 16)); mx = fmaxf(mx, __shfl_xor(mx, 32));
        const float m_new = fmaxf(m_run, mx);
        const float alpha = __builtin_amdgcn_exp2f((m_run - m_new) * C2);
        m_run = m_new;
        const float mL = -m_new * C2;
        float ps = 0.f;
#pragma unroll
        for (int kg = 0; kg < 4; ++kg)
#pragma unroll
            for (int r = 0; r < 4; ++r) { const float p = __builtin_amdgcn_exp2f(fmaf(sacc[kg][r], C2, mL)); sacc[kg][r] = p; ps += p; }
        l_run = l_run * alpha + ps;
#pragma unroll
        for (int dg = 0; dg < 8; ++dg) oacc[dg] = oacc[dg] * alpha;
        bf16x8 Bp[2];
#pragma unroll
        for (int kp = 0; kp < 2; ++kp) { u32x4 w = {cvtpk(sacc[2 * kp][0], sacc[2 * kp][1]), cvtpk(sacc[2 * kp][2], sacc[2 * kp][3]),
                                                    cvtpk(sacc[2 * kp + 1][0], sacc[2 * kp + 1][1]), cvtpk(sacc[2 * kp + 1][2], sacc[2 * kp + 1][3])};
            Bp[kp] = *reinterpret_cast<bf16x8*>(&w); }
#pragma unroll
        for (int dg = 0; dg < 8; ++dg)
#pragma unroll
            for (int kp = 0; kp < 2; ++kp) oacc[dg] = __builtin_amdgcn_mfma_f32_16x16x32_bf16(Va[dg][kp], Bp[kp], oacc[dg], 0, 0, 0);
    }
    l_run += __shfl_xor(l_run, 16); l_run += __shfl_xor(l_run, 32);
    if (col < 4) {
        const int head = 4 * g + col;
        const size_t m = (size_t)b * S + t;
        const float g1 = T.GATE[m * 24 + head * 3 + 1];
        const float sc = l_run > 0.f ? g1 / l_run : 0.f;
        const bf16* pre = T.OW + (((size_t)(b * 8 + head) * S + t) * 128) + 4 * q4;
        bf16* out = T.O + m * 2048 + head * 128 + 4 * q4;
#pragma unroll
        for (int dg = 0; dg < 8; ++dg) {
            const unsigned long long pv64 = __hip_atomic_load(reinterpret_cast<const unsigned long long*>(pre + 16 * dg), __ATOMIC_RELAXED, __HIP_MEMORY_SCOPE_AGENT);
            uint2 pv; pv.x = (unsigned)pv64; pv.y = (unsigned)(pv64 >> 32);
            const float a0 = __uint_as_float(pv.x << 16), a1 = __uint_as_float(pv.x & 0xffff0000u), a2 = __uint_as_float(pv.y << 16), a3 = __uint_as_float(pv.y & 0xffff0000u);
            uint2 w; w.x = cvtpk(a0 + sc * oacc[dg][0], a1 + sc * oacc[dg][1]); w.y = cvtpk(a2 + sc * oacc[dg][2], a3 + sc * oacc[dg][3]);
            *reinterpret_cast<uint2*>(out + 16 * dg) = w;
        }
    }
}

__device__ __forceinline__ void nsa_block(const Tensors& T, int b, int g, int c, char* lds) {
    constexpr int S = 16384;
    int tid_ = threadIdx.x; asm volatile("" : "+v"(tid_)); const int tid = tid_, wid = __builtin_amdgcn_readfirstlane(tid >> 6), lane = tid & 63, r32 = lane & 31, hi = lane >> 5;
    const int hh = wid & 3, rh = wid >> 2, head = 4 * g + hh;
    unsigned* imp = (unsigned*)(lds + LDS_IMP);
    short* sel = (short*)(lds + LDS_SEL);
    int* cntp = (int*)(lds + LDS_CNT);
    for (int i = tid; i < 64 * IMP_STRIDE; i += 512) imp[i] = 0u;
    const int t0 = 64 * c;
    const int n_vis = 4 * c + 3;
    const int NT = (n_vis + 63) >> 6;
    bf16x8 qr[8];
    { const bf16* qp = T.QN + (((size_t)(b * 8 + head) * S + t0 + 32 * rh + r32) * 128) + hi * 8;
#pragma unroll
      for (int d0 = 0; d0 < 8; ++d0) qr[d0] = load8(qp + d0 * 16); }
    const int trow = t0 + 32 * rh + r32;
    const int vp = (trow - 31) >> 4;
    char* V_lds = lds; char* K_lds = lds + 2 * SHM_V;
    const int sr = tid >> 4, sc = (tid & 15) * 8, vst0 = v_st(sr, sc), vst1 = v_st(32 + sr, sc), kws = KSWZ(sr, sc * 2);
    const int vb0 = (int)(uintptr_t)V_lds + v_rd_base(lane);
    const bf16* Kh = T.KC + (size_t)(b * 2 + g) * 1024 * 128;
    const bf16* Vh = T.VC + (size_t)(b * 2 + g) * 1024 * 128;
    float* ws = (float*)(lds + LDS_WS) + wid * 64; float* li_l = ws, * al_l = ws + 32;
    bf16x8 st_k0, st_k1, st_v0, st_v1;
#define ROWP(p, k0, rr) ((p) + (size_t)((k0) + (rr)) * 128 + sc)
    __syncthreads();
    float m_reg = -1e30f, l_reg = 0.f;
    {
        st_k0 = load8(ROWP(Kh, 0, sr)); st_k1 = load8(ROWP(Kh, 0, 32 + sr));
        asm volatile("s_waitcnt vmcnt(0)" ::: "memory");
        *(bf16x8*)(K_lds + kws) = st_k0; *(bf16x8*)(K_lds + kws + 32 * 256) = st_k1;
        __syncthreads();
        f32x16 p0, p1; float mn, al; bf16x8 pa0, pa1, pa2, pa3;
#define STEP1(t, BUF) do { \
            if ((t) + 1 < NT) { st_k0 = load8(ROWP(Kh, 64 * ((t) + 1), sr)); st_k1 = load8(ROWP(Kh, 64 * ((t) + 1), 32 + sr)); SBAR(); } \
            qkt<BUF, false, false>(p0, p1, K_lds, nullptr, r32, hi, qr, true); \
            mask_tile(p0, p1, vp - 64 * (t) - 4 * hi, 0x7fffffffu); \
            partialSM<CN>(p0, p1, m_reg, mn, al); finishSM(p0, p1, al, l_reg, pa0, pa1, pa2, pa3); \
            if ((t) + 1 < NT) { asm volatile("s_waitcnt vmcnt(0)" ::: "memory"); *(bf16x8*)(K_lds + (1 - BUF) * SHM_K + kws) = st_k0; *(bf16x8*)(K_lds + (1 - BUF) * SHM_K + kws + 32 * 256) = st_k1; } \
            __syncthreads(); } while (0)
        for (int t = 0; t < NT; t += 2) { STEP1(t, 0); if (t + 1 < NT) STEP1(t + 1, 1); }
#undef STEP1
    }
    const float rl = l_reg > 0.f ? 1.f / l_reg : 0.f;
    const float mL = -m_reg * C2;
    f32x16 o[4] = {};
    {
        st_k0 = load8(ROWP(Kh, 0, sr)); st_k1 = load8(ROWP(Kh, 0, 32 + sr)); st_v0 = load8(ROWP(Vh, 0, sr)); st_v1 = load8(ROWP(Vh, 0, 32 + sr));
        asm volatile("s_waitcnt vmcnt(0)" ::: "memory");
        *(bf16x8*)(K_lds + kws) = st_k0; *(bf16x8*)(K_lds + kws + 32 * 256) = st_k1; *(bf16x8*)(V_lds + vst0) = st_v0; *(bf16x8*)(V_lds + vst1) = st_v1;
        __syncthreads();
        f32x16 p0, p1; bf16x8 pa0, pa1, pa2, pa3;
        unsigned* improw = imp + (32 * rh + r32) * IMP_STRIDE;
#define STEP2(t, BUF) do { \
            if ((t) + 1 < NT) { st_k0 = load8(ROWP(Kh, 64 * ((t) + 1), sr)); st_k1 = load8(ROWP(Kh, 64 * ((t) + 1), 32 + sr)); \
                                st_v0 = load8(ROWP(Vh, 64 * ((t) + 1), sr)); st_v1 = load8(ROWP(Vh, 64 * ((t) + 1), 32 + sr)); SBAR(); } \
            qkt<BUF, false, false>(p0, p1, K_lds, nullptr, r32, hi, qr, true); \
            mask_tile(p0, p1, vp - 64 * (t) - 4 * hi, 0x7fffffffu); \
            _Pragma("unroll") for (int r = 0; r < 16; ++r) { p0[r] = __builtin_amdgcn_exp2f(fmaf(p0[r], C2, mL)) * rl; p1[r] = __builtin_amdgcn_exp2f(fmaf(p1[r], C2, mL)) * rl; } \
            _Pragma("unroll") for (int G = 0; G < 4; ++G) { \
                const int j0 = 16 * (t) + 2 * G + hi; \
                const float s4 = (p0[4 * G] + p0[4 * G + 1]) + (p0[4 * G + 2] + p0[4 * G + 3]); \
                const float s4b = (p1[4 * G] + p1[4 * G + 1]) + (p1[4 * G + 2] + p1[4 * G + 3]); \
                atomicAdd(improw + j0, (unsigned)(s4 * 536870912.f)); atomicAdd(improw + j0 + 1, (unsigned)(p0[4 * G + 3] * 536870912.f)); \
                atomicAdd(improw + j0 + 8, (unsigned)(s4b * 536870912.f)); atomicAdd(improw + j0 + 9, (unsigned)(p1[4 * G + 3] * 536870912.f)); } \
            packP(p0, p1, pa0, pa1, pa2, pa3); SBAR(); \
            pv_tile<BUF, false>(o, vb0, pa0, pa1, pa2, pa3, true); \
            if ((t) + 1 < NT) { asm volatile("s_waitcnt vmcnt(0)" ::: "memory"); *(bf16x8*)(K_lds + (1 - BUF) * SHM_K + kws) = st_k0; *(bf16x8*)(K_lds + (1 - BUF) * SHM_K + kws + 32 * 256) = st_k1; \
                                *(bf16x8*)(V_lds + (1 - BUF) * SHM_V + vst0) = st_v0; *(bf16x8*)(V_lds + (1 - BUF) * SHM_V + vst1) = st_v1; } \
            __syncthreads(); } while (0)
        for (int t = 0; t < NT; t += 2) { STEP2(t, 0); if (t + 1 < NT) STEP2(t + 1, 1); }
#undef STEP2
    }
#undef ROWP
    {
#pragma unroll
        for (int r = 0; r < 16; ++r) {
            const int orow = crow(r, hi); const int t = t0 + 32 * rh + orow; const size_t m = (size_t)b * S + t;
            const float g0 = T.GATE[m * 24 + head * 3 + 0], g2 = T.GATE[m * 24 + head * 3 + 2];
            bf16* owp = T.OW + (((size_t)(b * 8 + head) * S + t) * 128);
#pragma unroll
            for (int d0 = 0; d0 < 4; ++d0) {
                const float v = o[d0][r]; const float vn = __shfl_xor(v, 1);
                if ((r32 & 1) == 0) { unsigned* pp = (unsigned*)(owp + d0 * 32 + r32); const unsigned w = *pp;
                    const float w0 = __uint_as_float(w << 16), w1 = __uint_as_float(w & 0xffff0000u);
                    *pp = cvtpk(g0 * v + g2 * w0, g0 * vn + g2 * w1); }
            }
        }
    }
    __threadfence_block();
    __syncthreads();
    for (int qi = 0; qi < 8; ++qi) {
        const int q = wid * 8 + qi;
        short* srow = sel + q * 16;
        if (c <= 15) { if (lane <= c) srow[lane] = (short)lane; if (lane == 0) cntp[q] = c + 1; }
        else {
            unsigned long long key[4];
#pragma unroll
            for (int i = 0; i < 4; ++i) { const int j = lane + 64 * i; const bool ok = (j >= 1) && (j <= c - 2);
                key[i] = ok ? (((unsigned long long)imp[q * IMP_STRIDE + j] << 32) | (unsigned long long)(0xFFFFFFFFu - (unsigned)j)) : 0ull; }
            if (lane == 0) { srow[0] = 0; srow[1] = (short)(c - 1); srow[2] = (short)c; cntp[q] = 16; }
            for (int it = 0; it < 13; ++it) {
                unsigned long long mxk = key[0]; mxk = key[1] > mxk ? key[1] : mxk; mxk = key[2] > mxk ? key[2] : mxk; mxk = key[3] > mxk ? key[3] : mxk;
                const unsigned long long win = wave_max_u64(mxk);
                const int jw = (int)(0xFFFFFFFFu - (unsigned)(win & 0xFFFFFFFFull));
#pragma unroll
                for (int i = 0; i < 4; ++i) if (key[i] == win) key[i] = 0ull;
                if (lane == 0) srow[3 + it] = (short)jw;
            }
        }
    }
    __syncthreads();
    for (int qi = 0; qi < 8; ++qi) {
        const int q = wid + 8 * qi;
        const int cnt = __builtin_amdgcn_readfirstlane(cntp[q]);
        slc_row(T, b, g, t0 + q, sel + q * 16, cnt, lane);
    }
    __syncthreads();
}
}
#define LAS __attribute__((address_space(3)))
__device__ __forceinline__ unsigned f2bf(float f) { unsigned u = __builtin_bit_cast(unsigned, f); return (u + 0x7fffu + ((u >> 16) & 1u)) >> 16; }
__device__ __forceinline__ unsigned pk2(float lo, float hi) { unsigned r; asm volatile("v_cvt_pk_bf16_f32 %0, %1, %2" : "=v"(r) : "v"(lo), "v"(hi)); return r; }
__device__ __forceinline__ float bflo(unsigned w) { return __uint_as_float(w << 16); }
__device__ __forceinline__ float bfhi(unsigned w) { return __uint_as_float(w & 0xffff0000u); }
__device__ __forceinline__ float wave_sum(float v) {
#pragma unroll
    for (int o = 1; o < 64; o <<= 1) v += __shfl_xor(v, o);
    return v;
}
struct Ctx {
    float* out; unsigned char* ws; unsigned char* lds;
    int tid, lane, wave, vcu, G;
};
__device__ __forceinline__ void ctx_refresh(Ctx& C) { int t = threadIdx.x; asm volatile("" : "+v"(t)); C.tid = t; C.lane = t & 63; C.wave = __builtin_amdgcn_readfirstlane(t >> 6); }
#define WSP(T, off) ((T*)(C.ws + (off)))
#define ROWSQ(i) (WSP(float, SM_ROWSQ) + (size_t)(i) * MTOK)

enum { MAP_ID = 0, MAP_L0_WIN, MAP_UQ, MAP_L1_WIN };
__device__ __forceinline__ int wmap(int kind, int n) {
    if (kind == MAP_ID) return n;
    if (kind == MAP_L0_WIN) {
        if (n < 1024) { const int p = n & 127; return (n - p) + (p >> 1) + 64 * (p & 1); }
        if (n < 2560) { const int n2 = n - 1024, seg = n2 >> 7, p = n2 & 127; const int kv = (seg >> 1) & 1;
            return kv == 0 ? 1024 + seg * 128 + (p >> 1) + 64 * (p & 1) : 1024 + n2; }
        if (n < 3072) return 2584 + (n - 2560);
        if (n < 3328) return 3096 + (n - 3072);
        if (n < 3392) { const int p = n - 3328; return 3352 + (p >> 1) + 32 * (p & 1); }
        if (n < 3416) return 2560 + (n - 3392);
        return -1;
    }
    if (kind == MAP_UQ) {
        if (n < 1024) { const int h = n >> 7, d = n & 127; return h * 192 + d; }
        const int n2 = n - 1024, h = n2 >> 6, p = n2 & 63; return h * 192 + 128 + (p >> 1) + 32 * (p & 1);
    }
    { const int p = n & 127, base = n - p, qkv = (n >> 10) % 3; return qkv < 2 ? base + (p >> 1) + 64 * (p & 1) : n; }
}
__device__ __forceinline__ void transpose_item(const float* W, int Nsrc, const float* gain, bf16_t* WT, int Kdst, int row_off, int kind, int nblk, LAS float* scr, int item, int lane) {
    const int kb = item / nblk, nb = item % nblk, k0 = 64 * kb, n0 = 32 * nb;
    const int src = wmap(kind, n0 + (lane & 31));
#pragma unroll 8
    for (int i = 0; i < 32; ++i) { const int kk = 2 * i + (lane >> 5);
        float v = 0.f; if (src >= 0) { v = W[(size_t)(k0 + kk) * Nsrc + src]; if (gain) v *= gain[k0 + kk]; }
        scr[kk * 33 + (lane & 31)] = v; }
    asm volatile("s_waitcnt lgkmcnt(0)" ::: "memory");
    const int c = lane & 7;
#pragma unroll
    for (int j = 0; j < 4; ++j) { const int n = (lane >> 3) + 8 * j; const LAS float* s = scr + (8 * c) * 33 + n;
        u32x4 o; o.x = pk2(s[0 * 33], s[1 * 33]); o.y = pk2(s[2 * 33], s[3 * 33]); o.z = pk2(s[4 * 33], s[5 * 33]); o.w = pk2(s[6 * 33], s[7 * 33]);
        *(u32x4*)(WT + (size_t)(row_off + n0 + n) * Kdst + k0 + 8 * c) = o; }
    asm volatile("s_waitcnt lgkmcnt(0)" ::: "memory");
}
struct Args { const float* in[27]; float* out; unsigned char* ws; int phase_hi; int pad; };
__device__ __forceinline__ void prologue(Ctx& C, const Args& args) {
    ctx_refresh(C);
    LAS float* scr = (LAS float*)(C.lds) + C.wave * 4096;
    const int gw = C.vcu * NWAVES + C.wave, NGW = C.G * NWAVES;
    int it = gw;
#define WJOB(in_idx, gain_idx, K, Nsrc, Ndst, Kdst, row_off, kind, dst) do { constexpr int nblk_ = (Ndst) / 32, nitems_ = ((K) / 64) * nblk_; \
        for (; it < nitems_; it += NGW) transpose_item(args.in[in_idx], Nsrc, (gain_idx) >= 0 ? args.in[(gain_idx) >= 0 ? (gain_idx) : 0] : nullptr, WSP(bf16_t, dst), Kdst, row_off, kind, nblk_, scr, it, C.lane); \
        it -= nitems_; } while (0)
    WJOB(2, 1, 2048, 3416, 3584, 2048, 0, MAP_L0_WIN, W_L0_WIN);
    WJOB(10, 9, 512, 1536, 1536, 512, 0, MAP_UQ, W_UQ);
    WJOB(12, 11, 256, 2048, 2048, 256, 0, MAP_ID, W_UKV);
    WJOB(4, -1, 4096, 128, 128, 4096, 0, MAP_ID, W_C1);
    WJOB(7, -1, 4096, 128, 128, 4096, 128, MAP_ID, W_C1);
    WJOB(13, -1, 2048, 2048, 2048, 2048, 0, MAP_ID, W_L0_WOUT);
    WJOB(16, 15, 2048, 8192, 8192, 2048, 0, MAP_ID, W_L0_FF1);
    WJOB(17, -1, 8192, 2048, 2048, 8192, 0, MAP_ID, W_L0_FF2);
    WJOB(20, 19, 2048, 9216, 9216, 2048, 0, MAP_L1_WIN, W_L1_WIN);
    WJOB(21, -1, 1024, 2048, 2048, 1024, 0, MAP_ID, W_L1_WOUT);
    WJOB(24, 23, 2048, 8192, 8192, 2048, 0, MAP_ID, W_L1_FF1);
    WJOB(25, -1, 8192, 2048, 2048, 8192, 0, MAP_ID, W_L1_FF2);
    WJOB(5, -1, 128, 128, 128, 256, 0, MAP_ID, W_C2);
    WJOB(8, -1, 128, 128, 128, 256, 128, MAP_ID, W_C2);
#undef WJOB
    for (int i = gw * 64 + C.lane; i < 256 * 16; i += NGW * 64) { const int n = i >> 4, c = i & 15; *(u32x4*)(WSP(bf16_t, W_C2) + (size_t)n * 256 + 128 + 8 * c) = (u32x4){0u, 0u, 0u, 0u}; }
    for (int i = gw * 64 + C.lane; i < SEQ * 64; i += NGW * 64) {
        const int t = i >> 6, j = i & 63;
        double inv = 1.0; { double cbase = 0.86596432336006535; for (int q = 0; q < j; ++q) inv *= cbase; }
        const float ang = (float)t * (float)inv;
        double r = (double)ang * 0.15915494309189535; r -= __builtin_rint(r);
        const float rf = (float)r;
        WSP(float, SM_ROPE_C)[i] = __builtin_amdgcn_cosf(rf); WSP(float, SM_ROPE_S)[i] = __builtin_amdgcn_sinf(rf);
    }
    for (int i = gw * 64 + C.lane; i < SEQ * 32; i += NGW * 64) {
        const int t = i >> 5, j = i & 31;
        double inv = 1.0; { double cbase = 0.74989420933245582; for (int q = 0; q < j; ++q) inv *= cbase; }
        const float ang = (float)t * (float)inv;
        double r = (double)ang * 0.15915494309189535; r -= __builtin_rint(r);
        const float rf = (float)r;
        WSP(float, SM_ROPE2_C)[i] = __builtin_amdgcn_cosf(rf); WSP(float, SM_ROPE2_S)[i] = __builtin_amdgcn_sinf(rf);
    }
    for (int i = RS_CQ * MTOK + gw * 64 + C.lane; i < RS_N * MTOK; i += NGW * 64) WSP(float, SM_ROWSQ)[i] = 0.f;
    if (gw < 256) {
        const float* pe = args.in[gw < 128 ? 3 : 6]; const float* w1 = args.in[gw < 128 ? 4 : 7]; const int c = gw & 127;
        float s = 0.f; for (int i = C.lane; i < 4096; i += 64) s += pe[i] * w1[(size_t)i * 128 + c];
        s = wave_sum(s); if (C.lane == 0) WSP(float, SM_CBIAS)[gw] = s;
    }
    for (int m = gw; m < MTOK; m += NGW) {
        const f32x4* xr = (const f32x4*)(args.in[0] + (size_t)m * DM) + C.lane; u32x2* o = (u32x2*)(WSP(bf16_t, A_HB) + (size_t)m * DM) + C.lane;
        float s = 0.f;
#pragma unroll
        for (int j = 0; j < 8; ++j) { const f32x4 v = xr[64 * j]; s += (v.x * v.x + v.y * v.y) + (v.z * v.z + v.w * v.w); o[64 * j] = (u32x2){pk2(v.x, v.y), pk2(v.z, v.w)}; }
        s = wave_sum(s); if (C.lane == 0) ROWSQ(RS_X)[m] = s;
    }
}

__device__ __forceinline__ void postnorm_phase(Ctx& C, const float* hold, const bf16_t* mm, const float* g, float* rsq_out, bool write_hb) {
    ctx_refresh(C);
    const int gw = C.vcu * NWAVES + C.wave, NGW = C.G * NWAVES;
    f32x4 gv[8];
#pragma unroll
    for (int j = 0; j < 8; ++j) gv[j] = ((const f32x4*)g)[C.lane + 64 * j];
    for (int m = gw; m < MTOK; m += NGW) {
        const f32x4* hr = (const f32x4*)(hold + (size_t)m * DM) + C.lane; const u32x2* mr = (const u32x2*)(mm + (size_t)m * DM) + C.lane;
        f32x4* orow = (f32x4*)(C.out + (size_t)m * DM) + C.lane; u32x2* hb = (u32x2*)(WSP(bf16_t, A_HB) + (size_t)m * DM) + C.lane;
        u32x2 w[8]; float q = 0.f;
#pragma unroll
        for (int j = 0; j < 8; ++j) { w[j] = mr[64 * j]; const float a = bflo(w[j].x), b = bfhi(w[j].x), c = bflo(w[j].y), d = bfhi(w[j].y); q += (a * a + b * b) + (c * c + d * d); }
        q = wave_sum(q);
        const float rstd = __builtin_amdgcn_rsqf(q * (1.f / DM) + EPS);
        float s = 0.f;
#pragma unroll
        for (int j = 0; j < 8; ++j) { const f32x4 h = hr[64 * j];
            f32x4 v; v.x = h.x + bflo(w[j].x) * rstd * gv[j].x; v.y = h.y + bfhi(w[j].x) * rstd * gv[j].y; v.z = h.z + bflo(w[j].y) * rstd * gv[j].z; v.w = h.w + bfhi(w[j].y) * rstd * gv[j].w;
            orow[64 * j] = v; s += (v.x * v.x + v.y * v.y) + (v.z * v.z + v.w * v.w);
            if (write_hb) hb[64 * j] = (u32x2){pk2(v.x, v.y), pk2(v.z, v.w)}; }
        if (write_hb) { s = wave_sum(s); if (C.lane == 0) rsq_out[m] = s; }
    }
}

__device__ __forceinline__ void vst_phase(Ctx& C) {
    ctx_refresh(C);
    const int gw = C.vcu * NWAVES + C.wave, NGW = C.G * NWAVES;
    const bf16_t* VS = WSP(bf16_t, A_KV + 3 * 16 * MiB); bf16_t* VST = WSP(bf16_t, A_VST);
    for (int it = gw; it < 4 * 256 * 2 * 8; it += NGW) {
        const int sg = it & 7, dh = (it >> 3) & 1, blk = (it >> 4) & 255, bg = it >> 12;
        const int d = dh * 64 + C.lane; const int kp = sg >> 2, q4 = sg & 3;
        const bf16_t* src = VS + ((size_t)bg * SEQ + 64 * blk) * 128 + d;
        unsigned short e[8];
#pragma unroll
        for (int j = 0; j < 8; ++j) { const int key = 32 * kp + (j < 4 ? 4 * q4 + j : 16 + 4 * q4 + (j - 4)); e[j] = src[(size_t)key * 128]; }
        u32x4 o; o.x = e[0] | ((unsigned)e[1] << 16); o.y = e[2] | ((unsigned)e[3] << 16); o.z = e[4] | ((unsigned)e[5] << 16); o.w = e[6] | ((unsigned)e[7] << 16);
        *(u32x4*)(VST + (((size_t)bg * 256 + blk) * 128 + d) * 64 + 8 * sg) = o;
    }
}

__device__ __forceinline__ void dil_merge_phase(Ctx& C) {
    ctx_refresh(C);
    const int gw = C.vcu * NWAVES + C.wave, NGW = C.G * NWAVES;
    const float* LSE = WSP(float, SM_LSE);
    const bf16_t* OG[3] = {WSP(bf16_t, A_OG0), WSP(bf16_t, A_OG1), WSP(bf16_t, A_OG2)};
    bf16_t* O1 = WSP(bf16_t, A_O1);
    for (int it = gw; it < MTOK * 2; it += NGW) {
        const int m = it >> 1, half = it & 1; const int b = m / SEQ, t = m % SEQ;
        const int h = 4 * half + (C.lane >> 4), d0 = (C.lane & 15) * 8;
        float l[3]; size_t idx[3];
#pragma unroll
        for (int g = 0; g < 3; ++g) { const int sh = 2 * g, r = 1 << sh; const int tp = (t & (r - 1)) * (SEQ >> sh) + (t >> sh);
            idx[g] = (size_t)(b * 8 + h) * SEQ + tp; l[g] = LSE[(size_t)g * MTOK * 8 + idx[g]]; }
        const float mx = fmaxf(l[0], fmaxf(l[1], l[2]));
        float e0 = __expf(l[0] - mx), e1 = __expf(l[1] - mx), e2 = __expf(l[2] - mx); const float inv = 1.f / (e0 + e1 + e2);
        const float a[3] = {e0 * inv, e1 * inv, e2 * inv};
        float acc[8] = {0, 0, 0, 0, 0, 0, 0, 0};
#pragma unroll
        for (int g = 0; g < 3; ++g) { const u32x4 w = *(const u32x4*)(OG[g] + idx[g] * 128 + d0);
            acc[0] += a[g] * bflo(w.x); acc[1] += a[g] * bfhi(w.x); acc[2] += a[g] * bflo(w.y); acc[3] += a[g] * bfhi(w.y);
            acc[4] += a[g] * bflo(w.z); acc[5] += a[g] * bfhi(w.z); acc[6] += a[g] * bflo(w.w); acc[7] += a[g] * bfhi(w.w); }
        *(u32x4*)(O1 + (size_t)m * 1024 + h * 128 + d0) = (u32x4){pk2(acc[0], acc[1]), pk2(acc[2], acc[3]), pk2(acc[4], acc[5]), pk2(acc[6], acc[7])};
    }
}
typedef pg8::f32x4 accv;
#define EPI_FOR_ROWS _Pragma("unroll") for (int ai = 0; ai < 2; ++ai) _Pragma("unroll") for (int m = 0; m < 4; ++m)
#define EPI_ROW (u.pm * 256 + ai * 128 + wr * 64 + m * 16 + fr)
__device__ __forceinline__ void store8(bf16_t* p, accv a, accv b) { *(u32x4*)p = (u32x4){pk2(a[0], a[1]), pk2(a[2], a[3]), pk2(b[0], b[1]), pk2(b[2], b[3])}; }
__device__ __forceinline__ void rope_store(bf16_t* dst, int pc, int half, accv a, accv b, const float* ct, const float* st) {
    const int i0 = pc >> 1; const f32x4 c = *(const f32x4*)(ct + i0), s = *(const f32x4*)(st + i0);
    const float o1a = a[0] * c.x - a[1] * s.x, o2a = a[0] * s.x + a[1] * c.x;
    const float o1b = a[2] * c.y - a[3] * s.y, o2b = a[2] * s.y + a[3] * c.y;
    const float o1c = b[0] * c.z - b[1] * s.z, o2c = b[0] * s.z + b[1] * c.z;
    const float o1d = b[2] * c.w - b[3] * s.w, o2d = b[2] * s.w + b[3] * c.w;
    *(u32x2*)(dst + i0) = (u32x2){pk2(o1a, o1b), pk2(o1c, o1d)};
    *(u32x2*)(dst + half + i0) = (u32x2){pk2(o2a, o2b), pk2(o2c, o2d)};
}
__device__ __forceinline__ float sumsq8(accv a, accv b) { return (a[0] * a[0] + a[1] * a[1]) + (a[2] * a[2] + a[3] * a[3]) + (b[0] * b[0] + b[1] * b[1]) + (b[2] * b[2] + b[3] * b[3]); }
__device__ __forceinline__ void rowsq_add(unsigned long long* p, float s, int fq) { s += __shfl_xor(s, 16); s += __shfl_xor(s, 32); if (fq == 0) atomicAdd(p, (unsigned long long)(s * 1099511627776.f)); }
__device__ __forceinline__ float rowsq_fx(const unsigned long long* p) { return (float)(*p) * 9.094947017729282e-13f; }

struct EpiL0In {
    static constexpr bool PERM = true, AFTER_DRAIN = false;
    unsigned char* ws; const float* rsq_x;
    __device__ __forceinline__ void operator()(const accv (&acc)[2][2][4][2], const pg8::Unit& u, int wr, int wc, int fr, int fq) const {
        const int pn = u.pn, pc = wc * 32 + 8 * fq;
        EPI_FOR_ROWS { const int row = EPI_ROW; const float rstd = __builtin_amdgcn_rsqf(rsq_x[row] * (1.f / DM) + EPS);
            const int b = row / SEQ, t = row % SEQ; float ssq = 0.f;
#pragma unroll
            for (int bj = 0; bj < 2; ++bj) { const accv v0 = acc[ai][bj][m][0] * rstd, v1 = acc[ai][bj][m][1] * rstd;
                if (pn < 4) { const int head = 2 * pn + bj;
                    rope_store((bf16_t*)(ws + A_QN) + ((size_t)(b * 8 + head) * SEQ + t) * 128, pc, 64, v0, v1, (const float*)(ws + SM_ROPE_C) + t * 64, (const float*)(ws + SM_ROPE_S) + t * 64); }
                else if (pn < 10) { const int q = pn - 4, kv = q & 1;
                    bf16_t* dst = (bf16_t*)(ws + A_KV + (size_t)q * 16 * MiB) + ((size_t)(b * 2 + bj) * SEQ + t) * 128;
                    if (kv == 0) rope_store(dst, pc, 64, v0, v1, (const float*)(ws + SM_ROPE_C) + t * 64, (const float*)(ws + SM_ROPE_S) + t * 64);
                    else store8(dst + pc, v0, v1); }
                else if (pn < 12) { store8((bf16_t*)(ws + A_CQ) + (size_t)row * 512 + (pn - 10) * 256 + bj * 128 + pc, v0, v1); ssq += sumsq8(v0, v1); }
                else if (pn == 12) { store8((bf16_t*)(ws + A_CKV) + (size_t)row * 256 + bj * 128 + pc, v0, v1); ssq += sumsq8(v0, v1); }
                else if (bj == 0) {
                    if (pc < 64) rope_store((bf16_t*)(ws + A_KPE) + ((size_t)b * SEQ + t) * 64, pc, 32, v0, v1, (const float*)(ws + SM_ROPE2_C) + t * 32, (const float*)(ws + SM_ROPE2_S) + t * 32);
                    else if (pc < 88) { float* gp = (float*)(ws + SM_GATE) + (size_t)row * 24 + (pc - 64);
                        f32x4 g0, g1;
                        g0.x = 1.f / (1.f + __expf(-v0[0])); g0.y = 1.f / (1.f + __expf(-v0[1])); g0.z = 1.f / (1.f + __expf(-v0[2])); g0.w = 1.f / (1.f + __expf(-v0[3]));
                        g1.x = 1.f / (1.f + __expf(-v1[0])); g1.y = 1.f / (1.f + __expf(-v1[1])); g1.z = 1.f / (1.f + __expf(-v1[2])); g1.w = 1.f / (1.f + __expf(-v1[3]));
                        *(f32x4*)gp = g0; *(f32x4*)(gp + 4) = g1; }
                }
            }
            if (pn >= 10 && pn < 12) rowsq_add((unsigned long long*)((float*)(ws + SM_ROWSQ) + (size_t)RS_CQ * MTOK) + row, ssq, fq);
            if (pn == 12) rowsq_add((unsigned long long*)((float*)(ws + SM_ROWSQ) + (size_t)RS_CKV * MTOK) + row, ssq, fq);
        }
    }
};
struct EpiUQ {
    static constexpr bool PERM = true, AFTER_DRAIN = false;
    unsigned char* ws; bf16_t* MQ; const unsigned long long* rsq;
    __device__ __forceinline__ void operator()(const accv (&acc)[2][2][4][2], const pg8::Unit& u, int wr, int wc, int fr, int fq) const {
        const int pn = u.pn, pc = wc * 32 + 8 * fq;
        EPI_FOR_ROWS { const int row = EPI_ROW; const float rstd = __builtin_amdgcn_rsqf(rowsq_fx(rsq + row) * (1.f / 512.f) + EPS);
            const int b = row / SEQ, t = row % SEQ;
#pragma unroll
            for (int bj = 0; bj < 2; ++bj) { const accv v0 = acc[ai][bj][m][0] * rstd, v1 = acc[ai][bj][m][1] * rstd;
                if (pn < 4) { const int head = 2 * pn + bj; store8(MQ + ((size_t)(b * 8 + head) * SEQ + t) * 192 + pc, v0, v1); }
                else { const int head = 4 * (pn - 4) + 2 * bj + (pc >> 6);
                    rope_store(MQ + ((size_t)(b * 8 + head) * SEQ + t) * 192 + 128, pc & 63, 32, v0, v1, (const float*)(ws + SM_ROPE2_C) + t * 32, (const float*)(ws + SM_ROPE2_S) + t * 32); }
            }
        }
    }
};
struct EpiUKV {
    static constexpr bool PERM = true, AFTER_DRAIN = false;
    bf16_t* MK; bf16_t* MV; const unsigned long long* rsq;
    __device__ __forceinline__ void operator()(const accv (&acc)[2][2][4][2], const pg8::Unit& u, int wr, int wc, int fr, int fq) const {
        const int pc = wc * 32 + 8 * fq;
        EPI_FOR_ROWS { const int row = EPI_ROW; const float rstd = __builtin_amdgcn_rsqf(rowsq_fx(rsq + row) * (1.f / 256.f) + EPS);
            const int b = row / SEQ, t = row % SEQ; const size_t off = ((size_t)(b * 8 + u.pn) * SEQ + t) * 128 + pc;
            store8(MK + off, acc[ai][0][m][0] * rstd, acc[ai][0][m][1] * rstd);
            store8(MV + off, acc[ai][1][m][0] * rstd, acc[ai][1][m][1] * rstd);
        }
    }
};
__device__ __forceinline__ float gelu_tanh(float x) { const float u = 0.7978845608028654f * (x + 0.044715f * x * x * x); const float e = __expf(2.f * u); const float th = 1.f - 2.f / (e + 1.f); return 0.5f * x * (1.f + th); }
struct EpiC1 {
    static constexpr bool PERM = true, AFTER_DRAIN = false;
    bf16_t* HC; const float* cb;
    template <int SEL> __device__ __forceinline__ void body(const accv (&acc)[2][2][4][2], const pg8::Unit& u, int wr, int wc, int fr, int fq) const {
        const int pc = wc * 32 + 8 * fq;
        const f32x4 b0 = *(const f32x4*)(cb + SEL * 128 + pc), b1 = *(const f32x4*)(cb + SEL * 128 + pc + 4);
        EPI_FOR_ROWS { const int row = EPI_ROW;
            accv v0 = acc[ai][SEL][m][0], v1 = acc[ai][SEL][m][1];
            v0 += (accv){b0.x, b0.y, b0.z, b0.w}; v1 += (accv){b1.x, b1.y, b1.z, b1.w};
#pragma unroll
            for (int e = 0; e < 4; ++e) { v0[e] = gelu_tanh(v0[e]); v1[e] = gelu_tanh(v1[e]); }
            store8(HC + (size_t)row * 256 + pc, v0, v1);
            *(u32x4*)(HC + (size_t)row * 256 + 128 + pc) = (u32x4){0u, 0u, 0u, 0u};
            asm volatile("" ::: "memory");
        }
    }
    __device__ __forceinline__ void operator()(const accv (&acc)[2][2][4][2], const pg8::Unit& u, int wr, int wc, int fr, int fq) const {
        if (u.pm >= 16) body<1>(acc, u, wr, wc, fr, fq); else body<0>(acc, u, wr, wc, fr, fq);
    }
};
struct EpiC2 {
    static constexpr bool PERM = true, AFTER_DRAIN = false;
    bf16_t* KC; bf16_t* VC;
    template <int SEL> __device__ __forceinline__ void body(const accv (&acc)[2][2][4][2], const pg8::Unit& u, int wr, int wc, int fr, int fq) const {
        const int pc = wc * 32 + 8 * fq;
        EPI_FOR_ROWS { const int row = EPI_ROW;
            accv v0 = acc[ai][SEL][m][0], v1 = acc[ai][SEL][m][1];
            if ((row & 1023) == 1023) { v0 = (accv){0.f, 0.f, 0.f, 0.f}; v1 = v0; }
            bf16_t* dst = (SEL ? VC : KC) + (size_t)(row & 4095) * 128 + pc;
            store8(dst, v0, v1);
            asm volatile("" ::: "memory");
        }
    }
    __device__ __forceinline__ void operator()(const accv (&acc)[2][2][4][2], const pg8::Unit& u, int wr, int wc, int fr, int fq) const {
        if (u.pm >= 16) body<1>(acc, u, wr, wc, fr, fq); else body<0>(acc, u, wr, wc, fr, fq);
    }
};
template <int ACT> struct EpiOut {
    static constexpr bool PERM = true, AFTER_DRAIN = false;
    bf16_t* O; int ldc; float* rsq_out; const float* rsq_in;
    __device__ __forceinline__ void operator()(const accv (&acc)[2][2][4][2], const pg8::Unit& u, int wr, int wc, int fr, int fq) const {
        const int pc = wc * 32 + 8 * fq;
        EPI_FOR_ROWS { const int row = EPI_ROW;
            float rstd = 1.f; if (ACT == 1) rstd = __builtin_amdgcn_rsqf(rsq_in[row] * (1.f / DM) + EPS);
#pragma unroll
            for (int bj = 0; bj < 2; ++bj) { accv v0 = acc[ai][bj][m][0], v1 = acc[ai][bj][m][1];
                if (ACT == 1) {
#pragma unroll
                    for (int e = 0; e < 4; ++e) { float a = fmaxf(v0[e] * rstd, 0.f); v0[e] = a * a; float c = fmaxf(v1[e] * rstd, 0.f); v1[e] = c * c; } }
                store8(O + (size_t)row * ldc + u.pn * 256 + bj * 128 + pc, v0, v1); }
        }
    }
};
struct EpiL1In {
    static constexpr bool PERM = true, AFTER_DRAIN = false;
    unsigned char* ws; const float* rsq;
    __device__ __forceinline__ void operator()(const accv (&acc)[2][2][4][2], const pg8::Unit& u, int wr, int wc, int fr, int fq) const {
        const int pn = u.pn, pc = wc * 32 + 8 * fq; const int g = pn / 12, qkv = (pn % 12) >> 2, sh = 2 * g;
        EPI_FOR_ROWS { const int row = EPI_ROW; const float rstd = __builtin_amdgcn_rsqf(rsq[row] * (1.f / DM) + EPS);
            const int b = row / SEQ, t = row % SEQ; const int tp = (t & ((1 << sh) - 1)) * (SEQ >> sh) + (t >> sh);
#pragma unroll
            for (int bj = 0; bj < 2; ++bj) { const accv v0 = acc[ai][bj][m][0] * rstd, v1 = acc[ai][bj][m][1] * rstd;
                const int head = 2 * (pn & 3) + bj;
                bf16_t* dst = (bf16_t*)(ws + A_Z1 + (size_t)(g * 3 + qkv) * 64 * MiB) + ((size_t)(b * 8 + head) * SEQ + tp) * 128;
                if (qkv < 2) rope_store(dst, pc, 64, v0, v1, (const float*)(ws + SM_ROPE_C) + t * 64, (const float*)(ws + SM_ROPE_S) + t * 64);
                else store8(dst + pc, v0, v1); }
        }
    }
};

#ifndef ONLY_G
#define ONLY_G -1
#endif
#ifndef MK_PHASE_HI
#define MK_PHASE_HI 99
#endif
#define GRID_SYNC() do { __threadfence(); grid.sync(); __builtin_amdgcn_fence(__ATOMIC_ACQUIRE, "agent"); asm volatile("s_waitcnt vmcnt(0)" ::: "memory"); __syncthreads(); } while (0)
template <class Epi> __device__ __forceinline__ void run_gemm(Ctx& C, const bf16_t* A, const bf16_t* Bt, int Mr, int N, int K, int lda, const Epi& E) {
    asm volatile("" : "+s"(K), "+s"(lda), "+s"(N), "+s"(Mr));
    pg8::Gemm g{A, Bt, Mr, N, K, lda}; pg8::StaticOrder S; S.init(Mr, N, C.G, (int)blockIdx.x);
    pg8::gemm_phase<Epi, pg8::StaticOrder, true, true>((LAS unsigned char*)C.lds, g, S, E);
}
using CfgW = fa::Cfg<128, 128, false, true, 128>;
using CfgM = fa::Cfg<192, 2048, true, false, 192>;

__global__ void __launch_bounds__(NTHREADS, 2) mega_fwd(Args args) {
    extern __shared__ __attribute__((aligned(16))) unsigned char lds[];
    cg::grid_group grid = cg::this_grid();
    Ctx C;
    C.out = args.out; C.ws = args.ws; C.lds = lds;
    ctx_refresh(C);
    C.G = gridDim.x; { const int bx = blockIdx.x; C.vcu = (C.G % 8 == 0) ? (bx % 8) * (C.G / 8) + bx / 8 : bx; }
    const int phase_hi = args.phase_hi;
    unsigned char* dout = (unsigned char*)args.out;
    using fa::bf16;

    prologue(C, args);
    GRID_SYNC();
    { EpiL0In E{C.ws, ROWSQ(RS_X)}; if constexpr (ONLY_G < 0 || ONLY_G == 0) run_gemm(C, WSP(bf16_t, A_HB), WSP(bf16_t, W_L0_WIN), MTOK, 3584, 2048, 2048, E); }
    GRID_SYNC();
    { EpiC1 E{WSP(bf16_t, A_HC), WSP(float, SM_CBIAS)}; if constexpr (ONLY_G < 0 || ONLY_G == 1) run_gemm(C, WSP(bf16_t, A_KV), WSP(bf16_t, W_C1), 8192, 256, 4096, 2048, E); }
    { EpiUQ E{C.ws, (bf16_t*)(dout + DO_MQ), (const unsigned long long*)ROWSQ(RS_CQ)}; if constexpr (ONLY_G < 0 || ONLY_G == 2) run_gemm(C, WSP(bf16_t, A_CQ), WSP(bf16_t, W_UQ), MTOK, 1536, 512, 512, E); }
    { EpiUKV E{(bf16_t*)(dout + DO_MK), (bf16_t*)(dout + DO_MV), (const unsigned long long*)ROWSQ(RS_CKV)}; if constexpr (ONLY_G < 0 || ONLY_G == 3) run_gemm(C, WSP(bf16_t, A_CKV), WSP(bf16_t, W_UKV), MTOK, 2048, 256, 256, E); }
    vst_phase(C);
#ifndef NO_WIN
    {
        const bf16* QN = WSP(bf16, A_QN); const bf16* KW = WSP(bf16, A_KV + 4 * 16 * MiB); const bf16* VW = WSP(bf16, A_KV + 5 * 16 * MiB); bf16* OW = WSP(bf16, A_OW);
        for (int L = C.vcu * 4; L < C.vcu * 4 + 4 && L < 1024; ++L) {
            const int bh = L >> 6, qb = L & 63, b = bh >> 3, h = bh & 7;
            fa::BlockRef r; r.Q = QN + ((size_t)bh * SEQ + qb * 256) * 128; r.K = KW + (size_t)(b * 2 + (h >> 2)) * SEQ * 128; r.V = VW + (size_t)(b * 2 + (h >> 2)) * SEQ * 128;
            r.KP = nullptr; r.O = OW + ((size_t)bh * SEQ + qb * 256) * 128; r.L = nullptr; r.P0 = qb * 256;
            fa::block_simple<CfgW>(r, SEQ, 512, (char*)lds);
        }
    }
#endif
    GRID_SYNC();
    { EpiC2 E{WSP(bf16_t, A_KCMP), WSP(bf16_t, A_VCMP)}; if constexpr (ONLY_G < 0 || ONLY_G == 4) run_gemm(C, WSP(bf16_t, A_HC), WSP(bf16_t, W_C2), 8192, 256, 256, 256, E); }
#ifndef NO_MLA
    {
        const bf16* MQ = (const bf16*)(dout + DO_MQ); const bf16* MK = (const bf16*)(dout + DO_MK); const bf16* MV = (const bf16*)(dout + DO_MV);
        const bf16* KPE = WSP(bf16, A_KPE); bf16* O = WSP(bf16, A_O);
        for (int L = C.vcu * 2; L < C.vcu * 2 + 2 && L < 512; ++L) {
            const int bh = L >> 5, x = L & 31, b = bh >> 3, h = bh & 7;
            for (int pass = 0; pass < 2; ++pass) { const int qb = pass ? 63 - x : x;
                fa::BlockRef r; r.Q = MQ + ((size_t)bh * SEQ + qb * 256) * 192; r.K = MK + (size_t)bh * SEQ * 128; r.V = MV + (size_t)bh * SEQ * 128;
                r.KP = KPE + (size_t)b * SEQ * 64; r.O = O + ((size_t)b * SEQ + qb * 256) * 2048 + 1024 + h * 128; r.L = nullptr; r.P0 = qb * 256;
                fa::block_simple<CfgM>(r, SEQ, 1 << 30, (char*)lds);
            }
        }
    }
#endif
    GRID_SYNC();
#ifndef NO_NSA
    {
        nsa::Tensors T; T.QN = WSP(bf16, A_QN); T.KC = WSP(bf16, A_KCMP); T.VC = WSP(bf16, A_VCMP); T.KS = WSP(bf16, A_KV + 2 * 16 * MiB); T.VST = WSP(bf16, A_VST);
        T.OW = WSP(bf16, A_OW); T.GATE = WSP(float, SM_GATE); T.O = WSP(bf16, A_O);
        const int bg = C.vcu >> 6, k = C.vcu & 63;
        if (bg < 4) {
            for (int i = 0; i < 4; ++i) { const int c = (i == 0) ? k : (i == 1) ? 127 - k : (i == 2) ? 128 + k : 255 - k;
                nsa::nsa_block(T, bg >> 1, bg & 1, c, (char*)lds); }
        }
    }
#endif
    GRID_SYNC();
    { EpiOut<0> E{WSP(bf16_t, A_MM), 2048, nullptr, nullptr}; if constexpr (ONLY_G < 0 || ONLY_G == 5) run_gemm(C, WSP(bf16_t, A_O), WSP(bf16_t, W_L0_WOUT), MTOK, 2048, 2048, 2048, E); }
    GRID_SYNC();
    postnorm_phase(C, args.in[0], WSP(bf16_t, A_MM), args.in[14], ROWSQ(RS_H1), true);
    GRID_SYNC();
    if (phase_hi <= 6) return;
    { EpiOut<1> E{WSP(bf16_t, A_HID), 8192, nullptr, ROWSQ(RS_H1)}; if constexpr (ONLY_G < 0 || ONLY_G == 6) run_gemm(C, WSP(bf16_t, A_HB), WSP(bf16_t, W_L0_FF1), MTOK, 8192, 2048, 2048, E); }
    GRID_SYNC();
    { EpiOut<0> E{WSP(bf16_t, A_F), 2048, nullptr, nullptr}; if constexpr (ONLY_G < 0 || ONLY_G == 7) run_gemm(C, WSP(bf16_t, A_HID), WSP(bf16_t, W_L0_FF2), MTOK, 2048, 8192, 8192, E); }
    GRID_SYNC();
    postnorm_phase(C, C.out, WSP(bf16_t, A_F), args.in[18], ROWSQ(RS_H2), true);
    GRID_SYNC();
    if (phase_hi <= 9) return;
    { EpiL1In E{C.ws, ROWSQ(RS_H2)}; if constexpr (ONLY_G < 0 || ONLY_G == 8) run_gemm(C, WSP(bf16_t, A_HB), WSP(bf16_t, W_L1_WIN), MTOK, 9216, 2048, 2048, E); }
    GRID_SYNC();
#ifndef NO_DIL
    {
        for (int g = 0; g < 3; ++g) {
            const int sh = 2 * g, slen = SEQ >> sh, nqb = slen >> 8;
            const bf16* Qg = WSP(bf16, A_Z1 + (size_t)(g * 3 + 0) * 64 * MiB); const bf16* Kg = WSP(bf16, A_Z1 + (size_t)(g * 3 + 1) * 64 * MiB); const bf16* Vg = WSP(bf16, A_Z1 + (size_t)(g * 3 + 2) * 64 * MiB);
            bf16* Og = (g == 0) ? WSP(bf16, A_OG0) : (g == 1) ? WSP(bf16, A_OG1) : WSP(bf16, A_OG2);
            float* Lg = WSP(float, SM_LSE) + (size_t)g * MTOK * 8;
            for (int L = C.vcu * 4; L < C.vcu * 4 + 4 && L < 1024; ++L) {
                const int bh = L >> 6, rest = L & 63, res = rest / nqb, qb = rest % nqb;
                const size_t seq0 = (size_t)bh * SEQ + (size_t)res * slen;
                fa::BlockRef r; r.Q = Qg + (seq0 + qb * 256) * 128; r.K = Kg + seq0 * 128; r.V = Vg + seq0 * 128; r.KP = nullptr;
                r.O = Og + (seq0 + qb * 256) * 128; r.L = Lg + seq0 + qb * 256; r.P0 = qb * 256;
                fa::block_simple<CfgW>(r, slen, 129, (char*)lds);
            }
        }
    }
#endif
    GRID_SYNC();
    dil_merge_phase(C);
    GRID_SYNC();
    { EpiOut<0> E{WSP(bf16_t, A_MM1), 2048, nullptr, nullptr}; if constexpr (ONLY_G < 0 || ONLY_G == 9) run_gemm(C, WSP(bf16_t, A_O1), WSP(bf16_t, W_L1_WOUT), MTOK, 2048, 1024, 1024, E); }
    GRID_SYNC();
    postnorm_phase(C, C.out, WSP(bf16_t, A_MM1), args.in[22], ROWSQ(RS_H3), true);
    GRID_SYNC();
    if (phase_hi <= 14) return;
    { EpiOut<1> E{WSP(bf16_t, A_HID), 8192, nullptr, ROWSQ(RS_H3)}; if constexpr (ONLY_G < 0 || ONLY_G == 10) run_gemm(C, WSP(bf16_t, A_HB), WSP(bf16_t, W_L1_FF1), MTOK, 8192, 2048, 2048, E); }
    GRID_SYNC();
    { EpiOut<0> E{WSP(bf16_t, A_F), 2048, nullptr, nullptr}; if constexpr (ONLY_G < 0 || ONLY_G == 11) run_gemm(C, WSP(bf16_t, A_HID), WSP(bf16_t, W_L1_FF2), MTOK, 2048, 8192, 8192, E); }
    GRID_SYNC();
    postnorm_phase(C, C.out, WSP(bf16_t, A_F), args.in[26], nullptr, false);
}

extern "C" void kernel_launch(void* const* d_in, const int* in_sizes, int n_in, void* d_out, int out_size, void* d_ws, size_t ws_size, hipStream_t stream) {
    static int grid = 0;
    if (grid == 0) {
        if (n_in != 27 || out_size != MTOK * DM || ws_size < 1024 * MiB) { fprintf(stderr, "kernel_launch: unexpected shapes (n_in %d out %d ws %zu)\n", n_in, out_size, ws_size); grid = -1; return; }
        int dev = 0, cus = 0, per_cu = 0;
        if (hipGetDevice(&dev) != hipSuccess || hipDeviceGetAttribute(&cus, hipDeviceAttributeMultiprocessorCount, dev) != hipSuccess) { grid = -1; return; }
        if (hipFuncSetAttribute((const void*)mega_fwd, hipFuncAttributeMaxDynamicSharedMemorySize, LDS_BYTES) != hipSuccess) { fprintf(stderr, "kernel_launch: hipFuncSetAttribute failed\n"); grid = -1; return; }
        if (hipOccupancyMaxActiveBlocksPerMultiprocessor(&per_cu, (const void*)mega_fwd, NTHREADS, LDS_BYTES) != hipSuccess || per_cu < 1) { fprintf(stderr, "kernel_launch: occupancy query says %d\n", per_cu); (void)hipGetLastError(); grid = -1; return; }
        grid = cus;
        if (grid != 256) fprintf(stderr, "kernel_launch: note: %d CUs\n", grid);
    }
    if (grid < 0) return;
    Args a{};
    for (int i = 0; i < 27; ++i) a.in[i] = (const float*)d_in[i];
    a.out = (float*)d_out; a.ws = (unsigned char*)d_ws; a.phase_hi = MK_PHASE_HI; a.pad = 0;
    void* kargs[] = {&a};
    hipError_t e = hipLaunchCooperativeKernel((const void*)mega_fwd, dim3(grid), dim3(NTHREADS), kargs, LDS_BYTES, stream);
    if (e != hipSuccess) fprintf(stderr, "kernel_launch: cooperative launch failed: %s\n", hipGetErrorString(e));
}
```

```cpp
#include <hip/hip_runtime.h>
#include <hip/hip_bf16.h>
#include <hip/hip_cooperative_groups.h>
#include <cstdio>
#include <cstdint>
namespace cg = cooperative_groups;
namespace pg8 {
#define PG8_LAS __attribute__((address_space(3)))
typedef unsigned short bf16_t;
typedef short bf16x8 __attribute__((ext_vector_type(8)));
typedef float f32x4 __attribute__((ext_vector_type(4)));
typedef unsigned u32x4 __attribute__((ext_vector_type(4)));
constexpr int BM = 256, BK = 64, HALF = 128, HTB = HALF * BK * 2  , STAGE_BYTES = 8 * HTB, NXCD = 8, WGM = 8;

__host__ __device__ __forceinline__ int lds_byte(int r, int c) { const int st = (r >> 4) * 2 + (c >> 5), rr = r & 15, cc = c & 31, ob = rr * 64 + cc * 2; return st * 1024 + (ob ^ (((ob >> 9) & 1) << 5)); }
__host__ __device__ __forceinline__ void stage_rc(int b, int& R, int& C) { const int st = b / 1024, sb = b % 1024, swz = sb ^ (((sb >> 9) & 1) << 5); R = (st >> 1) * 16 + swz / 64; C = (st & 1) * 32 + (swz % 64) / 2; }
__host__ __device__ __forceinline__ int perm32(int rho) { const int n = rho >> 4, i = rho & 15; return 8 * (i >> 2) + 4 * n + (i & 3); }

struct Unit { int pm, pn; };
struct Gemm { const bf16_t* A; const bf16_t* Bt; int M, N, K, lda; };

struct StaticOrder {
    int nM, nN, nwg, G, c;
    __host__ __device__ void init(int M, int N, int G_, int c_) { nM = M / BM; nN = N / BM; nwg = nM * nN; G = G_; c = c_; }
    __host__ __device__ bool next(int i, Unit& u) const {
        const long L = (long)i * G + c; if (L >= nwg) return false;
        int wgid = (int)L; { const int q = nwg / NXCD, r = nwg % NXCD, xcd = wgid % NXCD, off = wgid / NXCD; wgid = (xcd < r ? xcd * (q + 1) : r * (q + 1) + (xcd - r) * q) + off; }
        const int nig = WGM * nN, gid = wgid / nig, fm = gid * WGM, gsz = (nM - fm) < WGM ? (nM - fm) : WGM;
        u.pm = fm + ((wgid % nig) % gsz); u.pn = (wgid % nig) / gsz; return true;
    }
    __device__ __forceinline__ void a_ready(const Unit&) const {}
    __device__ __forceinline__ void done(const Unit&) const {}
};

template <class Epi, class Sched, bool ALIGN_EPI = false, bool SP2 = false>
__device__ __forceinline__ void gemm_phase(PG8_LAS unsigned char* lds, const Gemm g, const Sched& S, const Epi& E) {
    int tid_ = threadIdx.x; asm volatile("" : "+v"(tid_)); const int tid = tid_, wid = __builtin_amdgcn_readfirstlane(tid >> 6), lane = tid & 63, wr = wid >> 2, wc = wid & 3, fr = lane & 15, fq = lane >> 4;
    const int K = g.K, nt = K / BK;
    unsigned voffA[2], voffB[2];
#pragma unroll
    for (int i = 0; i < 2; ++i) { int R, C; stage_rc(tid * 16 + i * 8192, R, C); const int Rb = Epi::PERM ? ((R & ~31) + perm32(R & 31)) : R;
        voffA[i] = (unsigned)(R * g.lda + C) * 2u; voffB[i] = (unsigned)(Rb * K + C) * 2u; }
    const size_t kstep = (size_t)(BK * 2);
    const size_t hstepA = (size_t)HALF * g.lda * 2, hstepB = (size_t)HALF * K * 2;
    const size_t tstepA = 2 * hstepA, tstepB = 2 * hstepB;
    const unsigned ldsw = (unsigned)wid * 1024u;
    const int aoff = lds_byte(wr * 64 + fr, fq * 8), boff = lds_byte(wc * 32 + fr, fq * 8);
#define PG8_SA(b, h) (((b) * 2 + (h)) * HTB)
#define PG8_SB(b, h) ((4 + (b) * 2 + (h)) * HTB)
#define PG8_STAGE(bufoff, gbase, voff) do { _Pragma("unroll") for (int _i = 0; _i < 2; ++_i) \
        __builtin_amdgcn_global_load_lds((const unsigned*)((const char*)(gbase) + (voff)[_i]), (PG8_LAS unsigned*)(lds + (bufoff) + ldsw + _i * 8192), 16, 0, 0); } while (0)
#define PG8_LDA(dst, b, h) do { _Pragma("unroll") for (int m = 0; m < 4; ++m) _Pragma("unroll") for (int k = 0; k < 2; ++k) dst[m][k] = *(const PG8_LAS bf16x8*)(lds + PG8_SA(b, h) + aoff + m * 2048 + k * 1024); } while (0)
#define PG8_LDB(dst, b, h) do { _Pragma("unroll") for (int n = 0; n < 2; ++n) _Pragma("unroll") for (int k = 0; k < 2; ++k) dst[n][k] = *(const PG8_LAS bf16x8*)(lds + PG8_SB(b, h) + boff + n * 2048 + k * 1024); } while (0)
#define PG8_MMA(ai, bj, At, Bt) do { __builtin_amdgcn_s_setprio(1); _Pragma("unroll") for (int m = 0; m < 4; ++m) _Pragma("unroll") for (int n = 0; n < 2; ++n) _Pragma("unroll") for (int k = 0; k < 2; ++k) \
        acc[ai][bj][m][n] = __builtin_amdgcn_mfma_f32_16x16x32_bf16(Bt[n][k], At[m][k], acc[ai][bj][m][n], 0, 0, 0); __builtin_amdgcn_s_setprio(0); } while (0)
#define PG8_WAIT_V(n) asm volatile("s_waitcnt vmcnt(" #n ")" ::: "memory")
#define PG8_WAIT_L(n) asm volatile("s_waitcnt lgkmcnt(" #n ")" ::: "memory")
#define PG8_BAR __builtin_amdgcn_s_barrier()
#define PG8_SCHED __builtin_amdgcn_sched_barrier(0)
    Unit cur, nxt; int ui = 0;
    if (!S.next(0, cur)) return;
    f32x4 acc[2][2][4][2];
#pragma unroll
    for (int a = 0; a < 2; ++a)
#pragma unroll
        for (int b = 0; b < 2; ++b)
#pragma unroll
            for (int m = 0; m < 4; ++m)
#pragma unroll
                for (int n = 0; n < 2; ++n) acc[a][b][m][n] = (f32x4){0.f, 0.f, 0.f, 0.f};
    bf16x8 At[4][2], B0[2][2], B1[2][2];
    const char* cA = (const char*)g.A + (size_t)cur.pm * tstepA; const char* cB = (const char*)g.Bt + (size_t)cur.pn * tstepB;
    S.a_ready(cur);
    if constexpr (SP2) {
        PG8_STAGE(PG8_SB(0, 0), cB, voffB); PG8_STAGE(PG8_SB(0, 1), cB + hstepB, voffB); PG8_STAGE(PG8_SA(0, 0), cA, voffA); PG8_STAGE(PG8_SA(0, 1), cA + hstepA, voffA);
        if (wr == 1) PG8_BAR;
        PG8_WAIT_V(2); PG8_BAR;
        PG8_STAGE(PG8_SB(1, 0), cB + kstep, voffB); PG8_STAGE(PG8_SA(1, 0), cA + kstep, voffA); PG8_STAGE(PG8_SB(1, 1), cB + hstepB + kstep, voffB);
        PG8_WAIT_V(6); PG8_BAR;
    } else {
        PG8_STAGE(PG8_SB(0, 0), cB, voffB); PG8_STAGE(PG8_SA(0, 0), cA, voffA); PG8_STAGE(PG8_SB(0, 1), cB + hstepB, voffB); PG8_STAGE(PG8_SA(0, 1), cA + hstepA, voffA);
        if (wr == 1) PG8_BAR;
        PG8_WAIT_V(4); PG8_BAR;
        PG8_STAGE(PG8_SB(1, 0), cB + kstep, voffB); PG8_STAGE(PG8_SA(1, 0), cA + kstep, voffA); PG8_STAGE(PG8_SB(1, 1), cB + hstepB + kstep, voffB);
        PG8_WAIT_V(6); PG8_BAR;
    }
    for (;;) {
        const bool has_next = S.next(ui + 1, nxt);
        const char* nA = has_next ? (const char*)g.A + (size_t)nxt.pm * tstepA : cA; const char* nB = has_next ? (const char*)g.Bt + (size_t)nxt.pn * tstepB : cB;
        for (int t = 0; t < nt; t += 2) {
            const bool last = (t == nt - 2);
            const char* a1 = cA + (size_t)(t + 1) * kstep;
            const char* a2 = last ? nA : cA + (size_t)(t + 2) * kstep; const char* b2 = last ? nB : cB + (size_t)(t + 2) * kstep;
            const char* a3 = a2 + kstep; const char* b3 = b2 + kstep;
            if (last && has_next) S.a_ready(nxt);
            if constexpr (SP2) {
            PG8_LDB(B0, 0, 0); PG8_LDB(B1, 0, 1); PG8_SCHED; PG8_LDA(At, 0, 0); PG8_STAGE(PG8_SA(1, 1), a1 + hstepA, voffA);
            PG8_WAIT_V(8); PG8_WAIT_L(0); PG8_BAR; PG8_MMA(0, 0, At, B0); PG8_MMA(0, 1, At, B1); PG8_BAR; PG8_SCHED;
            PG8_LDA(At, 0, 1); PG8_STAGE(PG8_SB(0, 0), b2, voffB); PG8_STAGE(PG8_SB(0, 1), b2 + hstepB, voffB); PG8_STAGE(PG8_SA(0, 0), a2, voffA);
            PG8_WAIT_V(8); PG8_WAIT_L(0); PG8_BAR; PG8_MMA(1, 0, At, B0); PG8_MMA(1, 1, At, B1); PG8_BAR; PG8_SCHED;
            PG8_LDB(B0, 1, 0); PG8_LDB(B1, 1, 1); PG8_SCHED; PG8_LDA(At, 1, 0); PG8_STAGE(PG8_SA(0, 1), a2 + hstepA, voffA);
            PG8_WAIT_V(8); PG8_WAIT_L(0); PG8_BAR; PG8_MMA(0, 0, At, B0); PG8_MMA(0, 1, At, B1); PG8_BAR; PG8_SCHED;
            PG8_LDA(At, 1, 1); PG8_STAGE(PG8_SB(1, 0), b3, voffB); PG8_STAGE(PG8_SB(1, 1), b3 + hstepB, voffB); PG8_STAGE(PG8_SA(1, 0), a3, voffA);
            PG8_WAIT_V(8); PG8_WAIT_L(0); PG8_BAR; PG8_MMA(1, 0, At, B0); PG8_MMA(1, 1, At, B1); PG8_BAR; PG8_SCHED;
            } else {
            PG8_LDB(B0, 0, 0); PG8_SCHED; PG8_LDA(At, 0, 0); PG8_STAGE(PG8_SA(1, 1), a1 + hstepA, voffA);
            PG8_WAIT_L(8); PG8_BAR; PG8_WAIT_L(0); PG8_MMA(0, 0, At, B0); PG8_BAR; PG8_SCHED;
            PG8_LDB(B1, 0, 1); PG8_STAGE(PG8_SB(0, 0), b2, voffB);
            PG8_BAR; PG8_WAIT_L(0); PG8_MMA(0, 1, At, B1); PG8_BAR;
            PG8_LDA(At, 0, 1); PG8_STAGE(PG8_SA(0, 0), a2, voffA);
            PG8_BAR; PG8_WAIT_L(0); PG8_MMA(1, 0, At, B0); PG8_BAR; PG8_SCHED;
            PG8_STAGE(PG8_SB(0, 1), b2 + hstepB, voffB);
            PG8_WAIT_V(6); PG8_BAR; PG8_MMA(1, 1, At, B1); PG8_BAR;
            PG8_LDB(B0, 1, 0); PG8_SCHED; PG8_LDA(At, 1, 0); PG8_STAGE(PG8_SA(0, 1), a2 + hstepA, voffA);
            PG8_WAIT_L(8); PG8_BAR; PG8_WAIT_L(0); PG8_MMA(0, 0, At, B0); PG8_BAR; PG8_SCHED;
            PG8_LDB(B1, 1, 1); PG8_STAGE(PG8_SB(1, 0), b3, voffB);
            PG8_BAR; PG8_WAIT_L(0); PG8_MMA(0, 1, At, B1); PG8_BAR;
            PG8_LDA(At, 1, 1); PG8_STAGE(PG8_SA(1, 0), a3, voffA);
            PG8_BAR; PG8_WAIT_L(0); PG8_MMA(1, 0, At, B0); PG8_BAR; PG8_SCHED;
            PG8_STAGE(PG8_SB(1, 1), b3 + hstepB, voffB);
            PG8_WAIT_V(6); PG8_BAR; PG8_MMA(1, 1, At, B1); PG8_BAR;
            }
        }
        if constexpr (ALIGN_EPI) { if (wr == 0) PG8_BAR; }
        if constexpr (!Epi::AFTER_DRAIN) { E(acc, cur, wr, wc, fr, fq); S.done(cur); }
        if (!has_next) break;
#pragma unroll
        for (int a = 0; a < 2; ++a)
#pragma unroll
            for (int b = 0; b < 2; ++b)
#pragma unroll
                for (int m = 0; m < 4; ++m)
#pragma unroll
                    for (int n = 0; n < 2; ++n) acc[a][b][m][n] = (f32x4){0.f, 0.f, 0.f, 0.f};
        cur = nxt; cA = nA; cB = nB; ++ui;
        if constexpr (ALIGN_EPI) { if (wr == 1) PG8_BAR; }
    }
    PG8_WAIT_V(0);
    if constexpr (!ALIGN_EPI) { if (wr == 0) PG8_BAR; }
    PG8_BAR;
    if constexpr (Epi::AFTER_DRAIN) { E.fused(acc, cur, wr, wc, fr, fq, lds, wid, lane); S.done(cur); }
#undef PG8_SA
#undef PG8_SB
#undef PG8_STAGE
#undef PG8_LDA
#undef PG8_LDB
#undef PG8_MMA
#undef PG8_WAIT_V
#undef PG8_WAIT_L
#undef PG8_BAR
#undef PG8_SCHED
}
}

namespace fa {
constexpr int D = 128;
constexpr int NW = 8, QBLK = 32, KVBLK = 64, QB = NW * QBLK;
constexpr int SHM_V = KVBLK * D * 2, SHM_K = KVBLK * D * 2, SHM_KP = KVBLK * 64 * 2;
constexpr int LDS_WS = 2 * SHM_V + 2 * SHM_K;
constexpr int LDS_KP = LDS_WS + NW * 64 * 4;
constexpr int LDS_BYTES = LDS_KP + 2 * SHM_KP;
constexpr float THR = 8.f;

using bf16 = __hip_bfloat16;
typedef short bf16x8 __attribute__((ext_vector_type(8)));
typedef short s16x4 __attribute__((ext_vector_type(4)));
typedef float f32x16 __attribute__((ext_vector_type(16)));
typedef float f32x4 __attribute__((ext_vector_type(4)));
typedef unsigned u32x4 __attribute__((ext_vector_type(4)));

#define KSWZ(row, colB) ((row) * 256 + ((colB) ^ (((row) & 7) << 4)))
#define KPSWZ(row, colB) ((row) * 128 + ((colB) ^ (((row) & 7) << 4)))
#define SBAR() __builtin_amdgcn_sched_barrier(0)
__device__ __forceinline__ int v_st(int k, int c) { const int kk = (k & ~0xC) | ((k & 4) << 1) | ((k & 8) >> 1); return ((kk >> 3) * 4 + (c >> 5)) * 512 + ((kk & 7) * 32 + (c & 31)) * 2; }
__device__ __forceinline__ int v_rd_base(int lane) { return ((lane & 3) << 3) | (((lane >> 2) & 3) << 6) | (((lane >> 4) & 1) << 5) | (((lane >> 5) & 1) << 8); }
constexpr int v_rd_off(int d0, int ks, int half) { return d0 * 512 + ks * 4096 + half * 2048; }
__device__ __forceinline__ int crow(int r, int hi) { return (r & 3) + 8 * (r >> 2) + 4 * hi; }
__device__ __forceinline__ unsigned cvtpk(float lo, float hi) {
    unsigned r; asm volatile("v_cvt_pk_bf16_f32 %0, %1, %2" : "=v"(r) : "v"(lo), "v"(hi)); return r;
}
__device__ __forceinline__ bf16x8 load8(const bf16* p) { return *reinterpret_cast<const bf16x8*>(p); }
__device__ __forceinline__ void mask_tile(f32x16& p0, f32x16& p1, int dq, unsigned W) {
    const float NEG = -__builtin_inff();
#pragma unroll
    for (int r = 0; r < 16; ++r) {
        const int c = (r & 3) + 8 * (r >> 2);
        if ((unsigned)(dq - c) >= W) p0[r] = NEG;
        if ((unsigned)(dq - c - 32) >= W) p1[r] = NEG;
    }
}
template <class C>
__device__ __forceinline__ void partialSM(f32x16& p0, f32x16& p1, float& m_reg, float& mn, float& alpha) {
    float pmax = p0[0]; for (int r = 1; r < 16; ++r) pmax = fmaxf(pmax, p0[r]); for (int r = 0; r < 16; ++r) pmax = fmaxf(pmax, p1[r]);
    { auto rr = __builtin_amdgcn_permlane32_swap(__float_as_uint(pmax), __float_as_uint(pmax), false, false);
      pmax = fmaxf(__uint_as_float(rr[0]), __uint_as_float(rr[1])); }
    constexpr float C2 = 1.4426950408889634f * C::SCALE;
    if (__builtin_expect(__all((pmax - m_reg) * C::SCALE <= THR), 1)) { mn = m_reg; alpha = 1.f; }
    else { mn = fmaxf(m_reg, pmax); alpha = __builtin_amdgcn_exp2f((m_reg - mn) * C2); m_reg = mn; }
    const float mnL = -mn * C2;
    for (int r = 0; r < 16; ++r) p0[r] = fmaf(p0[r], C2, mnL); for (int r = 0; r < 16; ++r) p1[r] = fmaf(p1[r], C2, mnL);
    for (int r = 0; r < 16; ++r) p0[r] = __builtin_amdgcn_exp2f(p0[r]);
}
#define FA_PK4(P, B_, OUT) do { unsigned a0 = cvtpk(P[B_+0], P[B_+1]), a1 = cvtpk(P[B_+2], P[B_+3]);                          \
        unsigned b0 = cvtpk(P[B_+4], P[B_+5]), b1 = cvtpk(P[B_+6], P[B_+7]);                                             \
        auto r0 = __builtin_amdgcn_permlane32_swap(a0, b0, false, false); auto r1 = __builtin_amdgcn_permlane32_swap(a1, b1, false, false); \
        u32x4 w = {r0[0], r1[0], r0[1], r1[1]}; OUT = *reinterpret_cast<bf16x8*>(&w); } while (0)
__device__ __forceinline__ void finishSM(f32x16& p0, f32x16& p1, float alpha, float& l_reg, bf16x8& pa0, bf16x8& pa1, bf16x8& pa2, bf16x8& pa3) {
    for (int r = 0; r < 16; ++r) p1[r] = __builtin_amdgcn_exp2f(p1[r]);
    float ps = 0; for (int r = 0; r < 16; ++r) ps += p0[r]; for (int r = 0; r < 16; ++r) ps += p1[r];
    { auto rr = __builtin_amdgcn_permlane32_swap(__float_as_uint(ps), __float_as_uint(ps), false, false);
      ps = __uint_as_float(rr[0]) + __uint_as_float(rr[1]); }
    l_reg = l_reg * alpha + ps;
    FA_PK4(p0, 0, pa0); FA_PK4(p0, 8, pa1); FA_PK4(p1, 0, pa2); FA_PK4(p1, 8, pa3);
}
__device__ __forceinline__ void packP(f32x16& p0, f32x16& p1, bf16x8& pa0, bf16x8& pa1, bf16x8& pa2, bf16x8& pa3) {
    FA_PK4(p0, 0, pa0); FA_PK4(p0, 8, pa1); FA_PK4(p1, 0, pa2); FA_PK4(p1, 8, pa3);
}
template <int KB, bool SK, bool PE>
__device__ __forceinline__ void qkt(f32x16& p0, f32x16& p1, const char* K_lds, const char* KP_lds, int r32, int hi, const bf16x8* qr, bool act) {
    if (SK && !act) { const float NEG = -__builtin_inff();
#pragma unroll
        for (int r = 0; r < 16; ++r) { p0[r] = NEG; p1[r] = NEG; } return; }
    p0 = f32x16{}; p1 = f32x16{};
    const char* kb[4];
#pragma unroll
    for (int dd = 0; dd < 4; ++dd) kb[dd] = K_lds + KB * SHM_K + KSWZ(r32, (dd * 16 + hi * 8) * 2);
#pragma unroll
    for (int d0 = 0; d0 < 8; ++d0) { const char* a = kb[d0 & 3] + (d0 >> 2) * 128;
        bf16x8 b0 = *reinterpret_cast<const bf16x8*>(a);
        bf16x8 b1 = *reinterpret_cast<const bf16x8*>(a + 32 * 256);
        p0 = __builtin_amdgcn_mfma_f32_32x32x16_bf16(b0, qr[d0], p0, 0, 0, 0);
        p1 = __builtin_amdgcn_mfma_f32_32x32x16_bf16(b1, qr[d0], p1, 0, 0, 0); }
    if constexpr (PE) {
#pragma unroll
        for (int d0 = 0; d0 < 4; ++d0) { const char* a = KP_lds + KB * SHM_KP + KPSWZ(r32, (d0 * 16 + hi * 8) * 2);
            bf16x8 b0 = *reinterpret_cast<const bf16x8*>(a);
            bf16x8 b1 = *reinterpret_cast<const bf16x8*>(a + 32 * 128);
            p0 = __builtin_amdgcn_mfma_f32_32x32x16_bf16(b0, qr[8 + d0], p0, 0, 0, 0);
            p1 = __builtin_amdgcn_mfma_f32_32x32x16_bf16(b1, qr[8 + d0], p1, 0, 0, 0); }
    }
}
template <int VB, bool SK>
__device__ __forceinline__ void pv_tile(f32x16* o, int vb0, bf16x8 pa0, bf16x8 pa1, bf16x8 pa2, bf16x8 pa3, bool act) {
    if (SK && !act) return;
#define TRRD(dst, off) asm volatile("ds_read_b64_tr_b16 %0, %1 offset:%2" : "=&v"(dst) : "v"(vb0), "i"(off) : "memory")
#define PV_D0(d0) do { s16x4 l0, l1, l2, l3, h0, h1, h2, h3; constexpr int b_ = VB * SHM_V + v_rd_off(d0, 0, 0);     \
        TRRD(l0, b_); TRRD(h0, b_ + 2048); TRRD(l1, b_ + 4096); TRRD(h1, b_ + 6144); TRRD(l2, b_ + 8192); TRRD(h2, b_ + 10240); TRRD(l3, b_ + 12288); TRRD(h3, b_ + 14336); \
        asm volatile("s_waitcnt lgkmcnt(0)" ::: "memory"); SBAR();   \
        o[d0] = __builtin_amdgcn_mfma_f32_32x32x16_bf16(pa0, (bf16x8){l0[0], l0[1], l0[2], l0[3], h0[0], h0[1], h0[2], h0[3]}, o[d0], 0, 0, 0);   \
        o[d0] = __builtin_amdgcn_mfma_f32_32x32x16_bf16(pa1, (bf16x8){l1[0], l1[1], l1[2], l1[3], h1[0], h1[1], h1[2], h1[3]}, o[d0], 0, 0, 0);   \
        o[d0] = __builtin_amdgcn_mfma_f32_32x32x16_bf16(pa2, (bf16x8){l2[0], l2[1], l2[2], l2[3], h2[0], h2[1], h2[2], h2[3]}, o[d0], 0, 0, 0);   \
        o[d0] = __builtin_amdgcn_mfma_f32_32x32x16_bf16(pa3, (bf16x8){l3[0], l3[1], l3[2], l3[3], h3[0], h3[1], h3[2], h3[3]}, o[d0], 0, 0, 0); } while (0)
    PV_D0(0); PV_D0(1); PV_D0(2); PV_D0(3);
#undef PV_D0
#undef TRRD
}

template <int QS_, int OS_, bool PE_, bool SK_, int SCALE_NUM> struct Cfg {
    static constexpr int QS = QS_, OS = OS_; static constexpr bool PE = PE_, SK = SK_;
    static constexpr float SCALE = SCALE_NUM == 128 ? 0.08838834764831845f : 0.07216878364870323f;
    static constexpr int NQ = PE_ ? 12 : 8;
};
struct BlockRef { const bf16* Q; const bf16* K; const bf16* V; const bf16* KP; bf16* O; float* L; int P0; };
template <class C> struct Seam { bf16x8 qr[C::NQ]; bf16x8 st_v0, st_v1, st_k0, st_k1, st_p; };
__device__ __forceinline__ int swa_jlo(int P0, int W) { const int lowk = P0 - W + 1; return lowk > 0 ? lowk / KVBLK : 0; }
#define ROW(p, k0, rr) ((p) + (size_t)((k0) + (rr)) * D + sc)
#define VMW() asm volatile("s_waitcnt vmcnt(0)" ::: "memory")
#define VMWN(n) asm volatile("s_waitcnt vmcnt(%0)" :: "i"(n) : "memory")
#define SLOAD_H(Kp, Vp, KPp, k0) do { S.st_v0 = load8(ROW(Vp, k0, sr)); S.st_v1 = load8(ROW(Vp, k0, 32 + sr));              \
                         S.st_k0 = load8(ROW(Kp, k0, sr)); S.st_k1 = load8(ROW(Kp, k0, 32 + sr));                           \
                         if constexpr (C::PE) S.st_p = load8((KPp) + (size_t)((k0) + pr) * 64 + pc); } while (0)
#define SWRITE_HK(bf) do { *(bf16x8*)(K_lds + (bf) * SHM_K + kws) = S.st_k0; *(bf16x8*)(K_lds + (bf) * SHM_K + kws + 32 * 256) = S.st_k1; \
                           if constexpr (C::PE) *(bf16x8*)(KP_lds + (bf) * SHM_KP + pws) = S.st_p; } while (0)
#define SWRITE_HV(bf) do { *(bf16x8*)(V_lds + (bf) * SHM_V + vst0) = S.st_v0; *(bf16x8*)(V_lds + (bf) * SHM_V + vst1) = S.st_v1; } while (0)
#define SWRITE_H(bf) do { SWRITE_HV(bf); SWRITE_HK(bf); } while (0)
#define QLOADS(ref) do { _Pragma("unroll") for (int d0 = 0; d0 < 8; ++d0) S.qr[d0] = load8((ref).Q + (size_t)(wid * QBLK + r32) * C::QS + d0 * 16 + hi * 8); \
        if constexpr (C::PE) { _Pragma("unroll") for (int d0 = 0; d0 < 4; ++d0) S.qr[8 + d0] = load8((ref).Q + (size_t)(wid * QBLK + r32) * C::QS + 128 + d0 * 16 + hi * 8); } } while (0)
template <class C>
__device__ __forceinline__ void prime(const BlockRef& cur, int W, char* lds, Seam<C>& S) {
    int tid_ = threadIdx.x; asm volatile("" : "+v"(tid_)); const int tid = tid_, wid = __builtin_amdgcn_readfirstlane(tid >> 6), lane = tid & 63, r32 = lane & 31, hi = lane >> 5;
    const int sr = tid >> 4, sc = (tid & 15) * 8, kws = KSWZ(sr, sc * 2); char* K_lds = lds + 2 * SHM_V; char* KP_lds = lds + LDS_KP;
    const int pr = tid >> 3, pc = (tid & 7) * 8, pws = KPSWZ(pr, pc * 2);
    const int kb0 = swa_jlo(cur.P0, W) * KVBLK;
    QLOADS(cur);
    SLOAD_H(cur.K, cur.V, cur.KP, kb0); VMW(); SWRITE_HK(0);
    __syncthreads();
}
template <class C>
__device__ __forceinline__ void block(const BlockRef& cur, const BlockRef& nxt, int skv, int W, char* lds, Seam<C>& S) {
    constexpr bool SK = C::SK, PE = C::PE;
    int tid_ = threadIdx.x; asm volatile("" : "+v"(tid_)); const int tid = tid_, wid = __builtin_amdgcn_readfirstlane(tid >> 6), lane = tid & 63, r32 = lane & 31, hi = lane >> 5;
    const int j_lo = swa_jlo(cur.P0, W);
    int j_hi = (cur.P0 + QB - 1) / KVBLK + 1; if (j_hi > skv / KVBLK) j_hi = skv / KVBLK;
    const int NT = j_hi - j_lo;
    const int kbn = swa_jlo(nxt.P0, W) * KVBLK;
    const int qlo = cur.P0 + wid * QBLK, qm = qlo + r32 - 4 * hi;
    char* V_lds = lds; char* K_lds = lds + 2 * SHM_V; char* KP_lds = lds + LDS_KP;
    float* ws = (float*)(lds + LDS_WS) + wid * 64; float* li_l = ws, * al_l = ws + 32;
    float m_reg = -1e30f, l_reg = 0; f32x16 o[4] = {};
    const int sr = tid >> 4, sc = (tid & 15) * 8, vst0 = v_st(sr, sc), vst1 = v_st(32 + sr, sc), kws = KSWZ(sr, sc * 2);
    const int pr = tid >> 3, pc = (tid & 7) * 8, pws = KPSWZ(pr, pc * 2);
    const int vb0 = (int)(uintptr_t)V_lds + v_rd_base(lane);
    const bf16* Kh = cur.K; const bf16* Vh = cur.V; const bf16* KPh = cur.KP;
#define RESC(a) do { if (__any((a) < 1.f)) { if (hi == 0) al_l[r32] = (a); asm volatile("s_waitcnt lgkmcnt(0)" ::: "memory");              \
                     for (int d_ = 0; d_ < 4; ++d_) for (int r = 0; r < 16; ++r) o[d_][r] *= al_l[crow(r, hi)]; } } while (0)
#define KBASE(t) ((j_lo + (t)) * KVBLK)
#define ACT(t) (KBASE(t) <= qlo + QBLK - 1 && KBASE(t) + KVBLK - 1 >= qlo - W + 1)
#define MASKT(P0_, P1_, t) do { const int kb_ = KBASE(t); if ((!SK || ACT(t)) && (kb_ + KVBLK - 1 > qlo || kb_ <= qlo + QBLK - 1 - W)) mask_tile(P0_, P1_, qm - kb_, (unsigned)W); } while (0)
    constexpr int NQL = C::NQ;
#define SEAM_K0() do { VMWN(NQL); SWRITE_HK(0); SBAR(); } while (0)
    f32x16 pA0, pA1, pB0, pB1; float mnA, mnB, alA, alB; bf16x8 pa0, pa1, pa2, pa3;
    SWRITE_HV(0); SBAR();
    if (NT > 1) { SLOAD_H(Kh, Vh, KPh, KBASE(1)); }
    SBAR(); qkt<0, SK, PE>(pA0, pA1, K_lds, KP_lds, r32, hi, S.qr, ACT(0));
    MASKT(pA0, pA1, 0); partialSM<C>(pA0, pA1, m_reg, mnA, alA);
    if (NT > 1) { VMW(); SWRITE_H(1); }
    __syncthreads();
#define HALF_STEP(PX0, PX1, mnX, alX, PY0, PY1, alY, t, KB, VB, SB) do {                                                      \
        SBAR(); qkt<KB, SK, PE>(PX0, PX1, K_lds, KP_lds, r32, hi, S.qr, ACT(t));                                             \
        finishSM(PY0, PY1, alY, l_reg, pa0, pa1, pa2, pa3); SBAR();                                                           \
        if ((t) + 1 < NT) { SLOAD_H(Kh, Vh, KPh, KBASE((t) + 1)); SBAR(); }                                               \
        pv_tile<VB, SK>(o, vb0, pa0, pa1, pa2, pa3, ACT((t) - 1)); MASKT(PX0, PX1, (t)); partialSM<C>(PX0, PX1, m_reg, mnX, alX);                                        \
        __syncthreads();                                                                                                      \
        if ((t) + 1 < NT) { VMW(); SWRITE_H(SB); }                                                                          \
        RESC(alX); __syncthreads(); } while (0)
    for (int t = 1; t + 1 < NT; t += 2) {
        HALF_STEP(pB0, pB1, mnB, alB, pA0, pA1, alA, t, 1, 0, 0);
        HALF_STEP(pA0, pA1, mnA, alA, pB0, pB1, alB, t + 1, 0, 1, 1);
    }
    const bool even = (NT & 1) == 0;
    if (even) { SBAR(); qkt<1, SK, PE>(pB0, pB1, K_lds, KP_lds, r32, hi, S.qr, ACT(NT - 1)); SBAR(); }
    SLOAD_H(nxt.K, nxt.V, nxt.KP, kbn); SBAR();
    QLOADS(nxt);
    SBAR();
    finishSM(pA0, pA1, alA, l_reg, pa0, pa1, pa2, pa3); SBAR();
    pv_tile<0, SK>(o, vb0, pa0, pa1, pa2, pa3, ACT(even ? NT - 2 : NT - 1));
    if (even) { MASKT(pB0, pB1, NT - 1); partialSM<C>(pB0, pB1, m_reg, mnB, alB); __syncthreads(); RESC(alB);
        finishSM(pB0, pB1, alB, l_reg, pa0, pa1, pa2, pa3); SBAR(); pv_tile<1, SK>(o, vb0, pa0, pa1, pa2, pa3, ACT(NT - 1)); }
    SBAR(); SEAM_K0();
    if (hi == 0) li_l[r32] = l_reg; asm volatile("s_waitcnt lgkmcnt(0)" ::: "memory");
    if (cur.L != nullptr && hi == 0) cur.L[wid * QBLK + r32] = m_reg * C::SCALE + __logf(l_reg);
    float rli[16];
#pragma unroll
    for (int r = 0; r < 16; ++r) rli[r] = __builtin_amdgcn_rcpf(li_l[crow(r, hi)]);
    bf16* Ow = cur.O + (size_t)(wid * QBLK) * C::OS;
#pragma unroll
    for (int r = 0; r < 16; ++r) { const int orow = crow(r, hi);
#pragma unroll
        for (int d0 = 0; d0 < 4; ++d0) { const float v = o[d0][r] * rli[r];
            const float vn = __shfl_xor(v, 1);
            if ((r32 & 1) == 0) *(unsigned*)(Ow + (size_t)orow * C::OS + d0 * 32 + r32) = cvtpk(v, vn); } }
    __syncthreads();
#undef RESC
#undef KBASE
#undef ACT
#undef MASKT
#undef SEAM_K0
#undef HALF_STEP
}

template <class C>
__device__ __forceinline__ void block_simple(const BlockRef& cur, int skv, int W, char* lds) {
    constexpr bool SK = C::SK, PE = C::PE;
    Seam<C> S;
    int tid_ = threadIdx.x; asm volatile("" : "+v"(tid_)); const int tid = tid_, wid = __builtin_amdgcn_readfirstlane(tid >> 6), lane = tid & 63, r32 = lane & 31, hi = lane >> 5;
    const int j_lo = swa_jlo(cur.P0, W);
    int j_hi = (cur.P0 + QB - 1) / KVBLK + 1; if (j_hi > skv / KVBLK) j_hi = skv / KVBLK;
    const int NT = j_hi - j_lo;
    const int qlo = cur.P0 + wid * QBLK, qm = qlo + r32 - 4 * hi;
    char* V_lds = lds; char* K_lds = lds + 2 * SHM_V; char* KP_lds = lds + LDS_KP;
    float* ws = (float*)(lds + LDS_WS) + wid * 64; float* li_l = ws, * al_l = ws + 32;
    float m_reg = -1e30f, l_reg = 0; f32x16 o[4] = {};
    const int sr = tid >> 4, sc = (tid & 15) * 8, vst0 = v_st(sr, sc), vst1 = v_st(32 + sr, sc), kws = KSWZ(sr, sc * 2);
    const int pr = tid >> 3, pc = (tid & 7) * 8, pws = KPSWZ(pr, pc * 2);
    const int vb0 = (int)(uintptr_t)V_lds + v_rd_base(lane);
    const bf16* Kh = cur.K; const bf16* Vh = cur.V; const bf16* KPh = cur.KP;
#define KBASE(t) ((j_lo + (t)) * KVBLK)
#define ACT(t) (KBASE(t) <= qlo + QBLK - 1 && KBASE(t) + KVBLK - 1 >= qlo - W + 1)
#define MASKT(P0_, P1_, t) do { const int kb_ = KBASE(t); if ((!SK || ACT(t)) && (kb_ + KVBLK - 1 > qlo || kb_ <= qlo + QBLK - 1 - W)) mask_tile(P0_, P1_, qm - kb_, (unsigned)W); } while (0)
#define RESC(a) do { if (__any((a) < 1.f)) { if (hi == 0) al_l[r32] = (a); asm volatile("s_waitcnt lgkmcnt(0)" ::: "memory");              \
                     for (int d_ = 0; d_ < 4; ++d_) for (int r = 0; r < 16; ++r) o[d_][r] *= al_l[crow(r, hi)]; } } while (0)
    QLOADS(cur);
    SLOAD_H(Kh, Vh, KPh, KBASE(0)); VMW(); SWRITE_H(0);
    __syncthreads();
    f32x16 p0, p1; float mn, al; bf16x8 pa0, pa1, pa2, pa3;
#define STEP(t, BUF) do { \
        if ((t) + 1 < NT) { SLOAD_H(Kh, Vh, KPh, KBASE((t) + 1)); SBAR(); } \
        qkt<BUF, SK, PE>(p0, p1, K_lds, KP_lds, r32, hi, S.qr, ACT(t)); \
        MASKT(p0, p1, (t)); partialSM<C>(p0, p1, m_reg, mn, al); finishSM(p0, p1, al, l_reg, pa0, pa1, pa2, pa3); RESC(al); SBAR(); \
        pv_tile<BUF, SK>(o, vb0, pa0, pa1, pa2, pa3, ACT(t)); \
        if ((t) + 1 < NT) { VMW(); SWRITE_H(1 - BUF); } \
        __syncthreads(); } while (0)
    for (int t = 0; t < NT; t += 2) {
        STEP(t, 0);
        if (t + 1 < NT) STEP(t + 1, 1);
    }
#undef STEP
    if (hi == 0) li_l[r32] = l_reg; asm volatile("s_waitcnt lgkmcnt(0)" ::: "memory");
    if (cur.L != nullptr && hi == 0) cur.L[wid * QBLK + r32] = m_reg * C::SCALE + __logf(l_reg);
    float rli[16];
#pragma unroll
    for (int r = 0; r < 16; ++r) rli[r] = __builtin_amdgcn_rcpf(li_l[crow(r, hi)]);
    bf16* Ow = cur.O + (size_t)(wid * QBLK) * C::OS;
#pragma unroll
    for (int r = 0; r < 16; ++r) { const int orow = crow(r, hi);
#pragma unroll
        for (int d0 = 0; d0 < 4; ++d0) { const float v = o[d0][r] * rli[r];
            const float vn = __shfl_xor(v, 1);
            if ((r32 & 1) == 0) *(unsigned*)(Ow + (size_t)orow * C::OS + d0 * 32 + r32) = cvtpk(v, vn); } }
    __syncthreads();
#undef RESC
#undef KBASE
#undef ACT
#undef MASKT
}
#undef ROW
#undef VMW
#undef VMWN
#undef SLOAD_H
#undef SWRITE_HK
#undef SWRITE_HV
#undef SWRITE_H
#undef QLOADS
}
constexpr int BATCH = 2, SEQ = 16384, DM = 2048, MTOK = BATCH * SEQ, DFF = 8192;
constexpr float EPS = 1e-6f;
constexpr int NWAVES = 8, NTHREADS = 512;
constexpr int LDS_BYTES = 159744;
constexpr size_t MiB = 1u << 20;
typedef unsigned short bf16_t;
typedef float f32x4 __attribute__((ext_vector_type(4)));
typedef unsigned u32x4 __attribute__((ext_vector_type(4)));
typedef unsigned u32x2 __attribute__((ext_vector_type(2)));

constexpr size_t W_L1_WIN = 0;
constexpr size_t W_L1_WOUT = W_L1_WIN + (size_t)9216 * 2048 * 2;
constexpr size_t W_L1_FF1 = W_L1_WOUT + (size_t)2048 * 1024 * 2;
constexpr size_t W_L1_FF2 = W_L1_FF1 + (size_t)8192 * 2048 * 2;
constexpr size_t W_L0_WIN = W_L1_FF2 + (size_t)2048 * 8192 * 2;
constexpr size_t W_L0_WOUT = W_L0_WIN + (size_t)3584 * 2048 * 2;
constexpr size_t W_L0_FF1 = W_L0_WOUT + (size_t)2048 * 2048 * 2;
constexpr size_t W_L0_FF2 = W_L0_FF1 + (size_t)8192 * 2048 * 2;
constexpr size_t W_UQ = W_L0_FF2 + (size_t)2048 * 8192 * 2;
constexpr size_t W_UKV = W_UQ + (size_t)1536 * 512 * 2;
constexpr size_t W_C1 = W_UKV + (size_t)2048 * 256 * 2;
constexpr size_t W_C2 = W_C1 + (size_t)256 * 4096 * 2;
constexpr size_t W_END = W_C2 + (size_t)256 * 256 * 2;
constexpr size_t SM_BASE = 196 * MiB;
static_assert(W_END <= SM_BASE, "weights");
constexpr size_t SM_ROPE_C = SM_BASE;
constexpr size_t SM_ROPE_S = SM_ROPE_C + (size_t)SEQ * 64 * 4;
constexpr size_t SM_ROPE2_C = SM_ROPE_S + (size_t)SEQ * 64 * 4;
constexpr size_t SM_ROPE2_S = SM_ROPE2_C + (size_t)SEQ * 32 * 4;
constexpr size_t SM_ROWSQ = SM_ROPE2_S + (size_t)SEQ * 32 * 4;
enum { RS_X = 0, RS_H1, RS_H2, RS_H3, RS_CQ = 4  , RS_CKV = 6  , RS_N = 8 };
constexpr size_t SM_CBIAS = SM_ROWSQ + (size_t)RS_N * MTOK * 4;
constexpr size_t SM_GATE = SM_CBIAS + 1024;
constexpr size_t SM_LSE = SM_GATE + (size_t)MTOK * 24 * 4;
constexpr size_t SM_END = SM_LSE + (size_t)3 * MTOK * 8 * 4;
constexpr size_t ACT_BASE = 216 * MiB;
static_assert(SM_END <= ACT_BASE, "small");
constexpr size_t A_HB = ACT_BASE;
constexpr size_t A_QN = A_HB + 128 * MiB;
constexpr size_t A_KV = A_QN + 64 * MiB;
constexpr size_t A_KVPAD = A_KV + 96 * MiB;
constexpr size_t A_VST = A_KVPAD + 1 * MiB;
constexpr size_t A_CQ = A_VST + 16 * MiB;
constexpr size_t A_CKV = A_CQ + 32 * MiB;
constexpr size_t A_KPE = A_CKV + 16 * MiB;
constexpr size_t A_HC = A_KPE + 4 * MiB;
constexpr size_t A_KCMP = A_HC + 4 * MiB;
constexpr size_t A_VCMP = A_KCMP + 1 * MiB;
constexpr size_t A_OW = A_VCMP + 1 * MiB;
constexpr size_t A_O = A_OW + 64 * MiB;
constexpr size_t A_MM = A_O + 128 * MiB;
constexpr size_t A_OP = A_MM + 128 * MiB;
constexpr size_t A_KST = A_OP + 64 * MiB;
constexpr size_t A_L0_END = A_KST + 16 * MiB;
static_assert(A_L0_END <= 1024 * MiB, "layer-0 map");
constexpr size_t DO_MQ = 0, DO_MK = 96 * MiB, DO_MV = 160 * MiB;
constexpr size_t A_F = A_HB + 128 * MiB;
constexpr size_t A_HID = A_F + 128 * MiB;
static_assert(A_HID + 512 * MiB <= 1024 * MiB, "ffn map");
constexpr size_t A_Z1 = A_HB + 128 * MiB;
constexpr size_t A_OG0 = A_Z1 + 576 * MiB;
constexpr size_t A_OG1 = W_L0_WIN;
constexpr size_t A_OG2 = A_HB;
static_assert(A_OG0 + 64 * MiB <= 1024 * MiB && A_OG1 + 64 * MiB <= SM_BASE, "OG map");
constexpr size_t A_O1 = A_HB + 64 * MiB;
constexpr size_t A_MM1 = A_Z1;
static_assert(A_Z1 + 576 * MiB <= 1024 * MiB, "layer-1 map");
namespace nsa {
using namespace fa;
constexpr int IMP_STRIDE = 257;
constexpr int LDS_IMP = 84992;
constexpr int LDS_SEL = LDS_IMP + 64 * IMP_STRIDE * 4;
constexpr int LDS_CNT = LDS_SEL + 64 * 16 * 2;
constexpr int LDS_END = LDS_CNT + 64 * 4;
constexpr float C2 = 1.4426950408889634f * 0.08838834764831845f;
typedef float f32x4v __attribute__((ext_vector_type(4)));
using CN = Cfg<128, 128, false, false, 128>;

struct Tensors {
    const bf16* QN;
    const bf16* KC;
    const bf16* VC;
    const bf16* KST;
    const bf16* VST;
    const bf16* OW;
    bf16* OP;
    const float* GATE;
    bf16* O;
};

__device__ __forceinline__ unsigned long long wave_max_u64(unsigned long long v) {
#pragma unroll
    for (int o = 1; o < 64; o <<= 1) { const unsigned long long w = __shfl_xor(v, o); v = w > v ? w : v; }
    return v;
}

__device__ __forceinline__ void slc_row(const Tensors& T, int b, int g, int t, const short* selrow, int cnt, int lane) {
    constexpr int S = 16384;
    const int col = lane & 15, q4 = lane >> 4;
    const size_t bg = (size_t)(b * 2 + g);
    bf16x8 Bq[4];
    { const bf16* qp = T.QN + (((size_t)(b * 8 + 4 * g + (col & 3)) * S + t) * 128) + 8 * q4;
#pragma unroll
      for (int ks = 0; ks < 4; ++ks) { bf16x8 v = load8(qp + 32 * ks); if (col >= 4) v = (bf16x8){0, 0, 0, 0, 0, 0, 0, 0}; Bq[ks] = v; } }
    float m_run = -1e30f, l_run = 0.f;
    f32x4v oacc[8];
#pragma unroll
    for (int i = 0; i < 8; ++i) oacc[i] = (f32x4v){0.f, 0.f, 0.f, 0.f};
    const bf16* Kbase = T.KST + bg * 256 * 8192 + (size_t)lane * 8;
    const bf16* Vbase = T.VST + bg * 256 * 8192 + (size_t)lane * 8;
    bf16x8 Kf[16];
    int jb = __builtin_amdgcn_readfirstlane((int)selrow[0]);
    { const bf16* Kb = Kbase + (size_t)jb * 8192;
#pragma unroll
      for (int c = 0; c < 16; ++c) Kf[c] = load8(Kb + c * 512); }
    for (int i = 0; i < cnt; ++i) {
        const bf16* Vb = Vbase + (size_t)jb * 8192;
        bf16x8 Va[16];
#pragma unroll
        for (int c = 0; c < 16; ++c) Va[c] = load8(Vb + c * 512);
        f32x4v sacc[4];
#pragma unroll
        for (int kg = 0; kg < 4; ++kg) { sacc[kg] = (f32x4v){0.f, 0.f, 0.f, 0.f};
#pragma unroll
            for (int ks = 0; ks < 4; ++ks) sacc[kg] = __builtin_amdgcn_mfma_f32_16x16x32_bf16(Kf[kg * 4 + ks], Bq[ks], sacc[kg], 0, 0, 0); }
        const int kbase = 64 * jb + 4 * q4;
        if (i + 1 < cnt) {
            jb = __builtin_amdgcn_readfirstlane((int)selrow[i + 1]);
            const bf16* Kb = Kbase + (size_t)jb * 8192;
#pragma unroll
            for (int c = 0; c < 16; ++c) Kf[c] = load8(Kb + c * 512);
        }
        float mx = -__builtin_inff();
#pragma unroll
        for (int kg = 0; kg < 4; ++kg)
#pragma unroll
            for (int r = 0; r < 4; ++r) { if (kbase + 16 * kg + r > t) sacc[kg][r] = -__builtin_inff(); mx = fmaxf(mx, sacc[kg][r]); }
        mx = fmaxf(mx, __shfl_xor(mx, 16)); mx = fmaxf(mx, __shfl_xor(mx, 32));
        const float m_new = fmaxf(m_run, mx);
        const float alpha = __builtin_amdgcn_exp2f((m_run - m_new) * C2);
        m_run = m_new;
        const float mL = -m_new * C2;
        float ps = 0.f;
#pragma unroll
        for (int kg = 0; kg < 4; ++kg)
#pragma unroll
            for (int r = 0; r < 4; ++r) { const float p = __builtin_amdgcn_exp2f(fmaf(sacc[kg][r], C2, mL)); sacc[kg][r] = p; ps += p; }
        l_run = l_run * alpha + ps;
#pragma unroll
        for (int dg = 0; dg < 8; ++dg) oacc[dg] = oacc[dg] * alpha;
        bf16x8 Bp[2];
#pragma unroll
        for (int kp = 0; kp < 2; ++kp) { u32x4 w = {cvtpk(sacc[2 * kp][0], sacc[2 * kp][1]), cvtpk(sacc[2 * kp][2], sacc[2 * kp][3]),
                                                    cvtpk(sacc[2 * kp + 1][0], sacc[2 * kp + 1][1]), cvtpk(sacc[2 * kp + 1][2], sacc[2 * kp + 1][3])};
            Bp[kp] = *reinterpret_cast<bf16x8*>(&w); }
#pragma unroll
        for (int dg = 0; dg < 8; ++dg)
#pragma unroll
            for (int kp = 0; kp < 2; ++kp) oacc[dg] = __builtin_amdgcn_mfma_f32_16x16x32_bf16(Va[dg * 2 + kp], Bp[kp], oacc[dg], 0, 0, 0);
    }
    l_run += __shfl_xor(l_run, 16); l_run += __shfl_xor(l_run, 32);
    if (col < 4) {
        const int head = 4 * g + col;
        const size_t m = (size_t)b * S + t;
        const float g1 = T.GATE[m * 24 + head * 3 + 1];
        const float sc = l_run > 0.f ? g1 / l_run : 0.f;
        const bf16* pre = T.OP + (((size_t)(b * 8 + head) * S + t) * 128) + 4 * q4;
        bf16* out = T.O + m * 2048 + head * 128 + 4 * q4;
#pragma unroll
        for (int dg = 0; dg < 8; ++dg) {
            const unsigned long long pv64 = __hip_atomic_load(reinterpret_cast<const unsigned long long*>(pre + 16 * dg), __ATOMIC_RELAXED, __HIP_MEMORY_SCOPE_AGENT);
            uint2 pv; pv.x = (unsigned)pv64; pv.y = (unsigned)(pv64 >> 32);
            const float a0 = __uint_as_float(pv.x << 16), a1 = __uint_as_float(pv.x & 0xffff0000u), a2 = __uint_as_float(pv.y << 16), a3 = __uint_as_float(pv.y & 0xffff0000u);
            uint2 w; w.x = cvtpk(a0 + sc * oacc[dg][0], a1 + sc * oacc[dg][1]); w.y = cvtpk(a2 + sc * oacc[dg][2], a3 + sc * oacc[dg][3]);
            *reinterpret_cast<uint2*>(out + 16 * dg) = w;
        }
    }
}

__device__ __forceinline__ void nsa_block(const Tensors& T, int b, int g, int c, char* lds) {
    constexpr int S = 16384;
    int tid_ = threadIdx.x; asm volatile("" : "+v"(tid_)); const int tid = tid_, wid = __builtin_amdgcn_readfirstlane(tid >> 6), lane = tid & 63, r32 = lane & 31, hi = lane >> 5;
    const int hh = wid & 3, rh = wid >> 2, head = 4 * g + hh;
    unsigned* imp = (unsigned*)(lds + LDS_IMP);
    short* sel = (short*)(lds + LDS_SEL);
    int* cntp = (int*)(lds + LDS_CNT);
    for (int i = tid; i < 64 * IMP_STRIDE; i += 512) imp[i] = 0u;
    const int t0 = 64 * c;
    const int n_vis = 4 * c + 3;
    const int NT = (n_vis + 63) >> 6;
    bf16x8 qr[8];
    { const bf16* qp = T.QN + (((size_t)(b * 8 + head) * S + t0 + 32 * rh + r32) * 128) + hi * 8;
#pragma unroll
      for (int d0 = 0; d0 < 8; ++d0) qr[d0] = load8(qp + d0 * 16); }
    const int trow = t0 + 32 * rh + r32;
    const int vp = (trow - 31) >> 4;
    char* V_lds = lds; char* K_lds = lds + 2 * SHM_V;
    const int sr = tid >> 4, sc = (tid & 15) * 8, vst0 = v_st(sr, sc), vst1 = v_st(32 + sr, sc), kws = KSWZ(sr, sc * 2);
    const int vb0 = (int)(uintptr_t)V_lds + v_rd_base(lane);
    const bf16* Kh = T.KC + (size_t)(b * 2 + g) * 1024 * 128;
    const bf16* Vh = T.VC + (size_t)(b * 2 + g) * 1024 * 128;
    float* ws = (float*)(lds + LDS_WS) + wid * 64; float* li_l = ws, * al_l = ws + 32;
    bf16x8 st_k0, st_k1, st_v0, st_v1;
#define ROWP(p, k0, rr) ((p) + (size_t)((k0) + (rr)) * 128 + sc)
    __syncthreads();
    float m_reg = -1e30f, l_reg = 0.f;
    {
        st_k0 = load8(ROWP(Kh, 0, sr)); st_k1 = load8(ROWP(Kh, 0, 32 + sr));
        asm volatile("s_waitcnt vmcnt(0)" ::: "memory");
        *(bf16x8*)(K_lds + kws) = st_k0; *(bf16x8*)(K_lds + kws + 32 * 256) = st_k1;
        __syncthreads();
        f32x16 p0, p1; float mn, al; bf16x8 pa0, pa1, pa2, pa3;
#define STEP1(t, BUF) do { \
            if ((t) + 1 < NT) { st_k0 = load8(ROWP(Kh, 64 * ((t) + 1), sr)); st_k1 = load8(ROWP(Kh, 64 * ((t) + 1), 32 + sr)); SBAR(); } \
            qkt<BUF, false, false>(p0, p1, K_lds, nullptr, r32, hi, qr, true); \
            mask_tile(p0, p1, vp - 64 * (t) - 4 * hi, 0x7fffffffu); \
            partialSM<CN>(p0, p1, m_reg, mn, al); finishSM(p0, p1, al, l_reg, pa0, pa1, pa2, pa3); \
            if ((t) + 1 < NT) { asm volatile("s_waitcnt vmcnt(0)" ::: "memory"); *(bf16x8*)(K_lds + (1 - BUF) * SHM_K + kws) = st_k0; *(bf16x8*)(K_lds + (1 - BUF) * SHM_K + kws + 32 * 256) = st_k1; } \
            __syncthreads(); } while (0)
        for (int t = 0; t < NT; t += 2) { STEP1(t, 0); if (t + 1 < NT) STEP1(t + 1, 1); }
#undef STEP1
    }
    const float rl = l_reg > 0.f ? 1.f / l_reg : 0.f;
    const float mL = -m_reg * C2;
    f32x16 o[4] = {};
    {
        st_k0 = load8(ROWP(Kh, 0, sr)); st_k1 = load8(ROWP(Kh, 0, 32 + sr)); st_v0 = load8(ROWP(Vh, 0, sr)); st_v1 = load8(ROWP(Vh, 0, 32 + sr));
        asm volatile("s_waitcnt vmcnt(0)" ::: "memory");
        *(bf16x8*)(K_lds + kws) = st_k0; *(bf16x8*)(K_lds + kws + 32 * 256) = st_k1; *(bf16x8*)(V_lds + vst0) = st_v0; *(bf16x8*)(V_lds + vst1) = st_v1;
        __syncthreads();
        f32x16 p0, p1; bf16x8 pa0, pa1, pa2, pa3;
        unsigned* improw = imp + (32 * rh + r32) * IMP_STRIDE;
#define STEP2(t, BUF) do { \
            if ((t) + 1 < NT) { st_k0 = load8(ROWP(Kh, 64 * ((t) + 1), sr)); st_k1 = load8(ROWP(Kh, 64 * ((t) + 1), 32 + sr)); \
                                st_v0 = load8(ROWP(Vh, 64 * ((t) + 1), sr)); st_v1 = load8(ROWP(Vh, 64 * ((t) + 1), 32 + sr)); SBAR(); } \
            qkt<BUF, false, false>(p0, p1, K_lds, nullptr, r32, hi, qr, true); \
            mask_tile(p0, p1, vp - 64 * (t) - 4 * hi, 0x7fffffffu); \
            _Pragma("unroll") for (int r = 0; r < 16; ++r) { p0[r] = __builtin_amdgcn_exp2f(fmaf(p0[r], C2, mL)) * rl; p1[r] = __builtin_amdgcn_exp2f(fmaf(p1[r], C2, mL)) * rl; } \
            _Pragma("unroll") for (int G = 0; G < 4; ++G) { \
                const int j0 = 16 * (t) + 2 * G + hi; \
                const float s4 = (p0[4 * G] + p0[4 * G + 1]) + (p0[4 * G + 2] + p0[4 * G + 3]); \
                const float s4b = (p1[4 * G] + p1[4 * G + 1]) + (p1[4 * G + 2] + p1[4 * G + 3]); \
                atomicAdd(improw + j0, (unsigned)(s4 * 536870912.f)); atomicAdd(improw + j0 + 1, (unsigned)(p0[4 * G + 3] * 536870912.f)); \
                atomicAdd(improw + j0 + 8, (unsigned)(s4b * 536870912.f)); atomicAdd(improw + j0 + 9, (unsigned)(p1[4 * G + 3] * 536870912.f)); } \
            packP(p0, p1, pa0, pa1, pa2, pa3); SBAR(); \
            pv_tile<BUF, false>(o, vb0, pa0, pa1, pa2, pa3, true); \
            if ((t) + 1 < NT) { asm volatile("s_waitcnt vmcnt(0)" ::: "memory"); *(bf16x8*)(K_lds + (1 - BUF) * SHM_K + kws) = st_k0; *(bf16x8*)(K_lds + (1 - BUF) * SHM_K + kws + 32 * 256) = st_k1; \
                                *(bf16x8*)(V_lds + (1 - BUF) * SHM_V + vst0) = st_v0; *(bf16x8*)(V_lds + (1 - BUF) * SHM_V + vst1) = st_v1; } \
            __syncthreads(); } while (0)
        for (int t = 0; t < NT; t += 2) { STEP2(t, 0); if (t + 1 < NT) STEP2(t + 1, 1); }
#undef STEP2
    }
#undef ROWP
    {
#pragma unroll
        for (int r = 0; r < 16; ++r) {
            const int orow = crow(r, hi); const int t = t0 + 32 * rh + orow; const size_t m = (size_t)b * S + t;
            const float g0 = T.GATE[m * 24 + head * 3 + 0], g2 = T.GATE[m * 24 + head * 3 + 2];
            const bf16* owp = T.OW + (((size_t)(b * 8 + head) * S + t) * 128); bf16* opp = T.OP + (((size_t)(b * 8 + head) * S + t) * 128);
#pragma unroll
            for (int d0 = 0; d0 < 4; ++d0) {
                const float v = o[d0][r]; const float vn = __shfl_xor(v, 1);
                if ((r32 & 1) == 0) { const unsigned w = *(const unsigned*)(owp + d0 * 32 + r32);
                    const float w0 = __uint_as_float(w << 16), w1 = __uint_as_float(w & 0xffff0000u);
                    *(unsigned*)(opp + d0 * 32 + r32) = cvtpk(g0 * v + g2 * w0, g0 * vn + g2 * w1); }
            }
        }
    }
    __threadfence_block();
    __syncthreads();
    for (int qi = 0; qi < 8; ++qi) {
        const int q = wid * 8 + qi;
        short* srow = sel + q * 16;
        if (c <= 15) { if (lane <= c) srow[lane] = (short)lane; if (lane == 0) cntp[q] = c + 1; }
        else {
            unsigned long long key[4];
#pragma unroll
            for (int i = 0; i < 4; ++i) { const int j = lane + 64 * i; const bool ok = (j >= 1) && (j <= c - 2);
                key[i] = ok ? (((unsigned long long)imp[q * IMP_STRIDE + j] << 32) | (unsigned long long)(0xFFFFFFFFu - (unsigned)j)) : 0ull; }
            if (lane == 0) { srow[0] = 0; srow[1] = (short)(c - 1); srow[2] = (short)c; cntp[q] = 16; }
            for (int it = 0; it < 13; ++it) {
                unsigned long long mxk = key[0]; mxk = key[1] > mxk ? key[1] : mxk; mxk = key[2] > mxk ? key[2] : mxk; mxk = key[3] > mxk ? key[3] : mxk;
                const unsigned long long win = wave_max_u64(mxk);
                const int jw = (int)(0xFFFFFFFFu - (unsigned)(win & 0xFFFFFFFFull));
#pragma unroll
                for (int i = 0; i < 4; ++i) if (key[i] == win) key[i] = 0ull;
                if (lane == 0) srow[3 + it] = (short)jw;
            }
        }
    }
    __syncthreads();
    for (int qi = 0; qi < 8; ++qi) {
        const int q = wid + 8 * qi;
        const int cnt = __builtin_amdgcn_readfirstlane(cntp[q]);
        slc_row(T, b, g, t0 + q, sel + q * 16, cnt, lane);
    }
    __syncthreads();
}
}
#define LAS __attribute__((address_space(3)))
__device__ __forceinline__ unsigned f2bf(float f) { unsigned u = __builtin_bit_cast(unsigned, f); return (u + 0x7fffu + ((u >> 16) & 1u)) >> 16; }
__device__ __forceinline__ unsigned pk2(float lo, float hi) { unsigned r; asm volatile("v_cvt_pk_bf16_f32 %0, %1, %2" : "=v"(r) : "v"(lo), "v"(hi)); return r; }
__device__ __forceinline__ float bflo(unsigned w) { return __uint_as_float(w << 16); }
__device__ __forceinline__ float bfhi(unsigned w) { return __uint_as_float(w & 0xffff0000u); }
__device__ __forceinline__ float wave_sum(float v) {
#pragma unroll
    for (int o = 1; o < 64; o <<= 1) v += __shfl_xor(v, o);
    return v;
}
struct Ctx {
    float* out; unsigned char* ws; unsigned char* lds;
    int tid, lane, wave, vcu, G;
};
__device__ __forceinline__ void ctx_refresh(Ctx& C) { int t = threadIdx.x; asm volatile("" : "+v"(t)); C.tid = t; C.lane = t & 63; C.wave = __builtin_amdgcn_readfirstlane(t >> 6); }
#define WSP(T, off) ((T*)(C.ws + (off)))
#define ROWSQ(i) (WSP(float, SM_ROWSQ) + (size_t)(i) * MTOK)

enum { MAP_ID = 0, MAP_L0_WIN, MAP_UQ, MAP_L1_WIN };
__device__ __forceinline__ int wmap(int kind, int n) {
    if (kind == MAP_ID) return n;
    if (kind == MAP_L0_WIN) {
        if (n < 1024) { const int p = n & 127; return (n - p) + (p >> 1) + 64 * (p & 1); }
        if (n < 2560) { const int n2 = n - 1024, seg = n2 >> 7, p = n2 & 127; const int kv = (seg >> 1) & 1;
            return kv == 0 ? 1024 + seg * 128 + (p >> 1) + 64 * (p & 1) : 1024 + n2; }
        if (n < 3072) return 2584 + (n - 2560);
        if (n < 3328) return 3096 + (n - 3072);
        if (n < 3392) { const int p = n - 3328; return 3352 + (p >> 1) + 32 * (p & 1); }
        if (n < 3416) return 2560 + (n - 3392);
        return -1;
    }
    if (kind == MAP_UQ) {
        if (n < 1024) { const int h = n >> 7, d = n & 127; return h * 192 + d; }
        const int n2 = n - 1024, h = n2 >> 6, p = n2 & 63; return h * 192 + 128 + (p >> 1) + 32 * (p & 1);
    }
    { const int p = n & 127, base = n - p, qkv = (n >> 10) % 3; return qkv < 2 ? base + (p >> 1) + 64 * (p & 1) : n; }
}
__device__ __forceinline__ void transpose_item(const float* W, int Nsrc, const float* gain, bf16_t* WT, int Kdst, int row_off, int kind, int nblk, LAS float* scr, int item, int lane) {
    const int kb = item / nblk, nb = item % nblk, k0 = 64 * kb, n0 = 32 * nb;
    const int src = wmap(kind, n0 + (lane & 31));
#pragma unroll 8
    for (int i = 0; i < 32; ++i) { const int kk = 2 * i + (lane >> 5);
        float v = 0.f; if (src >= 0) { v = W[(size_t)(k0 + kk) * Nsrc + src]; if (gain) v *= gain[k0 + kk]; }
        scr[kk * 33 + (lane & 31)] = v; }
    asm volatile("s_waitcnt lgkmcnt(0)" ::: "memory");
    const int c = lane & 7;
#pragma unroll
    for (int j = 0; j < 4; ++j) { const int n = (lane >> 3) + 8 * j; const LAS float* s = scr + (8 * c) * 33 + n;
        u32x4 o; o.x = pk2(s[0 * 33], s[1 * 33]); o.y = pk2(s[2 * 33], s[3 * 33]); o.z = pk2(s[4 * 33], s[5 * 33]); o.w = pk2(s[6 * 33], s[7 * 33]);
        *(u32x4*)(WT + (size_t)(row_off + n0 + n) * Kdst + k0 + 8 * c) = o; }
    asm volatile("s_waitcnt lgkmcnt(0)" ::: "memory");
}
struct Args { const float* in[27]; float* out; unsigned char* ws; int phase_hi; int pad; };
__device__ __forceinline__ void prologue(Ctx& C, const Args& args) {
    ctx_refresh(C);
    LAS float* scr = (LAS float*)(C.lds) + C.wave * 4096;
    const int gw = C.vcu * NWAVES + C.wave, NGW = C.G * NWAVES;
    int it = gw;
#define WJOB(in_idx, gain_idx, K, Nsrc, Ndst, Kdst, row_off, kind, dst) do { constexpr int nblk_ = (Ndst) / 32, nitems_ = ((K) / 64) * nblk_; \
        for (; it < nitems_; it += NGW) transpose_item(args.in[in_idx], Nsrc, (gain_idx) >= 0 ? args.in[(gain_idx) >= 0 ? (gain_idx) : 0] : nullptr, WSP(bf16_t, dst), Kdst, row_off, kind, nblk_, scr, it, C.lane); \
        it -= nitems_; } while (0)
    WJOB(2, 1, 2048, 3416, 3584, 2048, 0, MAP_L0_WIN, W_L0_WIN);
    WJOB(10, 9, 512, 1536, 1536, 512, 0, MAP_UQ, W_UQ);
    WJOB(12, 11, 256, 2048, 2048, 256, 0, MAP_ID, W_UKV);
    WJOB(4, -1, 4096, 128, 128, 4096, 0, MAP_ID, W_C1);
    WJOB(7, -1, 4096, 128, 128, 4096, 128, MAP_ID, W_C1);
    WJOB(13, -1, 2048, 2048, 2048, 2048, 0, MAP_ID, W_L0_WOUT);
    WJOB(16, 15, 2048, 8192, 8192, 2048, 0, MAP_ID, W_L0_FF1);
    WJOB(17, -1, 8192, 2048, 2048, 8192, 0, MAP_ID, W_L0_FF2);
    WJOB(20, 19, 2048, 9216, 9216, 2048, 0, MAP_L1_WIN, W_L1_WIN);
    WJOB(21, -1, 1024, 2048, 2048, 1024, 0, MAP_ID, W_L1_WOUT);
    WJOB(24, 23, 2048, 8192, 8192, 2048, 0, MAP_ID, W_L1_FF1);
    WJOB(25, -1, 8192, 2048, 2048, 8192, 0, MAP_ID, W_L1_FF2);
    WJOB(5, -1, 128, 128, 128, 256, 0, MAP_ID, W_C2);
    WJOB(8, -1, 128, 128, 128, 256, 128, MAP_ID, W_C2);
#undef WJOB
    for (int i = gw * 64 + C.lane; i < 256 * 16; i += NGW * 64) { const int n = i >> 4, c = i & 15; *(u32x4*)(WSP(bf16_t, W_C2) + (size_t)n * 256 + 128 + 8 * c) = (u32x4){0u, 0u, 0u, 0u}; }
    for (int i = gw * 64 + C.lane; i < SEQ * 64; i += NGW * 64) {
        const int t = i >> 6, j = i & 63;
        double inv = 1.0; { double cbase = 0.86596432336006535; for (int q = 0; q < j; ++q) inv *= cbase; }
        const float ang = (float)t * (float)inv;
        double r = (double)ang * 0.15915494309189535; r -= __builtin_rint(r);
        const float rf = (float)r;
        WSP(float, SM_ROPE_C)[i] = __builtin_amdgcn_cosf(rf); WSP(float, SM_ROPE_S)[i] = __builtin_amdgcn_sinf(rf);
    }
    for (int i = gw * 64 + C.lane; i < SEQ * 32; i += NGW * 64) {
        const int t = i >> 5, j = i & 31;
        double inv = 1.0; { double cbase = 0.74989420933245582; for (int q = 0; q < j; ++q) inv *= cbase; }
        const float ang = (float)t * (float)inv;
        double r = (double)ang * 0.15915494309189535; r -= __builtin_rint(r);
        const float rf = (float)r;
        WSP(float, SM_ROPE2_C)[i] = __builtin_amdgcn_cosf(rf); WSP(float, SM_ROPE2_S)[i] = __builtin_amdgcn_sinf(rf);
    }
    for (int i = RS_CQ * MTOK + gw * 64 + C.lane; i < RS_N * MTOK; i += NGW * 64) WSP(float, SM_ROWSQ)[i] = 0.f;
    if (gw < 256) {
        const float* pe = args.in[gw < 128 ? 3 : 6]; const float* w1 = args.in[gw < 128 ? 4 : 7]; const int c = gw & 127;
        float s = 0.f; for (int i = C.lane; i < 4096; i += 64) s += pe[i] * w1[(size_t)i * 128 + c];
        s = wave_sum(s); if (C.lane == 0) WSP(float, SM_CBIAS)[gw] = s;
    }
    for (int m = gw; m < MTOK; m += NGW) {
        const f32x4* xr = (const f32x4*)(args.in[0] + (size_t)m * DM) + C.lane; u32x2* o = (u32x2*)(WSP(bf16_t, A_HB) + (size_t)m * DM) + C.lane;
        float s = 0.f;
#pragma unroll
        for (int j = 0; j < 8; ++j) { const f32x4 v = xr[64 * j]; s += (v.x * v.x + v.y * v.y) + (v.z * v.z + v.w * v.w); o[64 * j] = (u32x2){pk2(v.x, v.y), pk2(v.z, v.w)}; }
        s = wave_sum(s); if (C.lane == 0) ROWSQ(RS_X)[m] = s;
    }
}

__device__ __forceinline__ void postnorm_phase(Ctx& C, const float* hold, const bf16_t* mm, const float* g, float* rsq_out, bool write_hb) {
    ctx_refresh(C);
    const int gw = C.vcu * NWAVES + C.wave, NGW = C.G * NWAVES;
    f32x4 gv[8];
#pragma unroll
    for (int j = 0; j < 8; ++j) gv[j] = ((const f32x4*)g)[C.lane + 64 * j];
    for (int m = gw; m < MTOK; m += NGW) {
        const f32x4* hr = (const f32x4*)(hold + (size_t)m * DM) + C.lane; const u32x2* mr = (const u32x2*)(mm + (size_t)m * DM) + C.lane;
        f32x4* orow = (f32x4*)(C.out + (size_t)m * DM) + C.lane; u32x2* hb = (u32x2*)(WSP(bf16_t, A_HB) + (size_t)m * DM) + C.lane;
        u32x2 w[8]; float q = 0.f;
#pragma unroll
        for (int j = 0; j < 8; ++j) { w[j] = mr[64 * j]; const float a = bflo(w[j].x), b = bfhi(w[j].x), c = bflo(w[j].y), d = bfhi(w[j].y); q += (a * a + b * b) + (c * c + d * d); }
        q = wave_sum(q);
        const float rstd = __builtin_amdgcn_rsqf(q * (1.f / DM) + EPS);
        float s = 0.f;
#pragma unroll
        for (int j = 0; j < 8; ++j) { const f32x4 h = hr[64 * j];
            f32x4 v; v.x = h.x + bflo(w[j].x) * rstd * gv[j].x; v.y = h.y + bfhi(w[j].x) * rstd * gv[j].y; v.z = h.z + bflo(w[j].y) * rstd * gv[j].z; v.w = h.w + bfhi(w[j].y) * rstd * gv[j].w;
            orow[64 * j] = v; s += (v.x * v.x + v.y * v.y) + (v.z * v.z + v.w * v.w);
            if (write_hb) hb[64 * j] = (u32x2){pk2(v.x, v.y), pk2(v.z, v.w)}; }
        if (write_hb) { s = wave_sum(s); if (C.lane == 0) rsq_out[m] = s; }
    }
}

__device__ __forceinline__ void vst_phase(Ctx& C) {
    ctx_refresh(C);
    const int gw = C.vcu * NWAVES + C.wave, NGW = C.G * NWAVES;
    const bf16_t* KS = WSP(bf16_t, A_KV + 2 * 16 * MiB); const bf16_t* VS = WSP(bf16_t, A_KV + 3 * 16 * MiB); bf16_t* KST = WSP(bf16_t, A_KST); bf16_t* VST = WSP(bf16_t, A_VST);
    const int col = C.lane & 15, q4 = C.lane >> 4;
    for (int it = gw; it < 4 * 256 * 16; it += NGW) {
        const int ch = it & 15, blk = (it >> 4) & 255, bg = it >> 12; const int kg = ch >> 2, ks = ch & 3;
        const u32x4 v = *(const u32x4*)(KS + ((size_t)bg * SEQ + 64 * blk + 16 * kg + col) * 128 + 32 * ks + 8 * q4);
        *(u32x4*)(KST + (((size_t)bg * 256 + blk) * 16 + ch) * 512 + C.lane * 8) = v;
    }
    for (int it = gw; it < 4 * 256 * 16; it += NGW) {
        const int ch = it & 15, blk = (it >> 4) & 255, bg = it >> 12; const int dg = ch >> 1, kp = ch & 1;
        const bf16_t* src = VS + ((size_t)bg * SEQ + 64 * blk) * 128 + 16 * dg + col;
        unsigned short e[8];
#pragma unroll
        for (int j = 0; j < 8; ++j) { const int key = 32 * kp + (j < 4 ? 4 * q4 + j : 16 + 4 * q4 + (j - 4)); e[j] = src[(size_t)key * 128]; }
        u32x4 o; o.x = e[0] | ((unsigned)e[1] << 16); o.y = e[2] | ((unsigned)e[3] << 16); o.z = e[4] | ((unsigned)e[5] << 16); o.w = e[6] | ((unsigned)e[7] << 16);
        *(u32x4*)(VST + (((size_t)bg * 256 + blk) * 16 + ch) * 512 + C.lane * 8) = o;
    }
}

__device__ __forceinline__ void dil_merge_phase(Ctx& C) {
    ctx_refresh(C);
    const int gw = C.vcu * NWAVES + C.wave, NGW = C.G * NWAVES;
    const float* LSE = WSP(float, SM_LSE);
    const bf16_t* OG[3] = {WSP(bf16_t, A_OG0), WSP(bf16_t, A_OG1), WSP(bf16_t, A_OG2)};
    bf16_t* O1 = WSP(bf16_t, A_O1);
    for (int it = gw; it < MTOK * 2; it += NGW) {
        const int m = it >> 1, half = it & 1; const int b = m / SEQ, t = m % SEQ;
        const int h = 4 * half + (C.lane >> 4), d0 = (C.lane & 15) * 8;
        float l[3]; size_t idx[3];
#pragma unroll
        for (int g = 0; g < 3; ++g) { const int sh = 2 * g, r = 1 << sh; const int tp = (t & (r - 1)) * (SEQ >> sh) + (t >> sh);
            idx[g] = (size_t)(b * 8 + h) * SEQ + tp; l[g] = LSE[(size_t)g * MTOK * 8 + idx[g]]; }
        const float mx = fmaxf(l[0], fmaxf(l[1], l[2]));
        float e0 = __expf(l[0] - mx), e1 = __expf(l[1] - mx), e2 = __expf(l[2] - mx); const float inv = 1.f / (e0 + e1 + e2);
        const float a[3] = {e0 * inv, e1 * inv, e2 * inv};
        float acc[8] = {0, 0, 0, 0, 0, 0, 0, 0};
#pragma unroll
        for (int g = 0; g < 3; ++g) { const u32x4 w = *(const u32x4*)(OG[g] + idx[g] * 128 + d0);
            acc[0] += a[g] * bflo(w.x); acc[1] += a[g] * bfhi(w.x); acc[2] += a[g] * bflo(w.y); acc[3] += a[g] * bfhi(w.y);
            acc[4] += a[g] * bflo(w.z); acc[5] += a[g] * bfhi(w.z); acc[6] += a[g] * bflo(w.w); acc[7] += a[g] * bfhi(w.w); }
        *(u32x4*)(O1 + (size_t)m * 1024 + h * 128 + d0) = (u32x4){pk2(acc[0], acc[1]), pk2(acc[2], acc[3]), pk2(acc[4], acc[5]), pk2(acc[6], acc[7])};
    }
}
typedef pg8::f32x4 accv;
#define EPI_FOR_ROWS _Pragma("unroll") for (int ai = 0; ai < 2; ++ai) _Pragma("unroll") for (int m = 0; m < 4; ++m)
#define EPI_ROW (u.pm * 256 + ai * 128 + wr * 64 + m * 16 + fr)
__device__ __forceinline__ void store8(bf16_t* p, accv a, accv b) { *(u32x4*)p = (u32x4){pk2(a[0], a[1]), pk2(a[2], a[3]), pk2(b[0], b[1]), pk2(b[2], b[3])}; }
__device__ __forceinline__ void rope_store(bf16_t* dst, int pc, int half, accv a, accv b, const float* ct, const float* st) {
    const int i0 = pc >> 1; const f32x4 c = *(const f32x4*)(ct + i0), s = *(const f32x4*)(st + i0);
    const float o1a = a[0] * c.x - a[1] * s.x, o2a = a[0] * s.x + a[1] * c.x;
    const float o1b = a[2] * c.y - a[3] * s.y, o2b = a[2] * s.y + a[3] * c.y;
    const float o1c = b[0] * c.z - b[1] * s.z, o2c = b[0] * s.z + b[1] * c.z;
    const float o1d = b[2] * c.w - b[3] * s.w, o2d = b[2] * s.w + b[3] * c.w;
    *(u32x2*)(dst + i0) = (u32x2){pk2(o1a, o1b), pk2(o1c, o1d)};
    *(u32x2*)(dst + half + i0) = (u32x2){pk2(o2a, o2b), pk2(o2c, o2d)};
}
__device__ __forceinline__ float sumsq8(accv a, accv b) { return (a[0] * a[0] + a[1] * a[1]) + (a[2] * a[2] + a[3] * a[3]) + (b[0] * b[0] + b[1] * b[1]) + (b[2] * b[2] + b[3] * b[3]); }
__device__ __forceinline__ void rowsq_add(unsigned long long* p, float s, int fq) { s += __shfl_xor(s, 16); s += __shfl_xor(s, 32); if (fq == 0) atomicAdd(p, (unsigned long long)(s * 1099511627776.f)); }
__device__ __forceinline__ float rowsq_fx(const unsigned long long* p) { return (float)(*p) * 9.094947017729282e-13f; }

struct EpiL0In {
    static constexpr bool PERM = true, AFTER_DRAIN = false;
    unsigned char* ws; const float* rsq_x;
    __device__ __forceinline__ void operator()(const accv (&acc)[2][2][4][2], const pg8::Unit& u, int wr, int wc, int fr, int fq) const {
        const int pn = u.pn, pc = wc * 32 + 8 * fq;
        EPI_FOR_ROWS { const int row = EPI_ROW; const float rstd = __builtin_amdgcn_rsqf(rsq_x[row] * (1.f / DM) + EPS);
            const int b = row / SEQ, t = row % SEQ; float ssq = 0.f;
#pragma unroll
            for (int bj = 0; bj < 2; ++bj) { const accv v0 = acc[ai][bj][m][0] * rstd, v1 = acc[ai][bj][m][1] * rstd;
                if (pn < 4) { const int head = 2 * pn + bj;
                    rope_store((bf16_t*)(ws + A_QN) + ((size_t)(b * 8 + head) * SEQ + t) * 128, pc, 64, v0, v1, (const float*)(ws + SM_ROPE_C) + t * 64, (const float*)(ws + SM_ROPE_S) + t * 64); }
                else if (pn < 10) { const int q = pn - 4, kv = q & 1;
                    bf16_t* dst = (bf16_t*)(ws + A_KV + (size_t)q * 16 * MiB) + ((size_t)(b * 2 + bj) * SEQ + t) * 128;
                    if (kv == 0) rope_store(dst, pc, 64, v0, v1, (const float*)(ws + SM_ROPE_C) + t * 64, (const float*)(ws + SM_ROPE_S) + t * 64);
                    else store8(dst + pc, v0, v1); }
                else if (pn < 12) { store8((bf16_t*)(ws + A_CQ) + (size_t)row * 512 + (pn - 10) * 256 + bj * 128 + pc, v0, v1); ssq += sumsq8(v0, v1); }
                else if (pn == 12) { store8((bf16_t*)(ws + A_CKV) + (size_t)row * 256 + bj * 128 + pc, v0, v1); ssq += sumsq8(v0, v1); }
                else if (bj == 0) {
                    if (pc < 64) rope_store((bf16_t*)(ws + A_KPE) + ((size_t)b * SEQ + t) * 64, pc, 32, v0, v1, (const float*)(ws + SM_ROPE2_C) + t * 32, (const float*)(ws + SM_ROPE2_S) + t * 32);
                    else if (pc < 88) { float* gp = (float*)(ws + SM_GATE) + (size_t)row * 24 + (pc - 64);
                        f32x4 g0, g1;
                        g0.x = 1.f / (1.f + __expf(-v0[0])); g0.y = 1.f / (1.f + __expf(-v0[1])); g0.z = 1.f / (1.f + __expf(-v0[2])); g0.w = 1.f / (1.f + __expf(-v0[3]));
                        g1.x = 1.f / (1.f + __expf(-v1[0])); g1.y = 1.f / (1.f + __expf(-v1[1])); g1.z = 1.f / (1.f + __expf(-v1[2])); g1.w = 1.f / (1.f + __expf(-v1[3]));
                        *(f32x4*)gp = g0; *(f32x4*)(gp + 4) = g1; }
                }
            }
            if (pn >= 10 && pn < 12) rowsq_add((unsigned long long*)((float*)(ws + SM_ROWSQ) + (size_t)RS_CQ * MTOK) + row, ssq, fq);
            if (pn == 12) rowsq_add((unsigned long long*)((float*)(ws + SM_ROWSQ) + (size_t)RS_CKV * MTOK) + row, ssq, fq);
        }
    }
};
struct EpiUQ {
    static constexpr bool PERM = true, AFTER_DRAIN = false;
    unsigned char* ws; bf16_t* MQ; const unsigned long long* rsq;
    __device__ __forceinline__ void operator()(const accv (&acc)[2][2][4][2], const pg8::Unit& u, int wr, int wc, int fr, int fq) const {
        const int pn = u.pn, pc = wc * 32 + 8 * fq;
        EPI_FOR_ROWS { const int row = EPI_ROW; const float rstd = __builtin_amdgcn_rsqf(rowsq_fx(rsq + row) * (1.f / 512.f) + EPS);
            const int b = row / SEQ, t = row % SEQ;
#pragma unroll
            for (int bj = 0; bj < 2; ++bj) { const accv v0 = acc[ai][bj][m][0] * rstd, v1 = acc[ai][bj][m][1] * rstd;
                if (pn < 4) { const int head = 2 * pn + bj; store8(MQ + ((size_t)(b * 8 + head) * SEQ + t) * 192 + pc, v0, v1); }
                else { const int head = 4 * (pn - 4) + 2 * bj + (pc >> 6);
                    rope_store(MQ + ((size_t)(b * 8 + head) * SEQ + t) * 192 + 128, pc & 63, 32, v0, v1, (const float*)(ws + SM_ROPE2_C) + t * 32, (const float*)(ws + SM_ROPE2_S) + t * 32); }
            }
        }
    }
};
struct EpiUKV {
    static constexpr bool PERM = true, AFTER_DRAIN = false;
    bf16_t* MK; bf16_t* MV; const unsigned long long* rsq;
    __device__ __forceinline__ void operator()(const accv (&acc)[2][2][4][2], const pg8::Unit& u, int wr, int wc, int fr, int fq) const {
        const int pc = wc * 32 + 8 * fq;
        EPI_FOR_ROWS { const int row = EPI_ROW; const float rstd = __builtin_amdgcn_rsqf(rowsq_fx(rsq + row) * (1.f / 256.f) + EPS);
            const int b = row / SEQ, t = row % SEQ; const size_t off = ((size_t)(b * 8 + u.pn) * SEQ + t) * 128 + pc;
            store8(MK + off, acc[ai][0][m][0] * rstd, acc[ai][0][m][1] * rstd);
            store8(MV + off, acc[ai][1][m][0] * rstd, acc[ai][1][m][1] * rstd);
        }
    }
};
__device__ __forceinline__ float gelu_tanh(float x) { const float u = 0.7978845608028654f * (x + 0.044715f * x * x * x); const float e = __expf(2.f * u); const float th = 1.f - 2.f / (e + 1.f); return 0.5f * x * (1.f + th); }
struct EpiC1 {
    static constexpr bool PERM = true, AFTER_DRAIN = false;
    bf16_t* HC; const float* cb;
    template <int SEL> __device__ __forceinline__ void body(const accv (&acc)[2][2][4][2], const pg8::Unit& u, int wr, int wc, int fr, int fq) const {
        const int pc = wc * 32 + 8 * fq;
        const f32x4 b0 = *(const f32x4*)(cb + SEL * 128 + pc), b1 = *(const f32x4*)(cb + SEL * 128 + pc + 4);
        EPI_FOR_ROWS { const int row = EPI_ROW;
            accv v0 = acc[ai][SEL][m][0], v1 = acc[ai][SEL][m][1];
            v0 += (accv){b0.x, b0.y, b0.z, b0.w}; v1 += (accv){b1.x, b1.y, b1.z, b1.w};
#pragma unroll
            for (int e = 0; e < 4; ++e) { v0[e] = gelu_tanh(v0[e]); v1[e] = gelu_tanh(v1[e]); }
            store8(HC + (size_t)row * 256 + pc, v0, v1);
            *(u32x4*)(HC + (size_t)row * 256 + 128 + pc) = (u32x4){0u, 0u, 0u, 0u};
            asm volatile("" ::: "memory");
        }
    }
    __device__ __forceinline__ void operator()(const accv (&acc)[2][2][4][2], const pg8::Unit& u, int wr, int wc, int fr, int fq) const {
        if (u.pm >= 16) body<1>(acc, u, wr, wc, fr, fq); else body<0>(acc, u, wr, wc, fr, fq);
    }
};
struct EpiC2 {
    static constexpr bool PERM = true, AFTER_DRAIN = false;
    bf16_t* KC; bf16_t* VC;
    template <int SEL> __device__ __forceinline__ void body(const accv (&acc)[2][2][4][2], const pg8::Unit& u, int wr, int wc, int fr, int fq) const {
        const int pc = wc * 32 + 8 * fq;
        EPI_FOR_ROWS { const int row = EPI_ROW;
            accv v0 = acc[ai][SEL][m][0], v1 = acc[ai][SEL][m][1];
            if ((row & 1023) == 1023) { v0 = (accv){0.f, 0.f, 0.f, 0.f}; v1 = v0; }
            bf16_t* dst = (SEL ? VC : KC) + (size_t)(row & 4095) * 128 + pc;
            store8(dst, v0, v1);
            asm volatile("" ::: "memory");
        }
    }
    __device__ __forceinline__ void operator()(const accv (&acc)[2][2][4][2], const pg8::Unit& u, int wr, int wc, int fr, int fq) const {
        if (u.pm >= 16) body<1>(acc, u, wr, wc, fr, fq); else body<0>(acc, u, wr, wc, fr, fq);
    }
};
template <int ACT> struct EpiOut {
    static constexpr bool PERM = true, AFTER_DRAIN = false;
    bf16_t* O; int ldc; float* rsq_out; const float* rsq_in;
    __device__ __forceinline__ void operator()(const accv (&acc)[2][2][4][2], const pg8::Unit& u, int wr, int wc, int fr, int fq) const {
        const int pc = wc * 32 + 8 * fq;
        EPI_FOR_ROWS { const int row = EPI_ROW;
            float rstd = 1.f; if (ACT == 1) rstd = __builtin_amdgcn_rsqf(rsq_in[row] * (1.f / DM) + EPS);
#pragma unroll
            for (int bj = 0; bj < 2; ++bj) { accv v0 = acc[ai][bj][m][0], v1 = acc[ai][bj][m][1];
                if (ACT == 1) {
#pragma unroll
                    for (int e = 0; e < 4; ++e) { float a = fmaxf(v0[e] * rstd, 0.f); v0[e] = a * a; float c = fmaxf(v1[e] * rstd, 0.f); v1[e] = c * c; } }
                store8(O + (size_t)row * ldc + u.pn * 256 + bj * 128 + pc, v0, v1); }
        }
    }
};
struct EpiL1In {
    static constexpr bool PERM = true, AFTER_DRAIN = false;
    unsigned char* ws; const float* rsq;
    __device__ __forceinline__ void operator()(const accv (&acc)[2][2][4][2], const pg8::Unit& u, int wr, int wc, int fr, int fq) const {
        const int pn = u.pn, pc = wc * 32 + 8 * fq; const int g = pn / 12, qkv = (pn % 12) >> 2, sh = 2 * g;
        EPI_FOR_ROWS { const int row = EPI_ROW; const float rstd = __builtin_amdgcn_rsqf(rsq[row] * (1.f / DM) + EPS);
            const int b = row / SEQ, t = row % SEQ; const int tp = (t & ((1 << sh) - 1)) * (SEQ >> sh) + (t >> sh);
#pragma unroll
            for (int bj = 0; bj < 2; ++bj) { const accv v0 = acc[ai][bj][m][0] * rstd, v1 = acc[ai][bj][m][1] * rstd;
                const int head = 2 * (pn & 3) + bj;
                bf16_t* dst = (bf16_t*)(ws + A_Z1 + (size_t)(g * 3 + qkv) * 64 * MiB) + ((size_t)(b * 8 + head) * SEQ + tp) * 128;
                if (qkv < 2) rope_store(dst, pc, 64, v0, v1, (const float*)(ws + SM_ROPE_C) + t * 64, (const float*)(ws + SM_ROPE_S) + t * 64);
                else store8(dst + pc, v0, v1); }
        }
    }
};

#ifndef REP_PRO
#define REP_PRO 1
#endif
#ifndef REP_G1
#define REP_G1 1
#endif
#ifndef REP_WIN
#define REP_WIN 1
#endif
#ifndef REP_MLA
#define REP_MLA 1
#endif
#ifndef REP_NSA
#define REP_NSA 1
#endif
#ifndef REP_DIL
#define REP_DIL 1
#endif
#ifndef ONLY_G
#define ONLY_G -1
#endif
#ifndef MK_PHASE_HI
#define MK_PHASE_HI 99
#endif
#define GRID_SYNC() do { __threadfence(); grid.sync(); __builtin_amdgcn_fence(__ATOMIC_ACQUIRE, "agent"); asm volatile("s_waitcnt vmcnt(0)" ::: "memory"); __syncthreads(); } while (0)
template <class Epi> __device__ __forceinline__ void run_gemm(Ctx& C, const bf16_t* A, const bf16_t* Bt, int Mr, int N, int K, int lda, const Epi& E) {
    asm volatile("" : "+s"(K), "+s"(lda), "+s"(N), "+s"(Mr));
    pg8::Gemm g{A, Bt, Mr, N, K, lda}; pg8::StaticOrder S; S.init(Mr, N, C.G, (int)blockIdx.x);
    pg8::gemm_phase<Epi, pg8::StaticOrder, true, true>((LAS unsigned char*)C.lds, g, S, E);
}
using CfgW = fa::Cfg<128, 128, false, true, 128>;
using CfgM = fa::Cfg<192, 2048, true, false, 192>;

__global__ void __launch_bounds__(NTHREADS, 2) mega_fwd(Args args) {
    extern __shared__ __attribute__((aligned(16))) unsigned char lds[];
    cg::grid_group grid = cg::this_grid();
    Ctx C;
    C.out = args.out; C.ws = args.ws; C.lds = lds;
    ctx_refresh(C);
    C.G = gridDim.x; { const int bx = blockIdx.x; C.vcu = (C.G % 8 == 0) ? (bx % 8) * (C.G / 8) + bx / 8 : bx; }
    const int phase_hi = args.phase_hi;
    unsigned char* dout = (unsigned char*)args.out;
    using fa::bf16;

    for (int rep_ = 0; rep_ < REP_PRO; ++rep_) prologue(C, args);
    GRID_SYNC();
    for (int rep_ = 0; rep_ < REP_G1; ++rep_) { EpiL0In E{C.ws, ROWSQ(RS_X)}; if constexpr (ONLY_G < 0 || ONLY_G == 0) run_gemm(C, WSP(bf16_t, A_HB), WSP(bf16_t, W_L0_WIN), MTOK, 3584, 2048, 2048, E); }
    GRID_SYNC();
    { EpiC1 E{WSP(bf16_t, A_HC), WSP(float, SM_CBIAS)}; if constexpr (ONLY_G < 0 || ONLY_G == 1) run_gemm(C, WSP(bf16_t, A_KV), WSP(bf16_t, W_C1), 8192, 256, 4096, 2048, E); }
    { EpiUQ E{C.ws, (bf16_t*)(dout + DO_MQ), (const unsigned long long*)ROWSQ(RS_CQ)}; if constexpr (ONLY_G < 0 || ONLY_G == 2) run_gemm(C, WSP(bf16_t, A_CQ), WSP(bf16_t, W_UQ), MTOK, 1536, 512, 512, E); }
    { EpiUKV E{(bf16_t*)(dout + DO_MK), (bf16_t*)(dout + DO_MV), (const unsigned long long*)ROWSQ(RS_CKV)}; if constexpr (ONLY_G < 0 || ONLY_G == 3) run_gemm(C, WSP(bf16_t, A_CKV), WSP(bf16_t, W_UKV), MTOK, 2048, 256, 256, E); }
    vst_phase(C);
#ifndef NO_WIN
    for (int rep_ = 0; rep_ < REP_WIN; ++rep_) {
        const bf16* QN = WSP(bf16, A_QN); const bf16* KW = WSP(bf16, A_KV + 4 * 16 * MiB); const bf16* VW = WSP(bf16, A_KV + 5 * 16 * MiB); bf16* OW = WSP(bf16, A_OW);
        for (int L = C.vcu * 4; L < C.vcu * 4 + 4 && L < 1024; ++L) {
            const int bh = L >> 6, qb = L & 63, b = bh >> 3, h = bh & 7;
            fa::BlockRef r; r.Q = QN + ((size_t)bh * SEQ + qb * 256) * 128; r.K = KW + (size_t)(b * 2 + (h >> 2)) * SEQ * 128; r.V = VW + (size_t)(b * 2 + (h >> 2)) * SEQ * 128;
            r.KP = nullptr; r.O = OW + ((size_t)bh * SEQ + qb * 256) * 128; r.L = nullptr; r.P0 = qb * 256;
            fa::block_simple<CfgW>(r, SEQ, 512, (char*)lds);
        }
    }
#endif
    GRID_SYNC();
    { EpiC2 E{WSP(bf16_t, A_KCMP), WSP(bf16_t, A_VCMP)}; if constexpr (ONLY_G < 0 || ONLY_G == 4) run_gemm(C, WSP(bf16_t, A_HC), WSP(bf16_t, W_C2), 8192, 256, 256, 256, E); }
#ifndef NO_MLA
    for (int rep_ = 0; rep_ < REP_MLA; ++rep_) {
        const bf16* MQ = (const bf16*)(dout + DO_MQ); const bf16* MK = (const bf16*)(dout + DO_MK); const bf16* MV = (const bf16*)(dout + DO_MV);
        const bf16* KPE = WSP(bf16, A_KPE); bf16* O = WSP(bf16, A_O);
        for (int L = C.vcu * 2; L < C.vcu * 2 + 2 && L < 512; ++L) {
            const int bh = L >> 5, x = L & 31, b = bh >> 3, h = bh & 7;
            for (int pass = 0; pass < 2; ++pass) { const int qb = pass ? 63 - x : x;
                fa::BlockRef r; r.Q = MQ + ((size_t)bh * SEQ + qb * 256) * 192; r.K = MK + (size_t)bh * SEQ * 128; r.V = MV + (size_t)bh * SEQ * 128;
                r.KP = KPE + (size_t)b * SEQ * 64; r.O = O + ((size_t)b * SEQ + qb * 256) * 2048 + 1024 + h * 128; r.L = nullptr; r.P0 = qb * 256;
                fa::block_simple<CfgM>(r, SEQ, 1 << 30, (char*)lds);
            }
        }
    }
#endif
    GRID_SYNC();
#ifndef NO_NSA
    for (int rep_ = 0; rep_ < REP_NSA; ++rep_) {
        nsa::Tensors T; T.QN = WSP(bf16, A_QN); T.KC = WSP(bf16, A_KCMP); T.VC = WSP(bf16, A_VCMP); T.KST = WSP(bf16, A_KST); T.VST = WSP(bf16, A_VST);
        T.OW = WSP(bf16, A_OW); T.OP = WSP(bf16, A_OP); T.GATE = WSP(float, SM_GATE); T.O = WSP(bf16, A_O);
        const int bg = C.vcu >> 6, k = C.vcu & 63;
        if (bg < 4) {
            for (int i = 0; i < 4; ++i) { const int c = (i == 0) ? k : (i == 1) ? 127 - k : (i == 2) ? 128 + k : 255 - k;
                nsa::nsa_block(T, bg >> 1, bg & 1, c, (char*)lds); }
        }
    }
#endif
    GRID_SYNC();
    { EpiOut<0> E{WSP(bf16_t, A_MM), 2048, nullptr, nullptr}; if constexpr (ONLY_G < 0 || ONLY_G == 5) run_gemm(C, WSP(bf16_t, A_O), WSP(bf16_t, W_L0_WOUT), MTOK, 2048, 2048, 2048, E); }
    GRID_SYNC();
    postnorm_phase(C, args.in[0], WSP(bf16_t, A_MM), args.in[14], ROWSQ(RS_H1), true);
    GRID_SYNC();
    if (phase_hi <= 6) return;
    { EpiOut<1> E{WSP(bf16_t, A_HID), 8192, nullptr, ROWSQ(RS_H1)}; if constexpr (ONLY_G < 0 || ONLY_G == 6) run_gemm(C, WSP(bf16_t, A_HB), WSP(bf16_t, W_L0_FF1), MTOK, 8192, 2048, 2048, E); }
    GRID_SYNC();
    { EpiOut<0> E{WSP(bf16_t, A_F), 2048, nullptr, nullptr}; if constexpr (ONLY_G < 0 || ONLY_G == 7) run_gemm(C, WSP(bf16_t, A_HID), WSP(bf16_t, W_L0_FF2), MTOK, 2048, 8192, 8192, E); }
    GRID_SYNC();
    postnorm_phase(C, C.out, WSP(bf16_t, A_F), args.in[18], ROWSQ(RS_H2), true);
    GRID_SYNC();
    if (phase_hi <= 9) return;
    { EpiL1In E{C.ws, ROWSQ(RS_H2)}; if constexpr (ONLY_G < 0 || ONLY_G == 8) run_gemm(C, WSP(bf16_t, A_HB), WSP(bf16_t, W_L1_WIN), MTOK, 9216, 2048, 2048, E); }
    GRID_SYNC();
#ifndef NO_DIL
    for (int rep_ = 0; rep_ < REP_DIL; ++rep_) {
        for (int g = 0; g < 3; ++g) {
            const int sh = 2 * g, slen = SEQ >> sh, nqb = slen >> 8;
            const bf16* Qg = WSP(bf16, A_Z1 + (size_t)(g * 3 + 0) * 64 * MiB); const bf16* Kg = WSP(bf16, A_Z1 + (size_t)(g * 3 + 1) * 64 * MiB); const bf16* Vg = WSP(bf16, A_Z1 + (size_t)(g * 3 + 2) * 64 * MiB);
            bf16* Og = (g == 0) ? WSP(bf16, A_OG0) : (g == 1) ? WSP(bf16, A_OG1) : WSP(bf16, A_OG2);
            float* Lg = WSP(float, SM_LSE) + (size_t)g * MTOK * 8;
            for (int L = C.vcu * 4; L < C.vcu * 4 + 4 && L < 1024; ++L) {
                const int bh = L >> 6, rest = L & 63, res = rest / nqb, qb = rest % nqb;
                const size_t seq0 = (size_t)bh * SEQ + (size_t)res * slen;
                fa::BlockRef r; r.Q = Qg + (seq0 + qb * 256) * 128; r.K = Kg + seq0 * 128; r.V = Vg + seq0 * 128; r.KP = nullptr;
                r.O = Og + (seq0 + qb * 256) * 128; r.L = Lg + seq0 + qb * 256; r.P0 = qb * 256;
                fa::block_simple<CfgW>(r, slen, 129, (char*)lds);
            }
        }
    }
#endif
    GRID_SYNC();
    dil_merge_phase(C);
    GRID_SYNC();
    { EpiOut<0> E{WSP(bf16_t, A_MM1), 2048, nullptr, nullptr}; if constexpr (ONLY_G < 0 || ONLY_G == 9) run_gemm(C, WSP(bf16_t, A_O1), WSP(bf16_t, W_L1_WOUT), MTOK, 2048, 1024, 1024, E); }
    GRID_SYNC();
    postnorm_phase(C, C.out, WSP(bf16_t, A_MM1), args.in[22], ROWSQ(RS_H3), true);
    GRID_SYNC();
    if (phase_hi <= 14) return;
    { EpiOut<1> E{WSP(bf16_t, A_HID), 8192, nullptr, ROWSQ(RS_H3)}; if constexpr (ONLY_G < 0 || ONLY_G == 10) run_gemm(C, WSP(bf16_t, A_HB), WSP(bf16_t, W_L1_FF1), MTOK, 8192, 2048, 2048, E); }
    GRID_SYNC();
    { EpiOut<0> E{WSP(bf16_t, A_F), 2048, nullptr, nullptr}; if constexpr (ONLY_G < 0 || ONLY_G == 11) run_gemm(C, WSP(bf16_t, A_HID), WSP(bf16_t, W_L1_FF2), MTOK, 2048, 8192, 8192, E); }
    GRID_SYNC();
    postnorm_phase(C, C.out, WSP(bf16_t, A_F), args.in[26], nullptr, false);
}

extern "C" void kernel_launch(void* const* d_in, const int* in_sizes, int n_in, void* d_out, int out_size, void* d_ws, size_t ws_size, hipStream_t stream) {
    static int grid = 0;
    if (grid == 0) {
        if (n_in != 27 || out_size != MTOK * DM || ws_size < 1024 * MiB) { fprintf(stderr, "kernel_launch: unexpected shapes (n_in %d out %d ws %zu)\n", n_in, out_size, ws_size); grid = -1; return; }
        int dev = 0, cus = 0, per_cu = 0;
        if (hipGetDevice(&dev) != hipSuccess || hipDeviceGetAttribute(&cus, hipDeviceAttributeMultiprocessorCount, dev) != hipSuccess) { grid = -1; return; }
        if (hipFuncSetAttribute((const void*)mega_fwd, hipFuncAttributeMaxDynamicSharedMemorySize, LDS_BYTES) != hipSuccess) { fprintf(stderr, "kernel_launch: hipFuncSetAttribute failed\n"); grid = -1; return; }
        if (hipOccupancyMaxActiveBlocksPerMultiprocessor(&per_cu, (const void*)mega_fwd, NTHREADS, LDS_BYTES) != hipSuccess || per_cu < 1) { fprintf(stderr, "kernel_launch: occupancy query says %d\n", per_cu); (void)hipGetLastError(); grid = -1; return; }
        grid = cus;
        if (grid != 256) fprintf(stderr, "kernel_launch: note: %d CUs\n", grid);
    }
    if (grid < 0) return;
    Args a{};
    for (int i = 0; i < 27; ++i) a.in[i] = (const float*)d_in[i];
    a.out = (float*)d_out; a.ws = (unsigned char*)d_ws; a.phase_hi = MK_PHASE_HI; a.pad = 0;
    void* kargs[] = {&a};
    hipError_t e = hipLaunchCooperativeKernel((const void*)mega_fwd, dim3(grid), dim3(NTHREADS), kargs, LDS_BYTES, stream);
    if (e != hipSuccess) fprintf(stderr, "kernel_launch: cooperative launch failed: %s\n", hipGetErrorString(e));
}
```

```cpp
#include <hip/hip_runtime.h>
#include <hip/hip_bf16.h>
#include <hip/hip_cooperative_groups.h>
#include <cstdio>
#include <cstdint>
namespace cg = cooperative_groups;
namespace pg8 {
#define PG8_LAS __attribute__((address_space(3)))
typedef unsigned short bf16_t;
typedef short bf16x8 __attribute__((ext_vector_type(8)));
typedef float f32x4 __attribute__((ext_vector_type(4)));
typedef unsigned u32x4 __attribute__((ext_vector_type(4)));
constexpr int BM = 256, BK = 64, HALF = 128, HTB = HALF * BK * 2  , STAGE_BYTES = 8 * HTB, NXCD = 8, WGM = 8;

__host__ __device__ __forceinline__ int lds_byte(int r, int c) { const int st = (r >> 4) * 2 + (c >> 5), rr = r & 15, cc = c & 31, ob = rr * 64 + cc * 2; return st * 1024 + (ob ^ (((ob >> 9) & 1) << 5)); }
__host__ __device__ __forceinline__ void stage_rc(int b, int& R, int& C) { const int st = b / 1024, sb = b % 1024, swz = sb ^ (((sb >> 9) & 1) << 5); R = (st >> 1) * 16 + swz / 64; C = (st & 1) * 32 + (swz % 64) / 2; }
__host__ __device__ __forceinline__ int perm32(int rho) { const int n = rho >> 4, i = rho & 15; return 8 * (i >> 2) + 4 * n + (i & 3); }

struct Unit { int pm, pn; };
struct Gemm { const bf16_t* A; const bf16_t* Bt; int M, N, K, lda; };

struct StaticOrder {
    int nM, nN, nwg, G, c;
    __host__ __device__ void init(int M, int N, int G_, int c_) { nM = M / BM; nN = N / BM; nwg = nM * nN; G = G_; c = c_; }
    __host__ __device__ bool next(int i, Unit& u) const {
        const long L = (long)i * G + c; if (L >= nwg) return false;
        int wgid = (int)L; { const int q = nwg / NXCD, r = nwg % NXCD, xcd = wgid % NXCD, off = wgid / NXCD; wgid = (xcd < r ? xcd * (q + 1) : r * (q + 1) + (xcd - r) * q) + off; }
        const int nig = WGM * nN, gid = wgid / nig, fm = gid * WGM, gsz = (nM - fm) < WGM ? (nM - fm) : WGM;
        u.pm = fm + ((wgid % nig) % gsz); u.pn = (wgid % nig) / gsz; return true;
    }
    __device__ __forceinline__ void a_ready(const Unit&) const {}
    __device__ __forceinline__ void done(const Unit&) const {}
};

template <class Epi, class Sched, bool ALIGN_EPI = false, bool SP2 = false>
__device__ __forceinline__ void gemm_phase(PG8_LAS unsigned char* lds, const Gemm g, const Sched& S, const Epi& E) {
    int tid_ = threadIdx.x; asm volatile("" : "+v"(tid_)); const int tid = tid_, wid = __builtin_amdgcn_readfirstlane(tid >> 6), lane = tid & 63, wr = wid >> 2, wc = wid & 3, fr = lane & 15, fq = lane >> 4;
    const int K = g.K, nt = K / BK;
    unsigned voffA[2], voffB[2];
#pragma unroll
    for (int i = 0; i < 2; ++i) { int R, C; stage_rc(tid * 16 + i * 8192, R, C); const int Rb = Epi::PERM ? ((R & ~31) + perm32(R & 31)) : R;
        voffA[i] = (unsigned)(R * g.lda + C) * 2u; voffB[i] = (unsigned)(Rb * K + C) * 2u; }
    const size_t kstep = (size_t)(BK * 2);
    const size_t hstepA = (size_t)HALF * g.lda * 2, hstepB = (size_t)HALF * K * 2;
    const size_t tstepA = 2 * hstepA, tstepB = 2 * hstepB;
    const unsigned ldsw = (unsigned)wid * 1024u;
    const int aoff = lds_byte(wr * 64 + fr, fq * 8), boff = lds_byte(wc * 32 + fr, fq * 8);
#define PG8_SA(b, h) (((b) * 2 + (h)) * HTB)
#define PG8_SB(b, h) ((4 + (b) * 2 + (h)) * HTB)
#define PG8_STAGE(bufoff, gbase, voff) do { _Pragma("unroll") for (int _i = 0; _i < 2; ++_i) \
        __builtin_amdgcn_global_load_lds((const unsigned*)((const char*)(gbase) + (voff)[_i]), (PG8_LAS unsigned*)(lds + (bufoff) + ldsw + _i * 8192), 16, 0, 0); } while (0)
#define PG8_LDA(dst, b, h) do { _Pragma("unroll") for (int m = 0; m < 4; ++m) _Pragma("unroll") for (int k = 0; k < 2; ++k) dst[m][k] = *(const PG8_LAS bf16x8*)(lds + PG8_SA(b, h) + aoff + m * 2048 + k * 1024); } while (0)
#define PG8_LDB(dst, b, h) do { _Pragma("unroll") for (int n = 0; n < 2; ++n) _Pragma("unroll") for (int k = 0; k < 2; ++k) dst[n][k] = *(const PG8_LAS bf16x8*)(lds + PG8_SB(b, h) + boff + n * 2048 + k * 1024); } while (0)
#define PG8_MMA(ai, bj, At, Bt) do { __builtin_amdgcn_s_setprio(1); _Pragma("unroll") for (int m = 0; m < 4; ++m) _Pragma("unroll") for (int n = 0; n < 2; ++n) _Pragma("unroll") for (int k = 0; k < 2; ++k) \
        acc[ai][bj][m][n] = __builtin_amdgcn_mfma_f32_16x16x32_bf16(Bt[n][k], At[m][k], acc[ai][bj][m][n], 0, 0, 0); __builtin_amdgcn_s_setprio(0); } while (0)
#define PG8_WAIT_V(n) asm volatile("s_waitcnt vmcnt(" #n ")" ::: "memory")
#define PG8_WAIT_L(n) asm volatile("s_waitcnt lgkmcnt(" #n ")" ::: "memory")
#define PG8_BAR __builtin_amdgcn_s_barrier()
#define PG8_SCHED __builtin_amdgcn_sched_barrier(0)
    Unit cur, nxt; int ui = 0;
    if (!S.next(0, cur)) return;
    f32x4 acc[2][2][4][2];
#pragma unroll
    for (int a = 0; a < 2; ++a)
#pragma unroll
        for (int b = 0; b < 2; ++b)
#pragma unroll
            for (int m = 0; m < 4; ++m)
#pragma unroll
                for (int n = 0; n < 2; ++n) acc[a][b][m][n] = (f32x4){0.f, 0.f, 0.f, 0.f};
    bf16x8 At[4][2], B0[2][2], B1[2][2];
    const char* cA = (const char*)g.A + (size_t)cur.pm * tstepA; const char* cB = (const char*)g.Bt + (size_t)cur.pn * tstepB;
    S.a_ready(cur);
    if constexpr (SP2) {
        PG8_STAGE(PG8_SB(0, 0), cB, voffB); PG8_STAGE(PG8_SB(0, 1), cB + hstepB, voffB); PG8_STAGE(PG8_SA(0, 0), cA, voffA); PG8_STAGE(PG8_SA(0, 1), cA + hstepA, voffA);
        if (wr == 1) PG8_BAR;
        PG8_WAIT_V(2); PG8_BAR;
        PG8_STAGE(PG8_SB(1, 0), cB + kstep, voffB); PG8_STAGE(PG8_SA(1, 0), cA + kstep, voffA); PG8_STAGE(PG8_SB(1, 1), cB + hstepB + kstep, voffB);
        PG8_WAIT_V(6); PG8_BAR;
    } else {
        PG8_STAGE(PG8_SB(0, 0), cB, voffB); PG8_STAGE(PG8_SA(0, 0), cA, voffA); PG8_STAGE(PG8_SB(0, 1), cB + hstepB, voffB); PG8_STAGE(PG8_SA(0, 1), cA + hstepA, voffA);
        if (wr == 1) PG8_BAR;
        PG8_WAIT_V(4); PG8_BAR;
        PG8_STAGE(PG8_SB(1, 0), cB + kstep, voffB); PG8_STAGE(PG8_SA(1, 0), cA + kstep, voffA); PG8_STAGE(PG8_SB(1, 1), cB + hstepB + kstep, voffB);
        PG8_WAIT_V(6); PG8_BAR;
    }
    for (;;) {
        const bool has_next = S.next(ui + 1, nxt);
        const char* nA = has_next ? (const char*)g.A + (size_t)nxt.pm * tstepA : cA; const char* nB = has_next ? (const char*)g.Bt + (size_t)nxt.pn * tstepB : cB;
        for (int t = 0; t < nt; t += 2) {
            const bool last = (t == nt - 2);
            const char* a1 = cA + (size_t)(t + 1) * kstep;
            const char* a2 = last ? nA : cA + (size_t)(t + 2) * kstep; const char* b2 = last ? nB : cB + (size_t)(t + 2) * kstep;
            const char* a3 = a2 + kstep; const char* b3 = b2 + kstep;
            if (last && has_next) S.a_ready(nxt);
            if constexpr (SP2) {
            PG8_LDB(B0, 0, 0); PG8_LDB(B1, 0, 1); PG8_SCHED; PG8_LDA(At, 0, 0); PG8_STAGE(PG8_SA(1, 1), a1 + hstepA, voffA);
            PG8_WAIT_V(8); PG8_WAIT_L(0); PG8_BAR; PG8_MMA(0, 0, At, B0); PG8_MMA(0, 1, At, B1); PG8_BAR; PG8_SCHED;
            PG8_LDA(At, 0, 1); PG8_STAGE(PG8_SB(0, 0), b2, voffB); PG8_STAGE(PG8_SB(0, 1), b2 + hstepB, voffB); PG8_STAGE(PG8_SA(0, 0), a2, voffA);
            PG8_WAIT_V(8); PG8_WAIT_L(0); PG8_BAR; PG8_MMA(1, 0, At, B0); PG8_MMA(1, 1, At, B1); PG8_BAR; PG8_SCHED;
            PG8_LDB(B0, 1, 0); PG8_LDB(B1, 1, 1); PG8_SCHED; PG8_LDA(At, 1, 0); PG8_STAGE(PG8_SA(0, 1), a2 + hstepA, voffA);
            PG8_WAIT_V(8); PG8_WAIT_L(0); PG8_BAR; PG8_MMA(0, 0, At, B0); PG8_MMA(0, 1, At, B1); PG8_BAR; PG8_SCHED;
            PG8_LDA(At, 1, 1); PG8_STAGE(PG8_SB(1, 0), b3, voffB); PG8_STAGE(PG8_SB(1, 1), b3 + hstepB, voffB); PG8_STAGE(PG8_SA(1, 0), a3, voffA);
            PG8_WAIT_V(8); PG8_WAIT_L(0); PG8_BAR; PG8_MMA(1, 0, At, B0); PG8_MMA(1, 1, At, B1); PG8_BAR; PG8_SCHED;
            } else {
            PG8_LDB(B0, 0, 0); PG8_SCHED; PG8_LDA(At, 0, 0); PG8_STAGE(PG8_SA(1, 1), a1 + hstepA, voffA);
            PG8_WAIT_L(8); PG8_BAR; PG8_WAIT_L(0); PG8_MMA(0, 0, At, B0); PG8_BAR; PG8_SCHED;
            PG8_LDB(B1, 0, 1); PG8_STAGE(PG8_SB(0, 0), b2, voffB);
            PG8_BAR; PG8_WAIT_L(0); PG8_MMA(0, 1, At, B1); PG8_BAR;
            PG8_LDA(At, 0, 1); PG8_STAGE(PG8_SA(0, 0), a2, voffA);
            PG8_BAR; PG8_WAIT_L(0); PG8_MMA(1, 0, At, B0); PG8_BAR; PG8_SCHED;
            PG8_STAGE(PG8_SB(0, 1), b2 + hstepB, voffB);
            PG8_WAIT_V(6); PG8_BAR; PG8_MMA(1, 1, At, B1); PG8_BAR;
            PG8_LDB(B0, 1, 0); PG8_SCHED; PG8_LDA(At, 1, 0); PG8_STAGE(PG8_SA(0, 1), a2 + hstepA, voffA);
            PG8_WAIT_L(8); PG8_BAR; PG8_WAIT_L(0); PG8_MMA(0, 0, At, B0); PG8_BAR; PG8_SCHED;
            PG8_LDB(B1, 1, 1); PG8_STAGE(PG8_SB(1, 0), b3, voffB);
            PG8_BAR; PG8_WAIT_L(0); PG8_MMA(0, 1, At, B1); PG8_BAR;
            PG8_LDA(At, 1, 1); PG8_STAGE(PG8_SA(1, 0), a3, voffA);
            PG8_BAR; PG8_WAIT_L(0); PG8_MMA(1, 0, At, B0); PG8_BAR; PG8_SCHED;
            PG8_STAGE(PG8_SB(1, 1), b3 + hstepB, voffB);
            PG8_WAIT_V(6); PG8_BAR; PG8_MMA(1, 1, At, B1); PG8_BAR;
            }
        }
        if constexpr (ALIGN_EPI) { if (wr == 0) PG8_BAR; }
        if constexpr (!Epi::AFTER_DRAIN) { E(acc, cur, wr, wc, fr, fq); S.done(cur); }
        if (!has_next) break;
#pragma unroll
        for (int a = 0; a < 2; ++a)
#pragma unroll
            for (int b = 0; b < 2; ++b)
#pragma unroll
                for (int m = 0; m < 4; ++m)
#pragma unroll
                    for (int n = 0; n < 2; ++n) acc[a][b][m][n] = (f32x4){0.f, 0.f, 0.f, 0.f};
        cur = nxt; cA = nA; cB = nB; ++ui;
        if constexpr (ALIGN_EPI) { if (wr == 1) PG8_BAR; }
    }
    PG8_WAIT_V(0);
    if constexpr (!ALIGN_EPI) { if (wr == 0) PG8_BAR; }
    PG8_BAR;
    if constexpr (Epi::AFTER_DRAIN) { E.fused(acc, cur, wr, wc, fr, fq, lds, wid, lane); S.done(cur); }
#undef PG8_SA
#undef PG8_SB
#undef PG8_STAGE
#undef PG8_LDA
#undef PG8_LDB
#undef PG8_MMA
#undef PG8_WAIT_V
#undef PG8_WAIT_L
#undef PG8_BAR
#undef PG8_SCHED
}
}

namespace fa {
constexpr int D = 128;
constexpr int NW = 8, QBLK = 32, KVBLK = 64, QB = NW * QBLK;
constexpr int SHM_V = KVBLK * D * 2, SHM_K = KVBLK * D * 2, SHM_KP = KVBLK * 64 * 2;
constexpr int LDS_WS = 2 * SHM_V + 2 * SHM_K;
constexpr int LDS_KP = LDS_WS + NW * 64 * 4;
constexpr int LDS_BYTES = LDS_KP + 2 * SHM_KP;
constexpr float THR = 8.f;

using bf16 = __hip_bfloat16;
typedef short bf16x8 __attribute__((ext_vector_type(8)));
typedef short s16x4 __attribute__((ext_vector_type(4)));
typedef float f32x16 __attribute__((ext_vector_type(16)));
typedef float f32x4 __attribute__((ext_vector_type(4)));
typedef unsigned u32x4 __attribute__((ext_vector_type(4)));

#define KSWZ(row, colB) ((row) * 256 + ((colB) ^ (((row) & 7) << 4)))
#define KPSWZ(row, colB) ((row) * 128 + ((colB) ^ (((row) & 7) << 4)))
#define SBAR() __builtin_amdgcn_sched_barrier(0)
__device__ __forceinline__ int v_st(int k, int c) { const int kk = (k & ~0xC) | ((k & 4) << 1) | ((k & 8) >> 1); return ((kk >> 3) * 4 + (c >> 5)) * 512 + ((kk & 7) * 32 + (c & 31)) * 2; }
__device__ __forceinline__ int v_rd_base(int lane) { return ((lane & 3) << 3) | (((lane >> 2) & 3) << 6) | (((lane >> 4) & 1) << 5) | (((lane >> 5) & 1) << 8); }
constexpr int v_rd_off(int d0, int ks, int half) { return d0 * 512 + ks * 4096 + half * 2048; }
__device__ __forceinline__ int crow(int r, int hi) { return (r & 3) + 8 * (r >> 2) + 4 * hi; }
__device__ __forceinline__ unsigned cvtpk(float lo, float hi) {
    unsigned r; asm volatile("v_cvt_pk_bf16_f32 %0, %1, %2" : "=v"(r) : "v"(lo), "v"(hi)); return r;
}
__device__ __forceinline__ bf16x8 load8(const bf16* p) { return *reinterpret_cast<const bf16x8*>(p); }
__device__ __forceinline__ void mask_tile(f32x16& p0, f32x16& p1, int dq, unsigned W) {
    const float NEG = -__builtin_inff();
#pragma unroll
    for (int r = 0; r < 16; ++r) {
        const int c = (r & 3) + 8 * (r >> 2);
        if ((unsigned)(dq - c) >= W) p0[r] = NEG;
        if ((unsigned)(dq - c - 32) >= W) p1[r] = NEG;
    }
}
template <class C>
__device__ __forceinline__ void partialSM(f32x16& p0, f32x16& p1, float& m_reg, float& mn, float& alpha) {
    float pmax = p0[0]; for (int r = 1; r < 16; ++r) pmax = fmaxf(pmax, p0[r]); for (int r = 0; r < 16; ++r) pmax = fmaxf(pmax, p1[r]);
    { auto rr = __builtin_amdgcn_permlane32_swap(__float_as_uint(pmax), __float_as_uint(pmax), false, false);
      pmax = fmaxf(__uint_as_float(rr[0]), __uint_as_float(rr[1])); }
    constexpr float C2 = 1.4426950408889634f * C::SCALE;
    if (__builtin_expect(__all((pmax - m_reg) * C::SCALE <= THR), 1)) { mn = m_reg; alpha = 1.f; }
    else { mn = fmaxf(m_reg, pmax); alpha = __builtin_amdgcn_exp2f((m_reg - mn) * C2); m_reg = mn; }
    const float mnL = -mn * C2;
    for (int r = 0; r < 16; ++r) p0[r] = fmaf(p0[r], C2, mnL); for (int r = 0; r < 16; ++r) p1[r] = fmaf(p1[r], C2, mnL);
    for (int r = 0; r < 16; ++r) p0[r] = __builtin_amdgcn_exp2f(p0[r]);
}
#define FA_PK4(P, B_, OUT) do { unsigned a0 = cvtpk(P[B_+0], P[B_+1]), a1 = cvtpk(P[B_+2], P[B_+3]);                          \
        unsigned b0 = cvtpk(P[B_+4], P[B_+5]), b1 = cvtpk(P[B_+6], P[B_+7]);                                             \
        auto r0 = __builtin_amdgcn_permlane32_swap(a0, b0, false, false); auto r1 = __builtin_amdgcn_permlane32_swap(a1, b1, false, false); \
        u32x4 w = {r0[0], r1[0], r0[1], r1[1]}; OUT = *reinterpret_cast<bf16x8*>(&w); } while (0)
__device__ __forceinline__ void finishSM(f32x16& p0, f32x16& p1, float alpha, float& l_reg, bf16x8& pa0, bf16x8& pa1, bf16x8& pa2, bf16x8& pa3) {
    for (int r = 0; r < 16; ++r) p1[r] = __builtin_amdgcn_exp2f(p1[r]);
    float ps = 0; for (int r = 0; r < 16; ++r) ps += p0[r]; for (int r = 0; r < 16; ++r) ps += p1[r];
    { auto rr = __builtin_amdgcn_permlane32_swap(__float_as_uint(ps), __float_as_uint(ps), false, false);
      ps = __uint_as_float(rr[0]) + __uint_as_float(rr[1]); }
    l_reg = l_reg * alpha + ps;
    FA_PK4(p0, 0, pa0); FA_PK4(p0, 8, pa1); FA_PK4(p1, 0, pa2); FA_PK4(p1, 8, pa3);
}
__device__ __forceinline__ void packP(f32x16& p0, f32x16& p1, bf16x8& pa0, bf16x8& pa1, bf16x8& pa2, bf16x8& pa3) {
    FA_PK4(p0, 0, pa0); FA_PK4(p0, 8, pa1); FA_PK4(p1, 0, pa2); FA_PK4(p1, 8, pa3);
}
template <int KB, bool SK, bool PE>
__device__ __forceinline__ void qkt(f32x16& p0, f32x16& p1, const char* K_lds, const char* KP_lds, int r32, int hi, const bf16x8* qr, bool act) {
    if (SK && !act) { const float NEG = -__builtin_inff();
#pragma unroll
        for (int r = 0; r < 16; ++r) { p0[r] = NEG; p1[r] = NEG; } return; }
    p0 = f32x16{}; p1 = f32x16{};
    const char* kb[4];
#pragma unroll
    for (int dd = 0; dd < 4; ++dd) kb[dd] = K_lds + KB * SHM_K + KSWZ(r32, (dd * 16 + hi * 8) * 2);
#pragma unroll
    for (int d0 = 0; d0 < 8; ++d0) { const char* a = kb[d0 & 3] + (d0 >> 2) * 128;
        bf16x8 b0 = *reinterpret_cast<const bf16x8*>(a);
        bf16x8 b1 = *reinterpret_cast<const bf16x8*>(a + 32 * 256);
        p0 = __builtin_amdgcn_mfma_f32_32x32x16_bf16(b0, qr[d0], p0, 0, 0, 0);
        p1 = __builtin_amdgcn_mfma_f32_32x32x16_bf16(b1, qr[d0], p1, 0, 0, 0); }
    if constexpr (PE) {
#pragma unroll
        for (int d0 = 0; d0 < 4; ++d0) { const char* a = KP_lds + KB * SHM_KP + KPSWZ(r32, (d0 * 16 + hi * 8) * 2);
            bf16x8 b0 = *reinterpret_cast<const bf16x8*>(a);
            bf16x8 b1 = *reinterpret_cast<const bf16x8*>(a + 32 * 128);
            p0 = __builtin_amdgcn_mfma_f32_32x32x16_bf16(b0, qr[8 + d0], p0, 0, 0, 0);
            p1 = __builtin_amdgcn_mfma_f32_32x32x16_bf16(b1, qr[8 + d0], p1, 0, 0, 0); }
    }
}
template <int VB, bool SK>
__device__ __forceinline__ void pv_tile(f32x16* o, int vb0, bf16x8 pa0, bf16x8 pa1, bf16x8 pa2, bf16x8 pa3, bool act) {
    if (SK && !act) return;
#define TRRD(dst, off) asm volatile("ds_read_b64_tr_b16 %0, %1 offset:%2" : "=&v"(dst) : "v"(vb0), "i"(off) : "memory")
#define PV_D0(d0) do { s16x4 l0, l1, l2, l3, h0, h1, h2, h3; constexpr int b_ = VB * SHM_V + v_rd_off(d0, 0, 0);     \
        TRRD(l0, b_); TRRD(h0, b_ + 2048); TRRD(l1, b_ + 4096); TRRD(h1, b_ + 6144); TRRD(l2, b_ + 8192); TRRD(h2, b_ + 10240); TRRD(l3, b_ + 12288); TRRD(h3, b_ + 14336); \
        asm volatile("s_waitcnt lgkmcnt(0)" ::: "memory"); SBAR();   \
        o[d0] = __builtin_amdgcn_mfma_f32_32x32x16_bf16(pa0, (bf16x8){l0[0], l0[1], l0[2], l0[3], h0[0], h0[1], h0[2], h0[3]}, o[d0], 0, 0, 0);   \
        o[d0] = __builtin_amdgcn_mfma_f32_32x32x16_bf16(pa1, (bf16x8){l1[0], l1[1], l1[2], l1[3], h1[0], h1[1], h1[2], h1[3]}, o[d0], 0, 0, 0);   \
        o[d0] = __builtin_amdgcn_mfma_f32_32x32x16_bf16(pa2, (bf16x8){l2[0], l2[1], l2[2], l2[3], h2[0], h2[1], h2[2], h2[3]}, o[d0], 0, 0, 0);   \
        o[d0] = __builtin_amdgcn_mfma_f32_32x32x16_bf16(pa3, (bf16x8){l3[0], l3[1], l3[2], l3[3], h3[0], h3[1], h3[2], h3[3]}, o[d0], 0, 0, 0); } while (0)
    PV_D0(0); PV_D0(1); PV_D0(2); PV_D0(3);
#undef PV_D0
#undef TRRD
}

template <int QS_, int OS_, bool PE_, bool SK_, int SCALE_NUM> struct Cfg {
    static constexpr int QS = QS_, OS = OS_; static constexpr bool PE = PE_, SK = SK_;
    static constexpr float SCALE = SCALE_NUM == 128 ? 0.08838834764831845f : 0.07216878364870323f;
    static constexpr int NQ = PE_ ? 12 : 8;
};
struct BlockRef { const bf16* Q; const bf16* K; const bf16* V; const bf16* KP; bf16* O; float* L; int P0; };
template <class C> struct Seam { bf16x8 qr[C::NQ]; bf16x8 st_v0, st_v1, st_k0, st_k1, st_p; };
__device__ __forceinline__ int swa_jlo(int P0, int W) { const int lowk = P0 - W + 1; return lowk > 0 ? lowk / KVBLK : 0; }
#define ROW(p, k0, rr) ((p) + (size_t)((k0) + (rr)) * D + sc)
#define VMW() asm volatile("s_waitcnt vmcnt(0)" ::: "memory")
#define VMWN(n) asm volatile("s_waitcnt vmcnt(%0)" :: "i"(n) : "memory")
#define SLOAD_H(Kp, Vp, KPp, k0) do { S.st_v0 = load8(ROW(Vp, k0, sr)); S.st_v1 = load8(ROW(Vp, k0, 32 + sr));              \
                         S.st_k0 = load8(ROW(Kp, k0, sr)); S.st_k1 = load8(ROW(Kp, k0, 32 + sr));                           \
                         if constexpr (C::PE) S.st_p = load8((KPp) + (size_t)((k0) + pr) * 64 + pc); } while (0)
#define SWRITE_HK(bf) do { *(bf16x8*)(K_lds + (bf) * SHM_K + kws) = S.st_k0; *(bf16x8*)(K_lds + (bf) * SHM_K + kws + 32 * 256) = S.st_k1; \
                           if constexpr (C::PE) *(bf16x8*)(KP_lds + (bf) * SHM_KP + pws) = S.st_p; } while (0)
#define SWRITE_HV(bf) do { *(bf16x8*)(V_lds + (bf) * SHM_V + vst0) = S.st_v0; *(bf16x8*)(V_lds + (bf) * SHM_V + vst1) = S.st_v1; } while (0)
#define SWRITE_H(bf) do { SWRITE_HV(bf); SWRITE_HK(bf); } while (0)
#define QLOADS(ref) do { _Pragma("unroll") for (int d0 = 0; d0 < 8; ++d0) S.qr[d0] = load8((ref).Q + (size_t)(wid * QBLK + r32) * C::QS + d0 * 16 + hi * 8); \
        if constexpr (C::PE) { _Pragma("unroll") for (int d0 = 0; d0 < 4; ++d0) S.qr[8 + d0] = load8((ref).Q + (size_t)(wid * QBLK + r32) * C::QS + 128 + d0 * 16 + hi * 8); } } while (0)
template <class C>
__device__ __forceinline__ void prime(const BlockRef& cur, int W, char* lds, Seam<C>& S) {
    int tid_ = threadIdx.x; asm volatile("" : "+v"(tid_)); const int tid = tid_, wid = __builtin_amdgcn_readfirstlane(tid >> 6), lane = tid & 63, r32 = lane & 31, hi = lane >> 5;
    const int sr = tid >> 4, sc = (tid & 15) * 8, kws = KSWZ(sr, sc * 2); char* K_lds = lds + 2 * SHM_V; char* KP_lds = lds + LDS_KP;
    const int pr = tid >> 3, pc = (tid & 7) * 8, pws = KPSWZ(pr, pc * 2);
    const int kb0 = swa_jlo(cur.P0, W) * KVBLK;
    QLOADS(cur);
    SLOAD_H(cur.K, cur.V, cur.KP, kb0); VMW(); SWRITE_HK(0);
    __syncthreads();
}
template <class C>
__device__ __forceinline__ void block(const BlockRef& cur, const BlockRef& nxt, int skv, int W, char* lds, Seam<C>& S) {
    constexpr bool SK = C::SK, PE = C::PE;
    int tid_ = threadIdx.x; asm volatile("" : "+v"(tid_)); const int tid = tid_, wid = __builtin_amdgcn_readfirstlane(tid >> 6), lane = tid & 63, r32 = lane & 31, hi = lane >> 5;
    const int j_lo = swa_jlo(cur.P0, W);
    int j_hi = (cur.P0 + QB - 1) / KVBLK + 1; if (j_hi > skv / KVBLK) j_hi = skv / KVBLK;
    const int NT = j_hi - j_lo;
    const int kbn = swa_jlo(nxt.P0, W) * KVBLK;
    const int qlo = cur.P0 + wid * QBLK, qm = qlo + r32 - 4 * hi;
    char* V_lds = lds; char* K_lds = lds + 2 * SHM_V; char* KP_lds = lds + LDS_KP;
    float* ws = (float*)(lds + LDS_WS) + wid * 64; float* li_l = ws, * al_l = ws + 32;
    float m_reg = -1e30f, l_reg = 0; f32x16 o[4] = {};
    const int sr = tid >> 4, sc = (tid & 15) * 8, vst0 = v_st(sr, sc), vst1 = v_st(32 + sr, sc), kws = KSWZ(sr, sc * 2);
    const int pr = tid >> 3, pc = (tid & 7) * 8, pws = KPSWZ(pr, pc * 2);
    const int vb0 = (int)(uintptr_t)V_lds + v_rd_base(lane);
    const bf16* Kh = cur.K; const bf16* Vh = cur.V; const bf16* KPh = cur.KP;
#define RESC(a) do { if (__any((a) < 1.f)) { if (hi == 0) al_l[r32] = (a); asm volatile("s_waitcnt lgkmcnt(0)" ::: "memory");              \
                     for (int d_ = 0; d_ < 4; ++d_) for (int r = 0; r < 16; ++r) o[d_][r] *= al_l[crow(r, hi)]; } } while (0)
#define KBASE(t) ((j_lo + (t)) * KVBLK)
#define ACT(t) (KBASE(t) <= qlo + QBLK - 1 && KBASE(t) + KVBLK - 1 >= qlo - W + 1)
#define MASKT(P0_, P1_, t) do { const int kb_ = KBASE(t); if ((!SK || ACT(t)) && (kb_ + KVBLK - 1 > qlo || kb_ <= qlo + QBLK - 1 - W)) mask_tile(P0_, P1_, qm - kb_, (unsigned)W); } while (0)
    constexpr int NQL = C::NQ;
#define SEAM_K0() do { VMWN(NQL); SWRITE_HK(0); SBAR(); } while (0)
    f32x16 pA0, pA1, pB0, pB1; float mnA, mnB, alA, alB; bf16x8 pa0, pa1, pa2, pa3;
    SWRITE_HV(0); SBAR();
    if (NT > 1) { SLOAD_H(Kh, Vh, KPh, KBASE(1)); }
    SBAR(); qkt<0, SK, PE>(pA0, pA1, K_lds, KP_lds, r32, hi, S.qr, ACT(0));
    MASKT(pA0, pA1, 0); partialSM<C>(pA0, pA1, m_reg, mnA, alA);
    if (NT > 1) { VMW(); SWRITE_H(1); }
    __syncthreads();
#define HALF_STEP(PX0, PX1, mnX, alX, PY0, PY1, alY, t, KB, VB, SB) do {                                                      \
        SBAR(); qkt<KB, SK, PE>(PX0, PX1, K_lds, KP_lds, r32, hi, S.qr, ACT(t));                                             \
        finishSM(PY0, PY1, alY, l_reg, pa0, pa1, pa2, pa3); SBAR();                                                           \
        if ((t) + 1 < NT) { SLOAD_H(Kh, Vh, KPh, KBASE((t) + 1)); SBAR(); }                                               \
        pv_tile<VB, SK>(o, vb0, pa0, pa1, pa2, pa3, ACT((t) - 1)); MASKT(PX0, PX1, (t)); partialSM<C>(PX0, PX1, m_reg, mnX, alX);                                        \
        __syncthreads();                                                                                                      \
        if ((t) + 1 < NT) { VMW(); SWRITE_H(SB); }                                                                          \
        RESC(alX); __syncthreads(); } while (0)
    for (int t = 1; t + 1 < NT; t += 2) {
        HALF_STEP(pB0, pB1, mnB, alB, pA0, pA1, alA, t, 1, 0, 0);
        HALF_STEP(pA0, pA1, mnA, alA, pB0, pB1, alB, t + 1, 0, 1, 1);
    }
    const bool even = (NT & 1) == 0;
    if (even) { SBAR(); qkt<1, SK, PE>(pB0, pB1, K_lds, KP_lds, r32, hi, S.qr, ACT(NT - 1)); SBAR(); }
    SLOAD_H(nxt.K, nxt.V, nxt.KP, kbn); SBAR();
    QLOADS(nxt);
    SBAR();
    finishSM(pA0, pA1, alA, l_reg, pa0, pa1, pa2, pa3); SBAR();
    pv_tile<0, SK>(o, vb0, pa0, pa1, pa2, pa3, ACT(even ? NT - 2 : NT - 1));
    if (even) { MASKT(pB0, pB1, NT - 1); partialSM<C>(pB0, pB1, m_reg, mnB, alB); __syncthreads(); RESC(alB);
        finishSM(pB0, pB1, alB, l_reg, pa0, pa1, pa2, pa3); SBAR(); pv_tile<1, SK>(o, vb0, pa0, pa1, pa2, pa3, ACT(NT - 1)); }
    SBAR(); SEAM_K0();
    if (hi == 0) li_l[r32] = l_reg; asm volatile("s_waitcnt lgkmcnt(0)" ::: "memory");
    if (cur.L != nullptr && hi == 0) cur.L[wid * QBLK + r32] = m_reg * C::SCALE + __logf(l_reg);
    float rli[16];
#pragma unroll
    for (int r = 0; r < 16; ++r) rli[r] = __builtin_amdgcn_rcpf(li_l[crow(r, hi)]);
    bf16* Ow = cur.O + (size_t)(wid * QBLK) * C::OS;
#pragma unroll
    for (int r = 0; r < 16; ++r) { const int orow = crow(r, hi);
#pragma unroll
        for (int d0 = 0; d0 < 4; ++d0) { const float v = o[d0][r] * rli[r];
            const float vn = __shfl_xor(v, 1);
            if ((r32 & 1) == 0) *(unsigned*)(Ow + (size_t)orow * C::OS + d0 * 32 + r32) = cvtpk(v, vn); } }
    __syncthreads();
#undef RESC
#undef KBASE
#undef ACT
#undef MASKT
#undef SEAM_K0
#undef HALF_STEP
}

template <class C>
__device__ __forceinline__ void block_simple(const BlockRef& cur, int skv, int W, char* lds) {
    constexpr bool SK = C::SK, PE = C::PE;
    Seam<C> S;
    int tid_ = threadIdx.x; asm volatile("" : "+v"(tid_)); const int tid = tid_, wid = __builtin_amdgcn_readfirstlane(tid >> 6), lane = tid & 63, r32 = lane & 31, hi = lane >> 5;
    const int j_lo = swa_jlo(cur.P0, W);
    int j_hi = (cur.P0 + QB - 1) / KVBLK + 1; if (j_hi > skv / KVBLK) j_hi = skv / KVBLK;
    const int NT = j_hi - j_lo;
    const int qlo = cur.P0 + wid * QBLK, qm = qlo + r32 - 4 * hi;
    char* V_lds = lds; char* K_lds = lds + 2 * SHM_V; char* KP_lds = lds + LDS_KP;
    float* ws = (float*)(lds + LDS_WS) + wid * 64; float* li_l = ws, * al_l = ws + 32;
    float m_reg = -1e30f, l_reg = 0; f32x16 o[4] = {};
    const int sr = tid >> 4, sc = (tid & 15) * 8, vst0 = v_st(sr, sc), vst1 = v_st(32 + sr, sc), kws = KSWZ(sr, sc * 2);
    const int pr = tid >> 3, pc = (tid & 7) * 8, pws = KPSWZ(pr, pc * 2);
    const int vb0 = (int)(uintptr_t)V_lds + v_rd_base(lane);
    const bf16* Kh = cur.K; const bf16* Vh = cur.V; const bf16* KPh = cur.KP;
#define KBASE(t) ((j_lo + (t)) * KVBLK)
#define ACT(t) (KBASE(t) <= qlo + QBLK - 1 && KBASE(t) + KVBLK - 1 >= qlo - W + 1)
#define MASKT(P0_, P1_, t) do { const int kb_ = KBASE(t); if ((!SK || ACT(t)) && (kb_ + KVBLK - 1 > qlo || kb_ <= qlo + QBLK - 1 - W)) mask_tile(P0_, P1_, qm - kb_, (unsigned)W); } while (0)
#define RESC(a) do { if (__any((a) < 1.f)) { if (hi == 0) al_l[r32] = (a); asm volatile("s_waitcnt lgkmcnt(0)" ::: "memory");              \
                     for (int d_ = 0; d_ < 4; ++d_) for (int r = 0; r < 16; ++r) o[d_][r] *= al_l[crow(r, hi)]; } } while (0)
    QLOADS(cur);
    SLOAD_H(Kh, Vh, KPh, KBASE(0)); VMW(); SWRITE_H(0);
    __syncthreads();
    f32x16 p0, p1; float mn, al; bf16x8 pa0, pa1, pa2, pa3;
#define STEP(t, BUF) do { \
        if ((t) + 1 < NT) { SLOAD_H(Kh, Vh, KPh, KBASE((t) + 1)); SBAR(); } \
        qkt<BUF, SK, PE>(p0, p1, K_lds, KP_lds, r32, hi, S.qr, ACT(t)); \
        MASKT(p0, p1, (t)); partialSM<C>(p0, p1, m_reg, mn, al); finishSM(p0, p1, al, l_reg, pa0, pa1, pa2, pa3); RESC(al); SBAR(); \
        pv_tile<BUF, SK>(o, vb0, pa0, pa1, pa2, pa3, ACT(t)); \
        if ((t) + 1 < NT) { VMW(); SWRITE_H(1 - BUF); } \
        __syncthreads(); } while (0)
    for (int t = 0; t < NT; t += 2) {
        STEP(t, 0);
        if (t + 1 < NT) STEP(t + 1, 1);
    }
#undef STEP
    if (hi == 0) li_l[r32] = l_reg; asm volatile("s_waitcnt lgkmcnt(0)" ::: "memory");
    if (cur.L != nullptr && hi == 0) cur.L[wid * QBLK + r32] = m_reg * C::SCALE + __logf(l_reg);
    float rli[16];
#pragma unroll
    for (int r = 0; r < 16; ++r) rli[r] = __builtin_amdgcn_rcpf(li_l[crow(r, hi)]);
    bf16* Ow = cur.O + (size_t)(wid * QBLK) * C::OS;
#pragma unroll
    for (int r = 0; r < 16; ++r) { const int orow = crow(r, hi);
#pragma unroll
        for (int d0 = 0; d0 < 4; ++d0) { const float v = o[d0][r] * rli[r];
            const float vn = __shfl_xor(v, 1);
            if ((r32 & 1) == 0) *(unsigned*)(Ow + (size_t)orow * C::OS + d0 * 32 + r32) = cvtpk(v, vn); } }
    __syncthreads();
#undef RESC
#undef KBASE
#undef ACT
#undef MASKT
}
#undef ROW
#undef VMW
#undef VMWN
#undef SLOAD_H
#undef SWRITE_HK
#undef SWRITE_HV
#undef SWRITE_H
#undef QLOADS
}
constexpr int BATCH = 2, SEQ = 16384, DM = 2048, MTOK = BATCH * SEQ, DFF = 8192;
constexpr float EPS = 1e-6f;
constexpr int NWAVES = 8, NTHREADS = 512;
constexpr int LDS_BAR_ST = 159744 - 64;
constexpr int LDS_BYTES = 159744;
constexpr size_t MiB = 1u << 20;
typedef unsigned short bf16_t;
typedef float f32x4 __attribute__((ext_vector_type(4)));
typedef unsigned u32x4 __attribute__((ext_vector_type(4)));
typedef unsigned u32x2 __attribute__((ext_vector_type(2)));

constexpr size_t W_L1_WIN = 0;
constexpr size_t W_L1_WOUT = W_L1_WIN + (size_t)9216 * 2048 * 2;
constexpr size_t W_L1_FF1 = W_L1_WOUT + (size_t)2048 * 1024 * 2;
constexpr size_t W_L1_FF2 = W_L1_FF1 + (size_t)8192 * 2048 * 2;
constexpr size_t W_L0_WIN = W_L1_FF2 + (size_t)2048 * 8192 * 2;
constexpr size_t W_L0_WOUT = W_L0_WIN + (size_t)3584 * 2048 * 2;
constexpr size_t W_L0_FF1 = W_L0_WOUT + (size_t)2048 * 2048 * 2;
constexpr size_t W_L0_FF2 = W_L0_FF1 + (size_t)8192 * 2048 * 2;
constexpr size_t W_UQ = W_L0_FF2 + (size_t)2048 * 8192 * 2;
constexpr size_t W_UKV = W_UQ + (size_t)1536 * 512 * 2;
constexpr size_t W_C1 = W_UKV + (size_t)2048 * 256 * 2;
constexpr size_t W_C2 = W_C1 + (size_t)256 * 4096 * 2;
constexpr size_t W_END = W_C2 + (size_t)256 * 256 * 2;
constexpr size_t SM_BASE = 196 * MiB;
static_assert(W_END <= SM_BASE, "weights");
constexpr size_t SM_ROPE_C = SM_BASE;
constexpr size_t SM_ROPE_S = SM_ROPE_C + (size_t)SEQ * 64 * 4;
constexpr size_t SM_ROPE2_C = SM_ROPE_S + (size_t)SEQ * 64 * 4;
constexpr size_t SM_ROPE2_S = SM_ROPE2_C + (size_t)SEQ * 32 * 4;
constexpr size_t SM_ROWSQ = SM_ROPE2_S + (size_t)SEQ * 32 * 4;
enum { RS_X = 0, RS_H1, RS_H2, RS_H3, RS_CQ = 4  , RS_CKV = 6  , RS_N = 8 };
constexpr size_t SM_CBIAS = SM_ROWSQ + (size_t)RS_N * MTOK * 4;
constexpr size_t SM_GATE = SM_CBIAS + 1024;
constexpr size_t SM_LSE = SM_GATE + (size_t)MTOK * 24 * 4;
constexpr size_t SM_END = SM_LSE + (size_t)3 * MTOK * 8 * 4;
constexpr size_t SM_BAR = (SM_END + 255) / 256 * 256;
constexpr size_t ACT_BASE = 216 * MiB;
static_assert(SM_BAR + 16384 <= ACT_BASE, "barrier words");
static_assert(SM_END <= ACT_BASE, "small");
constexpr size_t A_HB = ACT_BASE;
constexpr size_t A_QN = A_HB + 128 * MiB;
constexpr size_t A_KV = A_QN + 64 * MiB;
constexpr size_t A_KVPAD = A_KV + 96 * MiB;
constexpr size_t A_VST = A_KVPAD + 1 * MiB;
constexpr size_t A_CQ = A_VST + 16 * MiB;
constexpr size_t A_CKV = A_CQ + 32 * MiB;
constexpr size_t A_KPE = A_CKV + 16 * MiB;
constexpr size_t A_HC = A_KPE + 4 * MiB;
constexpr size_t A_KCMP = A_HC + 4 * MiB;
constexpr size_t A_VCMP = A_KCMP + 1 * MiB;
constexpr size_t A_OW = A_VCMP + 1 * MiB;
constexpr size_t A_O = A_OW + 64 * MiB;
constexpr size_t A_MM = A_O + 128 * MiB;
constexpr size_t A_OP = A_MM + 128 * MiB;
constexpr size_t A_KST = A_OP + 64 * MiB;
constexpr size_t A_L0_END = A_KST + 16 * MiB;
static_assert(A_L0_END <= 1024 * MiB, "layer-0 map");
constexpr size_t DO_MQ = 0, DO_MK = 96 * MiB, DO_MV = 160 * MiB;
constexpr size_t A_F = A_HB + 128 * MiB;
constexpr size_t A_HID = A_F + 128 * MiB;
static_assert(A_HID + 512 * MiB <= 1024 * MiB, "ffn map");
constexpr size_t A_Z1 = A_HB + 128 * MiB;
constexpr size_t A_OG0 = A_Z1 + 576 * MiB;
constexpr size_t A_OG1 = W_L0_WIN;
constexpr size_t A_OG2 = A_HB;
static_assert(A_OG0 + 64 * MiB <= 1024 * MiB && A_OG1 + 64 * MiB <= SM_BASE, "OG map");
constexpr size_t A_O1 = A_HB + 64 * MiB;
constexpr size_t A_MM1 = A_Z1;
static_assert(A_Z1 + 576 * MiB <= 1024 * MiB, "layer-1 map");
namespace nsa {
using namespace fa;
constexpr int IMP_STRIDE = 257;
constexpr int LDS_IMP = 84992;
constexpr int LDS_SEL = LDS_IMP + 64 * IMP_STRIDE * 4;
constexpr int LDS_CNT = LDS_SEL + 64 * 16 * 2;
constexpr int LDS_END = LDS_CNT + 64 * 4;
constexpr float C2 = 1.4426950408889634f * 0.08838834764831845f;
typedef float f32x4v __attribute__((ext_vector_type(4)));
using CN = Cfg<128, 128, false, false, 128>;

struct Tensors {
    const bf16* QN;
    const bf16* KC;
    const bf16* VC;
    const bf16* KST;
    const bf16* VST;
    const bf16* OW;
    bf16* OP;
    const float* GATE;
    bf16* O;
};

__device__ __forceinline__ unsigned long long wave_max_u64(unsigned long long v) {
#pragma unroll
    for (int o = 1; o < 64; o <<= 1) { const unsigned long long w = __shfl_xor(v, o); v = w > v ? w : v; }
    return v;
}

__device__ __forceinline__ void slc_row(const Tensors& T, int b, int g, int t, const short* selrow, int cnt, int lane) {
    constexpr int S = 16384;
    const int col = lane & 15, q4 = lane >> 4;
    const size_t bg = (size_t)(b * 2 + g);
    bf16x8 Bq[4];
    { const bf16* qp = T.QN + (((size_t)(b * 8 + 4 * g + (col & 3)) * S + t) * 128) + 8 * q4;
#pragma unroll
      for (int ks = 0; ks < 4; ++ks) { bf16x8 v = load8(qp + 32 * ks); if (col >= 4) v = (bf16x8){0, 0, 0, 0, 0, 0, 0, 0}; Bq[ks] = v; } }
    float m_run = -1e30f, l_run = 0.f;
    f32x4v oacc[8];
#pragma unroll
    for (int i = 0; i < 8; ++i) oacc[i] = (f32x4v){0.f, 0.f, 0.f, 0.f};
    const bf16* Kbase = T.KST + bg * 256 * 8192 + (size_t)lane * 8;
    const bf16* Vbase = T.VST + bg * 256 * 8192 + (size_t)lane * 8;
    bf16x8 Kf[16];
    int jb = __builtin_amdgcn_readfirstlane((int)selrow[0]);
    { const bf16* Kb = Kbase + (size_t)jb * 8192;
#pragma unroll
      for (int c = 0; c < 16; ++c) Kf[c] = load8(Kb + c * 512); }
    for (int i = 0; i < cnt; ++i) {
        const bf16* Vb = Vbase + (size_t)jb * 8192;
        bf16x8 Va[16];
#pragma unroll
        for (int c = 0; c < 16; ++c) Va[c] = load8(Vb + c * 512);
        f32x4v sacc[4];
#pragma unroll
        for (int kg = 0; kg < 4; ++kg) { sacc[kg] = (f32x4v){0.f, 0.f, 0.f, 0.f};
#pragma unroll
            for (int ks = 0; ks < 4; ++ks) sacc[kg] = __builtin_amdgcn_mfma_f32_16x16x32_bf16(Kf[kg * 4 + ks], Bq[ks], sacc[kg], 0, 0, 0); }
        const int kbase = 64 * jb + 4 * q4;
        if (i + 1 < cnt) {
            jb = __builtin_amdgcn_readfirstlane((int)selrow[i + 1]);
            const bf16* Kb = Kbase + (size_t)jb * 8192;
#pragma unroll
            for (int c = 0; c < 16; ++c) Kf[c] = load8(Kb + c * 512);
        }
        float mx = -__builtin_inff();
#pragma unroll
        for (int kg = 0; kg < 4; ++kg)
#pragma unroll
            for (int r = 0; r < 4; ++r) { if (kbase + 16 * kg + r > t) sacc[kg][r] = -__builtin_inff(); mx = fmaxf(mx, sacc[kg][r]); }
        mx = fmaxf(mx, __shfl_xor(mx, 16)); mx = fmaxf(mx, __shfl_xor(mx, 32));
        const float m_new = fmaxf(m_run, mx);
        const float alpha = __builtin_amdgcn_exp2f((m_run - m_new) * C2);
        m_run = m_new;
        const float mL = -m_new * C2;
        float ps = 0.f;
#pragma unroll
        for (int kg = 0; kg < 4; ++kg)
#pragma unroll
            for (int r = 0; r < 4; ++r) { const float p = __builtin_amdgcn_exp2f(fmaf(sacc[kg][r], C2, mL)); sacc[kg][r] = p; ps += p; }
        l_run = l_run * alpha + ps;
#pragma unroll
        for (int dg = 0; dg < 8; ++dg) oacc[dg] = oacc[dg] * alpha;
        bf16x8 Bp[2];
#pragma unroll
        for (int kp = 0; kp < 2; ++kp) { u32x4 w = {cvtpk(sacc[2 * kp][0], sacc[2 * kp][1]), cvtpk(sacc[2 * kp][2], sacc[2 * kp][3]),
                                                    cvtpk(sacc[2 * kp + 1][0], sacc[2 * kp + 1][1]), cvtpk(sacc[2 * kp + 1][2], sacc[2 * kp + 1][3])};
            Bp[kp] = *reinterpret_cast<bf16x8*>(&w); }
#pragma unroll
        for (int dg = 0; dg < 8; ++dg)
#pragma unroll
            for (int kp = 0; kp < 2; ++kp) oacc[dg] = __builtin_amdgcn_mfma_f32_16x16x32_bf16(Va[dg * 2 + kp], Bp[kp], oacc[dg], 0, 0, 0);
    }
    l_run += __shfl_xor(l_run, 16); l_run += __shfl_xor(l_run, 32);
    if (col < 4) {
        const int head = 4 * g + col;
        const size_t m = (size_t)b * S + t;
        const float g1 = T.GATE[m * 24 + head * 3 + 1];
        const float sc = l_run > 0.f ? g1 / l_run : 0.f;
        const bf16* pre = T.OP + (((size_t)(b * 8 + head) * S + t) * 128) + 4 * q4;
        bf16* out = T.O + m * 2048 + head * 128 + 4 * q4;
#pragma unroll
        for (int dg = 0; dg < 8; ++dg) {
            const unsigned long long pv64 = __hip_atomic_load(reinterpret_cast<const unsigned long long*>(pre + 16 * dg), __ATOMIC_RELAXED, __HIP_MEMORY_SCOPE_AGENT);
            uint2 pv; pv.x = (unsigned)pv64; pv.y = (unsigned)(pv64 >> 32);
            const float a0 = __uint_as_float(pv.x << 16), a1 = __uint_as_float(pv.x & 0xffff0000u), a2 = __uint_as_float(pv.y << 16), a3 = __uint_as_float(pv.y & 0xffff0000u);
            uint2 w; w.x = cvtpk(a0 + sc * oacc[dg][0], a1 + sc * oacc[dg][1]); w.y = cvtpk(a2 + sc * oacc[dg][2], a3 + sc * oacc[dg][3]);
            *reinterpret_cast<uint2*>(out + 16 * dg) = w;
        }
    }
}

__device__ __forceinline__ void nsa_block(const Tensors& T, int b, int g, int c, char* lds) {
    constexpr int S = 16384;
    int tid_ = threadIdx.x; asm volatile("" : "+v"(tid_)); const int tid = tid_, wid = __builtin_amdgcn_readfirstlane(tid >> 6), lane = tid & 63, r32 = lane & 31, hi = lane >> 5;
    const int hh = wid & 3, rh = wid >> 2, head = 4 * g + hh;
    unsigned* imp = (unsigned*)(lds + LDS_IMP);
    short* sel = (short*)(lds + LDS_SEL);
    int* cntp = (int*)(lds + LDS_CNT);
    for (int i = tid; i < 64 * IMP_STRIDE; i += 512) imp[i] = 0u;
    const int t0 = 64 * c;
    const int n_vis = 4 * c + 3;
    const int NT = (n_vis + 63) >> 6;
    bf16x8 qr[8];
    { const bf16* qp = T.QN + (((size_t)(b * 8 + head) * S + t0 + 32 * rh + r32) * 128) + hi * 8;
#pragma unroll
      for (int d0 = 0; d0 < 8; ++d0) qr[d0] = load8(qp + d0 * 16); }
    const int trow = t0 + 32 * rh + r32;
    const int vp = (trow - 31) >> 4;
    char* V_lds = lds; char* K_lds = lds + 2 * SHM_V;
    const int sr = tid >> 4, sc = (tid & 15) * 8, vst0 = v_st(sr, sc), vst1 = v_st(32 + sr, sc), kws = KSWZ(sr, sc * 2);
    const int vb0 = (int)(uintptr_t)V_lds + v_rd_base(lane);
    const bf16* Kh = T.KC + (size_t)(b * 2 + g) * 1024 * 128;
    const bf16* Vh = T.VC + (size_t)(b * 2 + g) * 1024 * 128;
    float* ws = (float*)(lds + LDS_WS) + wid * 64; float* li_l = ws, * al_l = ws + 32;
    bf16x8 st_k0, st_k1, st_v0, st_v1;
#define ROWP(p, k0, rr) ((p) + (size_t)((k0) + (rr)) * 128 + sc)
    __syncthreads();
    float m_reg = -1e30f, l_reg = 0.f;
    {
        st_k0 = load8(ROWP(Kh, 0, sr)); st_k1 = load8(ROWP(Kh, 0, 32 + sr));
        asm volatile("s_waitcnt vmcnt(0)" ::: "memory");
        *(bf16x8*)(K_lds + kws) = st_k0; *(bf16x8*)(K_lds + kws + 32 * 256) = st_k1;
        __syncthreads();
        f32x16 p0, p1; float mn, al; bf16x8 pa0, pa1, pa2, pa3;
#define STEP1(t, BUF) do { \
            if ((t) + 1 < NT) { st_k0 = load8(ROWP(Kh, 64 * ((t) + 1), sr)); st_k1 = load8(ROWP(Kh, 64 * ((t) + 1), 32 + sr)); SBAR(); } \
            qkt<BUF, false, false>(p0, p1, K_lds, nullptr, r32, hi, qr, true); \
            mask_tile(p0, p1, vp - 64 * (t) - 4 * hi, 0x7fffffffu); \
            partialSM<CN>(p0, p1, m_reg, mn, al); finishSM(p0, p1, al, l_reg, pa0, pa1, pa2, pa3); \
            if ((t) + 1 < NT) { asm volatile("s_waitcnt vmcnt(0)" ::: "memory"); *(bf16x8*)(K_lds + (1 - BUF) * SHM_K + kws) = st_k0; *(bf16x8*)(K_lds + (1 - BUF) * SHM_K + kws + 32 * 256) = st_k1; } \
            __syncthreads(); } while (0)
        for (int t = 0; t < NT; t += 2) { STEP1(t, 0); if (t + 1 < NT) STEP1(t + 1, 1); }
#undef STEP1
    }
    const float rl = l_reg > 0.f ? 1.f / l_reg : 0.f;
    const float mL = -m_reg * C2;
    f32x16 o[4] = {};
    {
        st_k0 = load8(ROWP(Kh, 0, sr)); st_k1 = load8(ROWP(Kh, 0, 32 + sr)); st_v0 = load8(ROWP(Vh, 0, sr)); st_v1 = load8(ROWP(Vh, 0, 32 + sr));
        asm volatile("s_waitcnt vmcnt(0)" ::: "memory");
        *(bf16x8*)(K_lds + kws) = st_k0; *(bf16x8*)(K_lds + kws + 32 * 256) = st_k1; *(bf16x8*)(V_lds + vst0) = st_v0; *(bf16x8*)(V_lds + vst1) = st_v1;
        __syncthreads();
        f32x16 p0, p1; bf16x8 pa0, pa1, pa2, pa3;
        unsigned* improw = imp + (32 * rh + r32) * IMP_STRIDE;
#define STEP2(t, BUF) do { \
            if ((t) + 1 < NT) { st_k0 = load8(ROWP(Kh, 64 * ((t) + 1), sr)); st_k1 = load8(ROWP(Kh, 64 * ((t) + 1), 32 + sr)); \
                                st_v0 = load8(ROWP(Vh, 64 * ((t) + 1), sr)); st_v1 = load8(ROWP(Vh, 64 * ((t) + 1), 32 + sr)); SBAR(); } \
            qkt<BUF, false, false>(p0, p1, K_lds, nullptr, r32, hi, qr, true); \
            mask_tile(p0, p1, vp - 64 * (t) - 4 * hi, 0x7fffffffu); \
            _Pragma("unroll") for (int r = 0; r < 16; ++r) { p0[r] = __builtin_amdgcn_exp2f(fmaf(p0[r], C2, mL)) * rl; p1[r] = __builtin_amdgcn_exp2f(fmaf(p1[r], C2, mL)) * rl; } \
            _Pragma("unroll") for (int G = 0; G < 4; ++G) { \
                const int j0 = 16 * (t) + 2 * G + hi; \
                const float s4 = (p0[4 * G] + p0[4 * G + 1]) + (p0[4 * G + 2] + p0[4 * G + 3]); \
                const float s4b = (p1[4 * G] + p1[4 * G + 1]) + (p1[4 * G + 2] + p1[4 * G + 3]); \
                atomicAdd(improw + j0, (unsigned)(s4 * 536870912.f)); atomicAdd(improw + j0 + 1, (unsigned)(p0[4 * G + 3] * 536870912.f)); \
                atomicAdd(improw + j0 + 8, (unsigned)(s4b * 536870912.f)); atomicAdd(improw + j0 + 9, (unsigned)(p1[4 * G + 3] * 536870912.f)); } \
            packP(p0, p1, pa0, pa1, pa2, pa3); SBAR(); \
            pv_tile<BUF, false>(o, vb0, pa0, pa1, pa2, pa3, true); \
            if ((t) + 1 < NT) { asm volatile("s_waitcnt vmcnt(0)" ::: "memory"); *(bf16x8*)(K_lds + (1 - BUF) * SHM_K + kws) = st_k0; *(bf16x8*)(K_lds + (1 - BUF) * SHM_K + kws + 32 * 256) = st_k1; \
                                *(bf16x8*)(V_lds + (1 - BUF) * SHM_V + vst0) = st_v0; *(bf16x8*)(V_lds + (1 - BUF) * SHM_V + vst1) = st_v1; } \
            __syncthreads(); } while (0)
        for (int t = 0; t < NT; t += 2) { STEP2(t, 0); if (t + 1 < NT) STEP2(t + 1, 1); }
#undef STEP2
    }
#undef ROWP
    {
#pragma unroll
        for (int r = 0; r < 16; ++r) {
            const int orow = crow(r, hi); const int t = t0 + 32 * rh + orow; const size_t m = (size_t)b * S + t;
            const float g0 = T.GATE[m * 24 + head * 3 + 0], g2 = T.GATE[m * 24 + head * 3 + 2];
            const bf16* owp = T.OW + (((size_t)(b * 8 + head) * S + t) * 128); bf16* opp = T.OP + (((size_t)(b * 8 + head) * S + t) * 128);
#pragma unroll
            for (int d0 = 0; d0 < 4; ++d0) {
                const float v = o[d0][r]; const float vn = __shfl_xor(v, 1);
                if ((r32 & 1) == 0) { const unsigned w = *(const unsigned*)(owp + d0 * 32 + r32);
                    const float w0 = __uint_as_float(w << 16), w1 = __uint_as_float(w & 0xffff0000u);
                    *(unsigned*)(opp + d0 * 32 + r32) = cvtpk(g0 * v + g2 * w0, g0 * vn + g2 * w1); }
            }
        }
    }
    __threadfence_block();
    __syncthreads();
    for (int qi = 0; qi < 8; ++qi) {
        const int q = wid * 8 + qi;
        short* srow = sel + q * 16;
        if (c <= 15) { if (lane <= c) srow[lane] = (short)lane; if (lane == 0) cntp[q] = c + 1; }
        else {
            unsigned long long key[4];
#pragma unroll
            for (int i = 0; i < 4; ++i) { const int j = lane + 64 * i; const bool ok = (j >= 1) && (j <= c - 2);
                key[i] = ok ? (((unsigned long long)imp[q * IMP_STRIDE + j] << 32) | (unsigned long long)(0xFFFFFFFFu - (unsigned)j)) : 0ull; }
            if (lane == 0) { srow[0] = 0; srow[1] = (short)(c - 1); srow[2] = (short)c; cntp[q] = 16; }
            for (int it = 0; it < 13; ++it) {
                unsigned long long mxk = key[0]; mxk = key[1] > mxk ? key[1] : mxk; mxk = key[2] > mxk ? key[2] : mxk; mxk = key[3] > mxk ? key[3] : mxk;
                const unsigned long long win = wave_max_u64(mxk);
                const int jw = (int)(0xFFFFFFFFu - (unsigned)(win & 0xFFFFFFFFull));
#pragma unroll
                for (int i = 0; i < 4; ++i) if (key[i] == win) key[i] = 0ull;
                if (lane == 0) srow[3 + it] = (short)jw;
            }
        }
    }
    __syncthreads();
    for (int qi = 0; qi < 8; ++qi) {
        const int q = wid + 8 * qi;
        const int cnt = __builtin_amdgcn_readfirstlane(cntp[q]);
        slc_row(T, b, g, t0 + q, sel + q * 16, cnt, lane);
    }
    __syncthreads();
}
}
#define LAS __attribute__((address_space(3)))
__device__ __forceinline__ unsigned f2bf(float f) { unsigned u = __builtin_bit_cast(unsigned, f); return (u + 0x7fffu + ((u >> 16) & 1u)) >> 16; }
__device__ __forceinline__ unsigned pk2(float lo, float hi) { unsigned r; asm volatile("v_cvt_pk_bf16_f32 %0, %1, %2" : "=v"(r) : "v"(lo), "v"(hi)); return r; }
__device__ __forceinline__ float bflo(unsigned w) { return __uint_as_float(w << 16); }
__device__ __forceinline__ float bfhi(unsigned w) { return __uint_as_float(w & 0xffff0000u); }
__device__ __forceinline__ float wave_sum(float v) {
#pragma unroll
    for (int o = 1; o < 64; o <<= 1) v += __shfl_xor(v, o);
    return v;
}
struct Ctx {
    float* out; unsigned char* ws; unsigned char* lds;
    int tid, lane, wave, vcu, G;
};
__device__ __forceinline__ void ctx_refresh(Ctx& C) { int t = threadIdx.x; asm volatile("" : "+v"(t)); C.tid = t; C.lane = t & 63; C.wave = __builtin_amdgcn_readfirstlane(t >> 6); }
#define WSP(T, off) ((T*)(C.ws + (off)))
#define ROWSQ(i) (WSP(float, SM_ROWSQ) + (size_t)(i) * MTOK)

enum { MAP_ID = 0, MAP_L0_WIN, MAP_UQ, MAP_L1_WIN };
__device__ __forceinline__ int wmap(int kind, int n) {
    if (kind == MAP_ID) return n;
    if (kind == MAP_L0_WIN) {
        if (n < 1024) { const int p = n & 127; return (n - p) + (p >> 1) + 64 * (p & 1); }
        if (n < 2560) { const int n2 = n - 1024, seg = n2 >> 7, p = n2 & 127; const int kv = (seg >> 1) & 1;
            return kv == 0 ? 1024 + seg * 128 + (p >> 1) + 64 * (p & 1) : 1024 + n2; }
        if (n < 3072) return 2584 + (n - 2560);
        if (n < 3328) return 3096 + (n - 3072);
        if (n < 3392) { const int p = n - 3328; return 3352 + (p >> 1) + 32 * (p & 1); }
        if (n < 3416) return 2560 + (n - 3392);
        return -1;
    }
    if (kind == MAP_UQ) {
        if (n < 1024) { const int h = n >> 7, d = n & 127; return h * 192 + d; }
        const int n2 = n - 1024, h = n2 >> 6, p = n2 & 63; return h * 192 + 128 + (p >> 1) + 32 * (p & 1);
    }
    { const int p = n & 127, base = n - p, qkv = (n >> 10) % 3; return qkv < 2 ? base + (p >> 1) + 64 * (p & 1) : n; }
}
__device__ __forceinline__ void transpose_item(const float* W, int Nsrc, const float* gain, bf16_t* WT, int Kdst, int row_off, int kind, int nblk, LAS float* scr, int item, int lane) {
    const int kb = item / nblk, nb = item % nblk, k0 = 64 * kb, n0 = 32 * nb;
    const int src = wmap(kind, n0 + (lane & 31));
#pragma unroll 8
    for (int i = 0; i < 32; ++i) { const int kk = 2 * i + (lane >> 5);
        float v = 0.f; if (src >= 0) { v = W[(size_t)(k0 + kk) * Nsrc + src]; if (gain) v *= gain[k0 + kk]; }
        scr[kk * 33 + (lane & 31)] = v; }
    asm volatile("s_waitcnt lgkmcnt(0)" ::: "memory");
    const int c = lane & 7;
#pragma unroll
    for (int j = 0; j < 4; ++j) { const int n = (lane >> 3) + 8 * j; const LAS float* s = scr + (8 * c) * 33 + n;
        u32x4 o; o.x = pk2(s[0 * 33], s[1 * 33]); o.y = pk2(s[2 * 33], s[3 * 33]); o.z = pk2(s[4 * 33], s[5 * 33]); o.w = pk2(s[6 * 33], s[7 * 33]);
        *(u32x4*)(WT + (size_t)(row_off + n0 + n) * Kdst + k0 + 8 * c) = o; }
    asm volatile("s_waitcnt lgkmcnt(0)" ::: "memory");
}
struct Args { const float* in[27]; float* out; unsigned char* ws; int phase_hi; int pad; };
__device__ __forceinline__ void prologue(Ctx& C, const Args& args) {
    ctx_refresh(C);
    LAS float* scr = (LAS float*)(C.lds) + C.wave * 4096;
    const int gw = C.vcu * NWAVES + C.wave, NGW = C.G * NWAVES;
    int it = gw;
#define WJOB(in_idx, gain_idx, K, Nsrc, Ndst, Kdst, row_off, kind, dst) do { constexpr int nblk_ = (Ndst) / 32, nitems_ = ((K) / 64) * nblk_; \
        for (; it < nitems_; it += NGW) transpose_item(args.in[in_idx], Nsrc, (gain_idx) >= 0 ? args.in[(gain_idx) >= 0 ? (gain_idx) : 0] : nullptr, WSP(bf16_t, dst), Kdst, row_off, kind, nblk_, scr, it, C.lane); \
        it -= nitems_; } while (0)
    WJOB(2, 1, 2048, 3416, 3584, 2048, 0, MAP_L0_WIN, W_L0_WIN);
    WJOB(10, 9, 512, 1536, 1536, 512, 0, MAP_UQ, W_UQ);
    WJOB(12, 11, 256, 2048, 2048, 256, 0, MAP_ID, W_UKV);
    WJOB(4, -1, 4096, 128, 128, 4096, 0, MAP_ID, W_C1);
    WJOB(7, -1, 4096, 128, 128, 4096, 128, MAP_ID, W_C1);
    WJOB(13, -1, 2048, 2048, 2048, 2048, 0, MAP_ID, W_L0_WOUT);
    WJOB(16, 15, 2048, 8192, 8192, 2048, 0, MAP_ID, W_L0_FF1);
    WJOB(17, -1, 8192, 2048, 2048, 8192, 0, MAP_ID, W_L0_FF2);
    WJOB(20, 19, 2048, 9216, 9216, 2048, 0, MAP_L1_WIN, W_L1_WIN);
    WJOB(21, -1, 1024, 2048, 2048, 1024, 0, MAP_ID, W_L1_WOUT);
    WJOB(24, 23, 2048, 8192, 8192, 2048, 0, MAP_ID, W_L1_FF1);
    WJOB(25, -1, 8192, 2048, 2048, 8192, 0, MAP_ID, W_L1_FF2);
    WJOB(5, -1, 128, 128, 128, 256, 0, MAP_ID, W_C2);
    WJOB(8, -1, 128, 128, 128, 256, 128, MAP_ID, W_C2);
#undef WJOB
    for (int i = gw * 64 + C.lane; i < 256 * 16; i += NGW * 64) { const int n = i >> 4, c = i & 15; *(u32x4*)(WSP(bf16_t, W_C2) + (size_t)n * 256 + 128 + 8 * c) = (u32x4){0u, 0u, 0u, 0u}; }
    for (int i = gw * 64 + C.lane; i < 4096; i += NGW * 64) WSP(unsigned, SM_BAR)[i] = 0u;
    for (int i = gw * 64 + C.lane; i < SEQ * 64; i += NGW * 64) {
        const int t = i >> 6, j = i & 63;
        double inv = 1.0; { double cbase = 0.86596432336006535; for (int q = 0; q < j; ++q) inv *= cbase; }
        const float ang = (float)t * (float)inv;
        double r = (double)ang * 0.15915494309189535; r -= __builtin_rint(r);
        const float rf = (float)r;
        WSP(float, SM_ROPE_C)[i] = __builtin_amdgcn_cosf(rf); WSP(float, SM_ROPE_S)[i] = __builtin_amdgcn_sinf(rf);
    }
    for (int i = gw * 64 + C.lane; i < SEQ * 32; i += NGW * 64) {
        const int t = i >> 5, j = i & 31;
        double inv = 1.0; { double cbase = 0.74989420933245582; for (int q = 0; q < j; ++q) inv *= cbase; }
        const float ang = (float)t * (float)inv;
        double r = (double)ang * 0.15915494309189535; r -= __builtin_rint(r);
        const float rf = (float)r;
        WSP(float, SM_ROPE2_C)[i] = __builtin_amdgcn_cosf(rf); WSP(float, SM_ROPE2_S)[i] = __builtin_amdgcn_sinf(rf);
    }
    for (int i = RS_CQ * MTOK + gw * 64 + C.lane; i < RS_N * MTOK; i += NGW * 64) WSP(float, SM_ROWSQ)[i] = 0.f;
    if (gw < 256) {
        const float* pe = args.in[gw < 128 ? 3 : 6]; const float* w1 = args.in[gw < 128 ? 4 : 7]; const int c = gw & 127;
        float s = 0.f; for (int i = C.lane; i < 4096; i += 64) s += pe[i] * w1[(size_t)i * 128 + c];
        s = wave_sum(s); if (C.lane == 0) WSP(float, SM_CBIAS)[gw] = s;
    }
    for (int m = gw; m < MTOK; m += NGW) {
        const f32x4* xr = (const f32x4*)(args.in[0] + (size_t)m * DM) + C.lane; u32x2* o = (u32x2*)(WSP(bf16_t, A_HB) + (size_t)m * DM) + C.lane;
        float s = 0.f;
#pragma unroll
        for (int j = 0; j < 8; ++j) { const f32x4 v = xr[64 * j]; s += (v.x * v.x + v.y * v.y) + (v.z * v.z + v.w * v.w); o[64 * j] = (u32x2){pk2(v.x, v.y), pk2(v.z, v.w)}; }
        s = wave_sum(s); if (C.lane == 0) ROWSQ(RS_X)[m] = s;
    }
}

__device__ __forceinline__ void postnorm_phase(Ctx& C, const float* hold, const bf16_t* mm, const float* g, float* rsq_out, bool write_hb) {
    ctx_refresh(C);
    const int gw = C.vcu * NWAVES + C.wave, NGW = C.G * NWAVES;
    f32x4 gv[8];
#pragma unroll
    for (int j = 0; j < 8; ++j) gv[j] = ((const f32x4*)g)[C.lane + 64 * j];
    for (int m = gw; m < MTOK; m += NGW) {
        const f32x4* hr = (const f32x4*)(hold + (size_t)m * DM) + C.lane; const u32x2* mr = (const u32x2*)(mm + (size_t)m * DM) + C.lane;
        f32x4* orow = (f32x4*)(C.out + (size_t)m * DM) + C.lane; u32x2* hb = (u32x2*)(WSP(bf16_t, A_HB) + (size_t)m * DM) + C.lane;
        u32x2 w[8]; float q = 0.f;
#pragma unroll
        for (int j = 0; j < 8; ++j) { w[j] = mr[64 * j]; const float a = bflo(w[j].x), b = bfhi(w[j].x), c = bflo(w[j].y), d = bfhi(w[j].y); q += (a * a + b * b) + (c * c + d * d); }
        q = wave_sum(q);
        const float rstd = __builtin_amdgcn_rsqf(q * (1.f / DM) + EPS);
        float s = 0.f;
#pragma unroll
        for (int j = 0; j < 8; ++j) { const f32x4 h = hr[64 * j];
            f32x4 v; v.x = h.x + bflo(w[j].x) * rstd * gv[j].x; v.y = h.y + bfhi(w[j].x) * rstd * gv[j].y; v.z = h.z + bflo(w[j].y) * rstd * gv[j].z; v.w = h.w + bfhi(w[j].y) * rstd * gv[j].w;
            orow[64 * j] = v; s += (v.x * v.x + v.y * v.y) + (v.z * v.z + v.w * v.w);
            if (write_hb) hb[64 * j] = (u32x2){pk2(v.x, v.y), pk2(v.z, v.w)}; }
        if (write_hb) { s = wave_sum(s); if (C.lane == 0) rsq_out[m] = s; }
    }
}

__device__ __forceinline__ void vst_phase(Ctx& C) {
    ctx_refresh(C);
    const int gw = C.vcu * NWAVES + C.wave, NGW = C.G * NWAVES;
    const bf16_t* KS = WSP(bf16_t, A_KV + 2 * 16 * MiB); const bf16_t* VS = WSP(bf16_t, A_KV + 3 * 16 * MiB); bf16_t* KST = WSP(bf16_t, A_KST); bf16_t* VST = WSP(bf16_t, A_VST);
    const int col = C.lane & 15, q4 = C.lane >> 4;
    for (int it = gw; it < 4 * 256 * 16; it += NGW) {
        const int ch = it & 15, blk = (it >> 4) & 255, bg = it >> 12; const int kg = ch >> 2, ks = ch & 3;
        const u32x4 v = *(const u32x4*)(KS + ((size_t)bg * SEQ + 64 * blk + 16 * kg + col) * 128 + 32 * ks + 8 * q4);
        *(u32x4*)(KST + (((size_t)bg * 256 + blk) * 16 + ch) * 512 + C.lane * 8) = v;
    }
    for (int it = gw; it < 4 * 256 * 16; it += NGW) {
        const int ch = it & 15, blk = (it >> 4) & 255, bg = it >> 12; const int dg = ch >> 1, kp = ch & 1;
        const bf16_t* src = VS + ((size_t)bg * SEQ + 64 * blk) * 128 + 16 * dg + col;
        unsigned short e[8];
#pragma unroll
        for (int j = 0; j < 8; ++j) { const int key = 32 * kp + (j < 4 ? 4 * q4 + j : 16 + 4 * q4 + (j - 4)); e[j] = src[(size_t)key * 128]; }
        u32x4 o; o.x = e[0] | ((unsigned)e[1] << 16); o.y = e[2] | ((unsigned)e[3] << 16); o.z = e[4] | ((unsigned)e[5] << 16); o.w = e[6] | ((unsigned)e[7] << 16);
        *(u32x4*)(VST + (((size_t)bg * 256 + blk) * 16 + ch) * 512 + C.lane * 8) = o;
    }
}

__device__ __forceinline__ void dil_merge_phase(Ctx& C) {
    ctx_refresh(C);
    const int gw = C.vcu * NWAVES + C.wave, NGW = C.G * NWAVES;
    const float* LSE = WSP(float, SM_LSE);
    const bf16_t* OG[3] = {WSP(bf16_t, A_OG0), WSP(bf16_t, A_OG1), WSP(bf16_t, A_OG2)};
    bf16_t* O1 = WSP(bf16_t, A_O1);
    for (int it = gw; it < MTOK * 2; it += NGW) {
        const int m = it >> 1, half = it & 1; const int b = m / SEQ, t = m % SEQ;
        const int h = 4 * half + (C.lane >> 4), d0 = (C.lane & 15) * 8;
        float l[3]; size_t idx[3];
#pragma unroll
        for (int g = 0; g < 3; ++g) { const int sh = 2 * g, r = 1 << sh; const int tp = (t & (r - 1)) * (SEQ >> sh) + (t >> sh);
            idx[g] = (size_t)(b * 8 + h) * SEQ + tp; l[g] = LSE[(size_t)g * MTOK * 8 + idx[g]]; }
        const float mx = fmaxf(l[0], fmaxf(l[1], l[2]));
        float e0 = __expf(l[0] - mx), e1 = __expf(l[1] - mx), e2 = __expf(l[2] - mx); const float inv = 1.f / (e0 + e1 + e2);
        const float a[3] = {e0 * inv, e1 * inv, e2 * inv};
        float acc[8] = {0, 0, 0, 0, 0, 0, 0, 0};
#pragma unroll
        for (int g = 0; g < 3; ++g) { const u32x4 w = *(const u32x4*)(OG[g] + idx[g] * 128 + d0);
            acc[0] += a[g] * bflo(w.x); acc[1] += a[g] * bfhi(w.x); acc[2] += a[g] * bflo(w.y); acc[3] += a[g] * bfhi(w.y);
            acc[4] += a[g] * bflo(w.z); acc[5] += a[g] * bfhi(w.z); acc[6] += a[g] * bflo(w.w); acc[7] += a[g] * bfhi(w.w); }
        *(u32x4*)(O1 + (size_t)m * 1024 + h * 128 + d0) = (u32x4){pk2(acc[0], acc[1]), pk2(acc[2], acc[3]), pk2(acc[4], acc[5]), pk2(acc[6], acc[7])};
    }
}
typedef __attribute__((address_space(1))) unsigned gu32;
#define XB_TMO      128
#define XB_XCNT(j)  (256  + 64 * (j))
#define XB_XSUB(j)  (1280 + 64 * (j))
#define XB_XGEN(j)  (2304 + 64 * (j))
#define XB_TOP      3328
#define XB_TOPGEN   3392
#define XCD_BAR_WORDS 3456
#define XB_SPIN_CAP (1u << 18)

__device__ __forceinline__ unsigned xb_ld(unsigned* p)              { return __hip_atomic_load(p, __ATOMIC_RELAXED, __HIP_MEMORY_SCOPE_AGENT); }
__device__ __forceinline__ unsigned xb_add(unsigned* p, unsigned v) { return __hip_atomic_fetch_add(p, v, __ATOMIC_RELAXED, __HIP_MEMORY_SCOPE_AGENT); }
__device__ __forceinline__ unsigned xb_xcc_id() { return (unsigned)__builtin_amdgcn_s_getreg((3 << 11) | 20) & 0xFu; }
#define XB_SPIN(cond, bar) do { unsigned _sp = 0; while (cond) { __builtin_amdgcn_s_sleep(1); \
    if ((++_sp & 255u) == 0u) { if (xb_ld(&(bar)[XB_TMO])) break; if (_sp > XB_SPIN_CAP) { atomicAdd(&(bar)[XB_TMO], 1u); break; } } } } while (0)

struct XcdBarrier {
    unsigned* bar; unsigned x;
    volatile LAS unsigned* st;
};

__device__ __forceinline__ XcdBarrier xcd_barrier_post(unsigned* bar, volatile LAS unsigned* st) {
    XcdBarrier b; b.bar = bar; b.x = xb_xcc_id(); b.st = st;
    if (threadIdx.x == 0) (void)xb_add(&bar[XB_XCNT(b.x)], 1u);
    return b;
}
__device__ __forceinline__ void xcd_barrier_complete(unsigned* bar, unsigned x, unsigned& nloc, unsigned& nx) {
    const unsigned G = gridDim.x * gridDim.y * gridDim.z;
    unsigned sum, cnt, mine, sp = 0u;
    for (;;) {
        sum = 0u; cnt = 0u; mine = 0u;
#pragma unroll
        for (unsigned j = 0; j < 16; ++j) { const unsigned c = xb_ld(&bar[XB_XCNT(j)]); sum += c; cnt += (c > 0u) ? 1u : 0u; mine = (j == x) ? c : mine; }
        if (sum == G) break;
        __builtin_amdgcn_s_sleep(1);
        if ((++sp & 255u) == 0u) { if (xb_ld(&bar[XB_TMO])) break; if (sp > XB_SPIN_CAP) { atomicAdd(&bar[XB_TMO], 1u); break; } }
    }
    nloc = mine > 0u ? mine : 1u; nx = cnt > 0u ? cnt : 1u;
}

__device__ __forceinline__ void xcd_barrier(const XcdBarrier& b) {
    asm volatile("s_waitcnt vmcnt(0)" ::: "memory");
    __syncthreads();
    if (threadIdx.x == 0) {
        unsigned* bar = b.bar;
        __builtin_amdgcn_s_waitcnt(0);
        unsigned nloc = b.st[0], nx = b.st[1];
        if (nloc == 0u) { xcd_barrier_complete(bar, b.x, nloc, nx); b.st[0] = nloc; b.st[1] = nx; }
        const unsigned old = xb_add(&bar[XB_XSUB(b.x)], 1u);
        const unsigned gen = old / nloc;
        if (old + 1u == (gen + 1u) * nloc) {
            __builtin_amdgcn_fence(__ATOMIC_RELEASE, "agent");
            asm volatile("s_waitcnt vmcnt(0)" ::: "memory");
            const unsigned og = xb_add(&bar[XB_TOP], 1u);
            const unsigned tg = og / nx;
            if (og + 1u == (tg + 1u) * nx) xb_add(&bar[XB_TOPGEN], 1u);
            else XB_SPIN(xb_ld(&bar[XB_TOPGEN]) == tg, bar);
            __builtin_amdgcn_fence(__ATOMIC_ACQUIRE, "agent");
            xb_add(&bar[XB_XGEN(b.x)], 1u);
            asm volatile("s_waitcnt vmcnt(0)" ::: "memory");
        } else {
            XB_SPIN(xb_ld(&bar[XB_XGEN(b.x)]) == gen, bar);
            __builtin_amdgcn_fence(__ATOMIC_ACQUIRE, "agent");
            asm volatile("s_waitcnt vmcnt(0)" ::: "memory");
        }
    }
    __syncthreads();
}

typedef pg8::f32x4 accv;
#define EPI_FOR_ROWS _Pragma("unroll") for (int ai = 0; ai < 2; ++ai) _Pragma("unroll") for (int m = 0; m < 4; ++m)
#define EPI_ROW (u.pm * 256 + ai * 128 + wr * 64 + m * 16 + fr)
__device__ __forceinline__ void store8(bf16_t* p, accv a, accv b) { *(u32x4*)p = (u32x4){pk2(a[0], a[1]), pk2(a[2], a[3]), pk2(b[0], b[1]), pk2(b[2], b[3])}; }
__device__ __forceinline__ void rope_store(bf16_t* dst, int pc, int half, accv a, accv b, const float* ct, const float* st) {
    const int i0 = pc >> 1; const f32x4 c = *(const f32x4*)(ct + i0), s = *(const f32x4*)(st + i0);
    const float o1a = a[0] * c.x - a[1] * s.x, o2a = a[0] * s.x + a[1] * c.x;
    const float o1b = a[2] * c.y - a[3] * s.y, o2b = a[2] * s.y + a[3] * c.y;
    const float o1c = b[0] * c.z - b[1] * s.z, o2c = b[0] * s.z + b[1] * c.z;
    const float o1d = b[2] * c.w - b[3] * s.w, o2d = b[2] * s.w + b[3] * c.w;
    *(u32x2*)(dst + i0) = (u32x2){pk2(o1a, o1b), pk2(o1c, o1d)};
    *(u32x2*)(dst + half + i0) = (u32x2){pk2(o2a, o2b), pk2(o2c, o2d)};
}
__device__ __forceinline__ float sumsq8(accv a, accv b) { return (a[0] * a[0] + a[1] * a[1]) + (a[2] * a[2] + a[3] * a[3]) + (b[0] * b[0] + b[1] * b[1]) + (b[2] * b[2] + b[3] * b[3]); }
__device__ __forceinline__ void rowsq_add(unsigned long long* p, float s, int fq) { s += __shfl_xor(s, 16); s += __shfl_xor(s, 32); if (fq == 0) atomicAdd(p, (unsigned long long)(s * 1099511627776.f)); }
__device__ __forceinline__ float rowsq_fx(const unsigned long long* p) { return (float)(*p) * 9.094947017729282e-13f; }

struct EpiL0In {
    static constexpr bool PERM = true, AFTER_DRAIN = false;
    unsigned char* ws; const float* rsq_x;
    __device__ __forceinline__ void operator()(const accv (&acc)[2][2][4][2], const pg8::Unit& u, int wr, int wc, int fr, int fq) const {
        const int pn = u.pn, pc = wc * 32 + 8 * fq;
        EPI_FOR_ROWS { const int row = EPI_ROW; const float rstd = __builtin_amdgcn_rsqf(rsq_x[row] * (1.f / DM) + EPS);
            const int b = row / SEQ, t = row % SEQ; float ssq = 0.f;
#pragma unroll
            for (int bj = 0; bj < 2; ++bj) { const accv v0 = acc[ai][bj][m][0] * rstd, v1 = acc[ai][bj][m][1] * rstd;
                if (pn < 4) { const int head = 2 * pn + bj;
                    rope_store((bf16_t*)(ws + A_QN) + ((size_t)(b * 8 + head) * SEQ + t) * 128, pc, 64, v0, v1, (const float*)(ws + SM_ROPE_C) + t * 64, (const float*)(ws + SM_ROPE_S) + t * 64); }
                else if (pn < 10) { const int q = pn - 4, kv = q & 1;
                    bf16_t* dst = (bf16_t*)(ws + A_KV + (size_t)q * 16 * MiB) + ((size_t)(b * 2 + bj) * SEQ + t) * 128;
                    if (kv == 0) rope_store(dst, pc, 64, v0, v1, (const float*)(ws + SM_ROPE_C) + t * 64, (const float*)(ws + SM_ROPE_S) + t * 64);
                    else store8(dst + pc, v0, v1); }
                else if (pn < 12) { store8((bf16_t*)(ws + A_CQ) + (size_t)row * 512 + (pn - 10) * 256 + bj * 128 + pc, v0, v1); ssq += sumsq8(v0, v1); }
                else if (pn == 12) { store8((bf16_t*)(ws + A_CKV) + (size_t)row * 256 + bj * 128 + pc, v0, v1); ssq += sumsq8(v0, v1); }
                else if (bj == 0) {
                    if (pc < 64) rope_store((bf16_t*)(ws + A_KPE) + ((size_t)b * SEQ + t) * 64, pc, 32, v0, v1, (const float*)(ws + SM_ROPE2_C) + t * 32, (const float*)(ws + SM_ROPE2_S) + t * 32);
                    else if (pc < 88) { float* gp = (float*)(ws + SM_GATE) + (size_t)row * 24 + (pc - 64);
                        f32x4 g0, g1;
                        g0.x = 1.f / (1.f + __expf(-v0[0])); g0.y = 1.f / (1.f + __expf(-v0[1])); g0.z = 1.f / (1.f + __expf(-v0[2])); g0.w = 1.f / (1.f + __expf(-v0[3]));
                        g1.x = 1.f / (1.f + __expf(-v1[0])); g1.y = 1.f / (1.f + __expf(-v1[1])); g1.z = 1.f / (1.f + __expf(-v1[2])); g1.w = 1.f / (1.f + __expf(-v1[3]));
                        *(f32x4*)gp = g0; *(f32x4*)(gp + 4) = g1; }
                }
            }
            if (pn >= 10 && pn < 12) rowsq_add((unsigned long long*)((float*)(ws + SM_ROWSQ) + (size_t)RS_CQ * MTOK) + row, ssq, fq);
            if (pn == 12) rowsq_add((unsigned long long*)((float*)(ws + SM_ROWSQ) + (size_t)RS_CKV * MTOK) + row, ssq, fq);
        }
    }
};
struct EpiUQ {
    static constexpr bool PERM = true, AFTER_DRAIN = false;
    unsigned char* ws; bf16_t* MQ; const unsigned long long* rsq;
    __device__ __forceinline__ void operator()(const accv (&acc)[2][2][4][2], const pg8::Unit& u, int wr, int wc, int fr, int fq) const {
        const int pn = u.pn, pc = wc * 32 + 8 * fq;
        EPI_FOR_ROWS { const int row = EPI_ROW; const float rstd = __builtin_amdgcn_rsqf(rowsq_fx(rsq + row) * (1.f / 512.f) + EPS);
            const int b = row / SEQ, t = row % SEQ;
#pragma unroll
            for (int bj = 0; bj < 2; ++bj) { const accv v0 = acc[ai][bj][m][0] * rstd, v1 = acc[ai][bj][m][1] * rstd;
                if (pn < 4) { const int head = 2 * pn + bj; store8(MQ + ((size_t)(b * 8 + head) * SEQ + t) * 192 + pc, v0, v1); }
                else { const int head = 4 * (pn - 4) + 2 * bj + (pc >> 6);
                    rope_store(MQ + ((size_t)(b * 8 + head) * SEQ + t) * 192 + 128, pc & 63, 32, v0, v1, (const float*)(ws + SM_ROPE2_C) + t * 32, (const float*)(ws + SM_ROPE2_S) + t * 32); }
            }
        }
    }
};
struct EpiUKV {
    static constexpr bool PERM = true, AFTER_DRAIN = false;
    bf16_t* MK; bf16_t* MV; const unsigned long long* rsq;
    __device__ __forceinline__ void operator()(const accv (&acc)[2][2][4][2], const pg8::Unit& u, int wr, int wc, int fr, int fq) const {
        const int pc = wc * 32 + 8 * fq;
        EPI_FOR_ROWS { const int row = EPI_ROW; const float rstd = __builtin_amdgcn_rsqf(rowsq_fx(rsq + row) * (1.f / 256.f) + EPS);
            const int b = row / SEQ, t = row % SEQ; const size_t off = ((size_t)(b * 8 + u.pn) * SEQ + t) * 128 + pc;
            store8(MK + off, acc[ai][0][m][0] * rstd, acc[ai][0][m][1] * rstd);
            store8(MV + off, acc[ai][1][m][0] * rstd, acc[ai][1][m][1] * rstd);
        }
    }
};
__device__ __forceinline__ float gelu_tanh(float x) { const float u = 0.7978845608028654f * (x + 0.044715f * x * x * x); const float e = __expf(2.f * u); const float th = 1.f - 2.f / (e + 1.f); return 0.5f * x * (1.f + th); }
struct EpiC1 {
    static constexpr bool PERM = true, AFTER_DRAIN = false;
    bf16_t* HC; const float* cb;
    template <int SEL> __device__ __forceinline__ void body(const accv (&acc)[2][2][4][2], const pg8::Unit& u, int wr, int wc, int fr, int fq) const {
        const int pc = wc * 32 + 8 * fq;
        const f32x4 b0 = *(const f32x4*)(cb + SEL * 128 + pc), b1 = *(const f32x4*)(cb + SEL * 128 + pc + 4);
        EPI_FOR_ROWS { const int row = EPI_ROW;
            accv v0 = acc[ai][SEL][m][0], v1 = acc[ai][SEL][m][1];
            v0 += (accv){b0.x, b0.y, b0.z, b0.w}; v1 += (accv){b1.x, b1.y, b1.z, b1.w};
#pragma unroll
            for (int e = 0; e < 4; ++e) { v0[e] = gelu_tanh(v0[e]); v1[e] = gelu_tanh(v1[e]); }
            store8(HC + (size_t)row * 256 + pc, v0, v1);
            *(u32x4*)(HC + (size_t)row * 256 + 128 + pc) = (u32x4){0u, 0u, 0u, 0u};
            asm volatile("" ::: "memory");
        }
    }
    __device__ __forceinline__ void operator()(const accv (&acc)[2][2][4][2], const pg8::Unit& u, int wr, int wc, int fr, int fq) const {
        if (u.pm >= 16) body<1>(acc, u, wr, wc, fr, fq); else body<0>(acc, u, wr, wc, fr, fq);
    }
};
struct EpiC2 {
    static constexpr bool PERM = true, AFTER_DRAIN = false;
    bf16_t* KC; bf16_t* VC;
    template <int SEL> __device__ __forceinline__ void body(const accv (&acc)[2][2][4][2], const pg8::Unit& u, int wr, int wc, int fr, int fq) const {
        const int pc = wc * 32 + 8 * fq;
        EPI_FOR_ROWS { const int row = EPI_ROW;
            accv v0 = acc[ai][SEL][m][0], v1 = acc[ai][SEL][m][1];
            if ((row & 1023) == 1023) { v0 = (accv){0.f, 0.f, 0.f, 0.f}; v1 = v0; }
            bf16_t* dst = (SEL ? VC : KC) + (size_t)(row & 4095) * 128 + pc;
            store8(dst, v0, v1);
            asm volatile("" ::: "memory");
        }
    }
    __device__ __forceinline__ void operator()(const accv (&acc)[2][2][4][2], const pg8::Unit& u, int wr, int wc, int fr, int fq) const {
        if (u.pm >= 16) body<1>(acc, u, wr, wc, fr, fq); else body<0>(acc, u, wr, wc, fr, fq);
    }
};
template <int ACT> struct EpiOut {
    static constexpr bool PERM = true, AFTER_DRAIN = false;
    bf16_t* O; int ldc; float* rsq_out; const float* rsq_in;
    __device__ __forceinline__ void operator()(const accv (&acc)[2][2][4][2], const pg8::Unit& u, int wr, int wc, int fr, int fq) const {
        const int pc = wc * 32 + 8 * fq;
        EPI_FOR_ROWS { const int row = EPI_ROW;
            float rstd = 1.f; if (ACT == 1) rstd = __builtin_amdgcn_rsqf(rsq_in[row] * (1.f / DM) + EPS);
#pragma unroll
            for (int bj = 0; bj < 2; ++bj) { accv v0 = acc[ai][bj][m][0], v1 = acc[ai][bj][m][1];
                if (ACT == 1) {
#pragma unroll
                    for (int e = 0; e < 4; ++e) { float a = fmaxf(v0[e] * rstd, 0.f); v0[e] = a * a; float c = fmaxf(v1[e] * rstd, 0.f); v1[e] = c * c; } }
                store8(O + (size_t)row * ldc + u.pn * 256 + bj * 128 + pc, v0, v1); }
        }
    }
};
struct EpiL1In {
    static constexpr bool PERM = true, AFTER_DRAIN = false;
    unsigned char* ws; const float* rsq;
    __device__ __forceinline__ void operator()(const accv (&acc)[2][2][4][2], const pg8::Unit& u, int wr, int wc, int fr, int fq) const {
        const int pn = u.pn, pc = wc * 32 + 8 * fq; const int g = pn / 12, qkv = (pn % 12) >> 2, sh = 2 * g;
        EPI_FOR_ROWS { const int row = EPI_ROW; const float rstd = __builtin_amdgcn_rsqf(rsq[row] * (1.f / DM) + EPS);
            const int b = row / SEQ, t = row % SEQ; const int tp = (t & ((1 << sh) - 1)) * (SEQ >> sh) + (t >> sh);
#pragma unroll
            for (int bj = 0; bj < 2; ++bj) { const accv v0 = acc[ai][bj][m][0] * rstd, v1 = acc[ai][bj][m][1] * rstd;
                const int head = 2 * (pn & 3) + bj;
                bf16_t* dst = (bf16_t*)(ws + A_Z1 + (size_t)(g * 3 + qkv) * 64 * MiB) + ((size_t)(b * 8 + head) * SEQ + tp) * 128;
                if (qkv < 2) rope_store(dst, pc, 64, v0, v1, (const float*)(ws + SM_ROPE_C) + t * 64, (const float*)(ws + SM_ROPE_S) + t * 64);
                else store8(dst + pc, v0, v1); }
        }
    }
};

#ifndef REP_PRO
#define REP_PRO 1
#endif
#ifndef REP_G1
#define REP_G1 1
#endif
#ifndef REP_WIN
#define REP_WIN 1
#endif
#ifndef REP_MLA
#define REP_MLA 1
#endif
#ifndef REP_NSA
#define REP_NSA 1
#endif
#ifndef REP_DIL
#define REP_DIL 1
#endif
#ifndef REP_FF1
#define REP_FF1 1
#endif
#ifndef REP_FF2
#define REP_FF2 1
#endif
#ifndef ONLY_G
#define ONLY_G -1
#endif
#ifndef MK_PHASE_HI
#define MK_PHASE_HI 99
#endif
#define CG_SYNC() do { __threadfence(); grid.sync(); __builtin_amdgcn_fence(__ATOMIC_ACQUIRE, "agent"); asm volatile("s_waitcnt vmcnt(0)" ::: "memory"); __syncthreads(); } while (0)
#ifdef USE_CG_SYNC
#define GRID_SYNC() CG_SYNC()
#else
#define GRID_SYNC() xcd_barrier(xbar)
#endif
template <class Epi> __device__ __forceinline__ void run_gemm(Ctx& C, const bf16_t* A, const bf16_t* Bt, int Mr, int N, int K, int lda, const Epi& E) {
    asm volatile("" : "+s"(K), "+s"(lda), "+s"(N), "+s"(Mr));
    pg8::Gemm g{A, Bt, Mr, N, K, lda}; pg8::StaticOrder S; S.init(Mr, N, C.G, (int)blockIdx.x);
    pg8::gemm_phase<Epi, pg8::StaticOrder, true, true>((LAS unsigned char*)C.lds, g, S, E);
}
using CfgW = fa::Cfg<128, 128, false, true, 128>;
using CfgM = fa::Cfg<192, 2048, true, false, 192>;

__global__ void __launch_bounds__(NTHREADS, 2) mega_fwd(Args args) {
    extern __shared__ __attribute__((aligned(16))) unsigned char lds[];
    cg::grid_group grid = cg::this_grid();
    Ctx C;
    C.out = args.out; C.ws = args.ws; C.lds = lds;
    ctx_refresh(C);
    C.G = gridDim.x; { const int bx = blockIdx.x; C.vcu = (C.G % 8 == 0) ? (bx % 8) * (C.G / 8) + bx / 8 : bx; }
    const int phase_hi = args.phase_hi;
    unsigned char* dout = (unsigned char*)args.out;
    using fa::bf16;

    if (threadIdx.x < 2) ((volatile LAS unsigned*)((LAS unsigned char*)lds + LDS_BAR_ST))[threadIdx.x] = 0u;
    for (int rep_ = 0; rep_ < REP_PRO; ++rep_) prologue(C, args);
    CG_SYNC();
    XcdBarrier xbar = xcd_barrier_post(WSP(unsigned, SM_BAR), (volatile LAS unsigned*)((LAS unsigned char*)lds + LDS_BAR_ST));
    for (int rep_ = 0; rep_ < REP_G1; ++rep_) { EpiL0In E{C.ws, ROWSQ(RS_X)}; if constexpr (ONLY_G < 0 || ONLY_G == 0) run_gemm(C, WSP(bf16_t, A_HB), WSP(bf16_t, W_L0_WIN), MTOK, 3584, 2048, 2048, E); }
    GRID_SYNC();
    { EpiC1 E{WSP(bf16_t, A_HC), WSP(float, SM_CBIAS)}; if constexpr (ONLY_G < 0 || ONLY_G == 1) run_gemm(C, WSP(bf16_t, A_KV), WSP(bf16_t, W_C1), 8192, 256, 4096, 2048, E); }
    { EpiUQ E{C.ws, (bf16_t*)(dout + DO_MQ), (const unsigned long long*)ROWSQ(RS_CQ)}; if constexpr (ONLY_G < 0 || ONLY_G == 2) run_gemm(C, WSP(bf16_t, A_CQ), WSP(bf16_t, W_UQ), MTOK, 1536, 512, 512, E); }
    { EpiUKV E{(bf16_t*)(dout + DO_MK), (bf16_t*)(dout + DO_MV), (const unsigned long long*)ROWSQ(RS_CKV)}; if constexpr (ONLY_G < 0 || ONLY_G == 3) run_gemm(C, WSP(bf16_t, A_CKV), WSP(bf16_t, W_UKV), MTOK, 2048, 256, 256, E); }
    vst_phase(C);
#ifndef NO_WIN
    for (int rep_ = 0; rep_ < REP_WIN; ++rep_) {
        const bf16* QN = WSP(bf16, A_QN); const bf16* KW = WSP(bf16, A_KV + 4 * 16 * MiB); const bf16* VW = WSP(bf16, A_KV + 5 * 16 * MiB); bf16* OW = WSP(bf16, A_OW);
        for (int L = C.vcu * 4; L < C.vcu * 4 + 4 && L < 1024; ++L) {
            const int bh = L >> 6, qb = L & 63, b = bh >> 3, h = bh & 7;
            fa::BlockRef r; r.Q = QN + ((size_t)bh * SEQ + qb * 256) * 128; r.K = KW + (size_t)(b * 2 + (h >> 2)) * SEQ * 128; r.V = VW + (size_t)(b * 2 + (h >> 2)) * SEQ * 128;
            r.KP = nullptr; r.O = OW + ((size_t)bh * SEQ + qb * 256) * 128; r.L = nullptr; r.P0 = qb * 256;
            fa::block_simple<CfgW>(r, SEQ, 512, (char*)lds);
        }
    }
#endif
    GRID_SYNC();
    { EpiC2 E{WSP(bf16_t, A_KCMP), WSP(bf16_t, A_VCMP)}; if constexpr (ONLY_G < 0 || ONLY_G == 4) run_gemm(C, WSP(bf16_t, A_HC), WSP(bf16_t, W_C2), 8192, 256, 256, 256, E); }
#ifndef NO_MLA
    for (int rep_ = 0; rep_ < REP_MLA; ++rep_) {
        const bf16* MQ = (const bf16*)(dout + DO_MQ); const bf16* MK = (const bf16*)(dout + DO_MK); const bf16* MV = (const bf16*)(dout + DO_MV);
        const bf16* KPE = WSP(bf16, A_KPE); bf16* O = WSP(bf16, A_O);
        for (int L = C.vcu * 2; L < C.vcu * 2 + 2 && L < 512; ++L) {
            const int bh = L >> 5, x = L & 31, b = bh >> 3, h = bh & 7;
            for (int pass = 0; pass < 2; ++pass) { const int qb = pass ? 63 - x : x;
                fa::BlockRef r; r.Q = MQ + ((size_t)bh * SEQ + qb * 256) * 192; r.K = MK + (size_t)bh * SEQ * 128; r.V = MV + (size_t)bh * SEQ * 128;
                r.KP = KPE + (size_t)b * SEQ * 64; r.O = O + ((size_t)b * SEQ + qb * 256) * 2048 + 1024 + h * 128; r.L = nullptr; r.P0 = qb * 256;
                fa::block_simple<CfgM>(r, SEQ, 1 << 30, (char*)lds);
            }
        }
    }
#endif
    GRID_SYNC();
#ifndef NO_NSA
    for (int rep_ = 0; rep_ < REP_NSA; ++rep_) {
        nsa::Tensors T; T.QN = WSP(bf16, A_QN); T.KC = WSP(bf16, A_KCMP); T.VC = WSP(bf16, A_VCMP); T.KST = WSP(bf16, A_KST); T.VST = WSP(bf16, A_VST);
        T.OW = WSP(bf16, A_OW); T.OP = WSP(bf16, A_OP); T.GATE = WSP(float, SM_GATE); T.O = WSP(bf16, A_O);
        const int bg = C.vcu >> 6, k = C.vcu & 63;
        if (bg < 4) {
            for (int i = 0; i < 4; ++i) { const int c = (i == 0) ? k : (i == 1) ? 127 - k : (i == 2) ? 128 + k : 255 - k;
                nsa::nsa_block(T, bg >> 1, bg & 1, c, (char*)lds); }
        }
    }
#endif
    GRID_SYNC();
    { EpiOut<0> E{WSP(bf16_t, A_MM), 2048, nullptr, nullptr}; if constexpr (ONLY_G < 0 || ONLY_G == 5) run_gemm(C, WSP(bf16_t, A_O), WSP(bf16_t, W_L0_WOUT), MTOK, 2048, 2048, 2048, E); }
    GRID_SYNC();
    postnorm_phase(C, args.in[0], WSP(bf16_t, A_MM), args.in[14], ROWSQ(RS_H1), true);
    GRID_SYNC();
    if (phase_hi <= 6) return;
    for (int rep_ = 0; rep_ < REP_FF1; ++rep_) { EpiOut<1> E{WSP(bf16_t, A_HID), 8192, nullptr, ROWSQ(RS_H1)}; if constexpr (ONLY_G < 0 || ONLY_G == 6) run_gemm(C, WSP(bf16_t, A_HB), WSP(bf16_t, W_L0_FF1), MTOK, 8192, 2048, 2048, E); }
    GRID_SYNC();
    for (int rep_ = 0; rep_ < REP_FF2; ++rep_) { EpiOut<0> E{WSP(bf16_t, A_F), 2048, nullptr, nullptr}; if constexpr (ONLY_G < 0 || ONLY_G == 7) run_gemm(C, WSP(bf16_t, A_HID), WSP(bf16_t, W_L0_FF2), MTOK, 2048, 8192, 8192, E); }
    GRID_SYNC();
    postnorm_phase(C, C.out, WSP(bf16_t, A_F), args.in[18], ROWSQ(RS_H2), true);
    GRID_SYNC();
    if (phase_hi <= 9) return;
    { EpiL1In E{C.ws, ROWSQ(RS_H2)}; if constexpr (ONLY_G < 0 || ONLY_G == 8) run_gemm(C, WSP(bf16_t, A_HB), WSP(bf16_t, W_L1_WIN), MTOK, 9216, 2048, 2048, E); }
    GRID_SYNC();
#ifndef NO_DIL
    for (int rep_ = 0; rep_ < REP_DIL; ++rep_) {
        for (int g = 0; g < 3; ++g) {
            const int sh = 2 * g, slen = SEQ >> sh, nqb = slen >> 8;
            const bf16* Qg = WSP(bf16, A_Z1 + (size_t)(g * 3 + 0) * 64 * MiB); const bf16* Kg = WSP(bf16, A_Z1 + (size_t)(g * 3 + 1) * 64 * MiB); const bf16* Vg = WSP(bf16, A_Z1 + (size_t)(g * 3 + 2) * 64 * MiB);
            bf16* Og = (g == 0) ? WSP(bf16, A_OG0) : (g == 1) ? WSP(bf16, A_OG1) : WSP(bf16, A_OG2);
            float* Lg = WSP(float, SM_LSE) + (size_t)g * MTOK * 8;
            for (int L = C.vcu * 4; L < C.vcu * 4 + 4 && L < 1024; ++L) {
                const int bh = L >> 6, rest = L & 63, res = rest / nqb, qb = rest % nqb;
                const size_t seq0 = (size_t)bh * SEQ + (size_t)res * slen;
                fa::BlockRef r; r.Q = Qg + (seq0 + qb * 256) * 128; r.K = Kg + seq0 * 128; r.V = Vg + seq0 * 128; r.KP = nullptr;
                r.O = Og + (seq0 + qb * 256) * 128; r.L = Lg + seq0 + qb * 256; r.P0 = qb * 256;
                fa::block_simple<CfgW>(r, slen, 129, (char*)lds);
            }
        }
    }
#endif
    GRID_SYNC();
    dil_merge_phase(C);
    GRID_SYNC();
    { EpiOut<0> E{WSP(bf16_t, A_MM1), 2048, nullptr, nullptr}; if constexpr (ONLY_G < 0 || ONLY_G == 9) run_gemm(C, WSP(bf16_t, A_O1), WSP(bf16_t, W_L1_WOUT), MTOK, 2048, 1024, 1024, E); }
    GRID_SYNC();
    postnorm_phase(C, C.out, WSP(bf16_t, A_MM1), args.in[22], ROWSQ(RS_H3), true);
    GRID_SYNC();
    if (phase_hi <= 14) return;
    { EpiOut<1> E{WSP(bf16_t, A_HID), 8192, nullptr, ROWSQ(RS_H3)}; if constexpr (ONLY_G < 0 || ONLY_G == 10) run_gemm(C, WSP(bf16_t, A_HB), WSP(bf16_t, W_L1_FF1), MTOK, 8192, 2048, 2048, E); }
    GRID_SYNC();
    { EpiOut<0> E{WSP(bf16_t, A_F), 2048, nullptr, nullptr}; if constexpr (ONLY_G < 0 || ONLY_G == 11) run_gemm(C, WSP(bf16_t, A_HID), WSP(bf16_t, W_L1_FF2), MTOK, 2048, 8192, 8192, E); }
    GRID_SYNC();
    postnorm_phase(C, C.out, WSP(bf16_t, A_F), args.in[26], nullptr, false);
}

extern "C" void kernel_launch(void* const* d_in, const int* in_sizes, int n_in, void* d_out, int out_size, void* d_ws, size_t ws_size, hipStream_t stream) {
    static int grid = 0;
    if (grid == 0) {
        if (n_in != 27 || out_size != MTOK * DM || ws_size < 1024 * MiB) { fprintf(stderr, "kernel_launch: unexpected shapes (n_in %d out %d ws %zu)\n", n_in, out_size, ws_size); grid = -1; return; }
        int dev = 0, cus = 0, per_cu = 0;
        if (hipGetDevice(&dev) != hipSuccess || hipDeviceGetAttribute(&cus, hipDeviceAttributeMultiprocessorCount, dev) != hipSuccess) { grid = -1; return; }
        if (hipFuncSetAttribute((const void*)mega_fwd, hipFuncAttributeMaxDynamicSharedMemorySize, LDS_BYTES) != hipSuccess) { fprintf(stderr, "kernel_launch: hipFuncSetAttribute failed\n"); grid = -1; return; }
        if (hipOccupancyMaxActiveBlocksPerMultiprocessor(&per_cu, (const void*)mega_fwd, NTHREADS, LDS_BYTES) != hipSuccess || per_cu < 1) { fprintf(stderr, "kernel_launch: occupancy query says %d\n", per_cu); (void)hipGetLastError(); grid = -1; return; }
        grid = cus;
        if (grid != 256) fprintf(stderr, "kernel_launch: note: %d CUs\n", grid);
    }
    if (grid < 0) return;
    Args a{};
    for (int i = 0; i < 27; ++i) a.in[i] = (const float*)d_in[i];
    a.out = (float*)d_out; a.ws = (unsigned char*)d_ws; a.phase_hi = MK_PHASE_HI; a.pad = 0;
    void* kargs[] = {&a};
    hipError_t e = hipLaunchCooperativeKernel((const void*)mega_fwd, dim3(grid), dim3(NTHREADS), kargs, LDS_BYTES, stream);
    if (e != hipSuccess) fprintf(stderr, "kernel_launch: cooperative launch failed: %s\n", hipGetErrorString(e));
}
```

```cpp
#include <hip/hip_runtime.h>
#include <hip/hip_bf16.h>
#include <hip/hip_cooperative_groups.h>
#include <cstdio>
#include <cstdint>
namespace cg = cooperative_groups;
namespace pg8 {
#define PG8_LAS __attribute__((address_space(3)))
typedef unsigned short bf16_t;
typedef short bf16x8 __attribute__((ext_vector_type(8)));
typedef float f32x4 __attribute__((ext_vector_type(4)));
typedef unsigned u32x4 __attribute__((ext_vector_type(4)));
constexpr int BM = 256, BK = 64, HALF = 128, HTB = HALF * BK * 2  , STAGE_BYTES = 8 * HTB, NXCD = 8, WGM = 8;

__host__ __device__ __forceinline__ int lds_byte(int r, int c) { const int st = (r >> 4) * 2 + (c >> 5), rr = r & 15, cc = c & 31, ob = rr * 64 + cc * 2; return st * 1024 + (ob ^ (((ob >> 9) & 1) << 5)); }
__host__ __device__ __forceinline__ void stage_rc(int b, int& R, int& C) { const int st = b / 1024, sb = b % 1024, swz = sb ^ (((sb >> 9) & 1) << 5); R = (st >> 1) * 16 + swz / 64; C = (st & 1) * 32 + (swz % 64) / 2; }
__host__ __device__ __forceinline__ int perm32(int rho) { const int n = rho >> 4, i = rho & 15; return 8 * (i >> 2) + 4 * n + (i & 3); }

struct Unit { int pm, pn; };
struct Gemm { const bf16_t* A; const bf16_t* Bt; int M, N, K, lda; };

struct StaticOrder {
    int nM, nN, nwg, G, c;
    __host__ __device__ void init(int M, int N, int G_, int c_) { nM = M / BM; nN = N / BM; nwg = nM * nN; G = G_; c = c_; }
    __host__ __device__ bool next(int i, Unit& u) const {
        const long L = (long)i * G + c; if (L >= nwg) return false;
        int wgid = (int)L; { const int q = nwg / NXCD, r = nwg % NXCD, xcd = wgid % NXCD, off = wgid / NXCD; wgid = (xcd < r ? xcd * (q + 1) : r * (q + 1) + (xcd - r) * q) + off; }
        const int nig = WGM * nN, gid = wgid / nig, fm = gid * WGM, gsz = (nM - fm) < WGM ? (nM - fm) : WGM;
        u.pm = fm + ((wgid % nig) % gsz); u.pn = (wgid % nig) / gsz; return true;
    }
    __device__ __forceinline__ void a_ready(const Unit&) const {}
    __device__ __forceinline__ void done(const Unit&) const {}
};

template <class Epi, class Sched, bool ALIGN_EPI = false, bool SP2 = false>
__device__ __forceinline__ void gemm_phase(PG8_LAS unsigned char* lds, const Gemm g, const Sched& S, const Epi& E) {
    int tid_ = threadIdx.x; asm volatile("" : "+v"(tid_)); const int tid = tid_, wid = __builtin_amdgcn_readfirstlane(tid >> 6), lane = tid & 63, wr = wid >> 2, wc = wid & 3, fr = lane & 15, fq = lane >> 4;
    const int K = g.K, nt = K / BK;
    unsigned voffA[2], voffB[2];
#pragma unroll
    for (int i = 0; i < 2; ++i) { int R, C; stage_rc(tid * 16 + i * 8192, R, C); const int Rb = Epi::PERM ? ((R & ~31) + perm32(R & 31)) : R;
        voffA[i] = (unsigned)(R * g.lda + C) * 2u; voffB[i] = (unsigned)(Rb * K + C) * 2u; }
    const size_t kstep = (size_t)(BK * 2);
    const size_t hstepA = (size_t)HALF * g.lda * 2, hstepB = (size_t)HALF * K * 2;
    const size_t tstepA = 2 * hstepA, tstepB = 2 * hstepB;
    const unsigned ldsw = (unsigned)wid * 1024u;
    const int aoff = lds_byte(wr * 64 + fr, fq * 8), boff = lds_byte(wc * 32 + fr, fq * 8);
#define PG8_SA(b, h) (((b) * 2 + (h)) * HTB)
#define PG8_SB(b, h) ((4 + (b) * 2 + (h)) * HTB)
#define PG8_STAGE(bufoff, gbase, voff) do { _Pragma("unroll") for (int _i = 0; _i < 2; ++_i) \
        __builtin_amdgcn_global_load_lds((const unsigned*)((const char*)(gbase) + (voff)[_i]), (PG8_LAS unsigned*)(lds + (bufoff) + ldsw + _i * 8192), 16, 0, 0); } while (0)
#define PG8_LDA(dst, b, h) do { _Pragma("unroll") for (int m = 0; m < 4; ++m) _Pragma("unroll") for (int k = 0; k < 2; ++k) dst[m][k] = *(const PG8_LAS bf16x8*)(lds + PG8_SA(b, h) + aoff + m * 2048 + k * 1024); } while (0)
#define PG8_LDB(dst, b, h) do { _Pragma("unroll") for (int n = 0; n < 2; ++n) _Pragma("unroll") for (int k = 0; k < 2; ++k) dst[n][k] = *(const PG8_LAS bf16x8*)(lds + PG8_SB(b, h) + boff + n * 2048 + k * 1024); } while (0)
#define PG8_MMA(ai, bj, At, Bt) do { __builtin_amdgcn_s_setprio(1); _Pragma("unroll") for (int m = 0; m < 4; ++m) _Pragma("unroll") for (int n = 0; n < 2; ++n) _Pragma("unroll") for (int k = 0; k < 2; ++k) \
        acc[ai][bj][m][n] = __builtin_amdgcn_mfma_f32_16x16x32_bf16(Bt[n][k], At[m][k], acc[ai][bj][m][n], 0, 0, 0); __builtin_amdgcn_s_setprio(0); } while (0)
#define PG8_WAIT_V(n) asm volatile("s_waitcnt vmcnt(" #n ")" ::: "memory")
#define PG8_WAIT_L(n) asm volatile("s_waitcnt lgkmcnt(" #n ")" ::: "memory")
#define PG8_BAR __builtin_amdgcn_s_barrier()
#define PG8_SCHED __builtin_amdgcn_sched_barrier(0)
    Unit cur, nxt; int ui = 0;
    if (!S.next(0, cur)) return;
    f32x4 acc[2][2][4][2];
#pragma unroll
    for (int a = 0; a < 2; ++a)
#pragma unroll
        for (int b = 0; b < 2; ++b)
#pragma unroll
            for (int m = 0; m < 4; ++m)
#pragma unroll
                for (int n = 0; n < 2; ++n) acc[a][b][m][n] = (f32x4){0.f, 0.f, 0.f, 0.f};
    bf16x8 At[4][2], B0[2][2], B1[2][2];
    const char* cA = (const char*)g.A + (size_t)cur.pm * tstepA; const char* cB = (const char*)g.Bt + (size_t)cur.pn * tstepB;
    S.a_ready(cur);
    if constexpr (SP2) {
        PG8_STAGE(PG8_SB(0, 0), cB, voffB); PG8_STAGE(PG8_SB(0, 1), cB + hstepB, voffB); PG8_STAGE(PG8_SA(0, 0), cA, voffA); PG8_STAGE(PG8_SA(0, 1), cA + hstepA, voffA);
        if (wr == 1) PG8_BAR;
        PG8_WAIT_V(2); PG8_BAR;
        PG8_STAGE(PG8_SB(1, 0), cB + kstep, voffB); PG8_STAGE(PG8_SA(1, 0), cA + kstep, voffA); PG8_STAGE(PG8_SB(1, 1), cB + hstepB + kstep, voffB);
        PG8_WAIT_V(6); PG8_BAR;
    } else {
        PG8_STAGE(PG8_SB(0, 0), cB, voffB); PG8_STAGE(PG8_SA(0, 0), cA, voffA); PG8_STAGE(PG8_SB(0, 1), cB + hstepB, voffB); PG8_STAGE(PG8_SA(0, 1), cA + hstepA, voffA);
        if (wr == 1) PG8_BAR;
        PG8_WAIT_V(4); PG8_BAR;
        PG8_STAGE(PG8_SB(1, 0), cB + kstep, voffB); PG8_STAGE(PG8_SA(1, 0), cA + kstep, voffA); PG8_STAGE(PG8_SB(1, 1), cB + hstepB + kstep, voffB);
        PG8_WAIT_V(6); PG8_BAR;
    }
    for (;;) {
        const bool has_next = S.next(ui + 1, nxt);
        const char* nA = has_next ? (const char*)g.A + (size_t)nxt.pm * tstepA : cA; const char* nB = has_next ? (const char*)g.Bt + (size_t)nxt.pn * tstepB : cB;
        for (int t = 0; t < nt; t += 2) {
            const bool last = (t == nt - 2);
            const char* a1 = cA + (size_t)(t + 1) * kstep;
            const char* a2 = last ? nA : cA + (size_t)(t + 2) * kstep; const char* b2 = last ? nB : cB + (size_t)(t + 2) * kstep;
            const char* a3 = a2 + kstep; const char* b3 = b2 + kstep;
            if (last && has_next) S.a_ready(nxt);
            if constexpr (SP2) {
            PG8_LDB(B0, 0, 0); PG8_LDB(B1, 0, 1); PG8_SCHED; PG8_LDA(At, 0, 0); PG8_STAGE(PG8_SA(1, 1), a1 + hstepA, voffA);
            PG8_WAIT_V(8); PG8_WAIT_L(0); PG8_BAR; PG8_MMA(0, 0, At, B0); PG8_MMA(0, 1, At, B1); PG8_BAR; PG8_SCHED;
            PG8_LDA(At, 0, 1); PG8_STAGE(PG8_SB(0, 0), b2, voffB); PG8_STAGE(PG8_SB(0, 1), b2 + hstepB, voffB); PG8_STAGE(PG8_SA(0, 0), a2, voffA);
            PG8_WAIT_V(8); PG8_WAIT_L(0); PG8_BAR; PG8_MMA(1, 0, At, B0); PG8_MMA(1, 1, At, B1); PG8_BAR; PG8_SCHED;
            PG8_LDB(B0, 1, 0); PG8_LDB(B1, 1, 1); PG8_SCHED; PG8_LDA(At, 1, 0); PG8_STAGE(PG8_SA(0, 1), a2 + hstepA, voffA);
            PG8_WAIT_V(8); PG8_WAIT_L(0); PG8_BAR; PG8_MMA(0, 0, At, B0); PG8_MMA(0, 1, At, B1); PG8_BAR; PG8_SCHED;
            PG8_LDA(At, 1, 1); PG8_STAGE(PG8_SB(1, 0), b3, voffB); PG8_STAGE(PG8_SB(1, 1), b3 + hstepB, voffB); PG8_STAGE(PG8_SA(1, 0), a3, voffA);
            PG8_WAIT_V(8); PG8_WAIT_L(0); PG8_BAR; PG8_MMA(1, 0, At, B0); PG8_MMA(1, 1, At, B1); PG8_BAR; PG8_SCHED;
            } else {
            PG8_LDB(B0, 0, 0); PG8_SCHED; PG8_LDA(At, 0, 0); PG8_STAGE(PG8_SA(1, 1), a1 + hstepA, voffA);
            PG8_WAIT_L(8); PG8_BAR; PG8_WAIT_L(0); PG8_MMA(0, 0, At, B0); PG8_BAR; PG8_SCHED;
            PG8_LDB(B1, 0, 1); PG8_STAGE(PG8_SB(0, 0), b2, voffB);
            PG8_BAR; PG8_WAIT_L(0); PG8_MMA(0, 1, At, B1); PG8_BAR;
            PG8_LDA(At, 0, 1); PG8_STAGE(PG8_SA(0, 0), a2, voffA);
            PG8_BAR; PG8_WAIT_L(0); PG8_MMA(1, 0, At, B0); PG8_BAR; PG8_SCHED;
            PG8_STAGE(PG8_SB(0, 1), b2 + hstepB, voffB);
            PG8_WAIT_V(6); PG8_BAR; PG8_MMA(1, 1, At, B1); PG8_BAR;
            PG8_LDB(B0, 1, 0); PG8_SCHED; PG8_LDA(At, 1, 0); PG8_STAGE(PG8_SA(0, 1), a2 + hstepA, voffA);
            PG8_WAIT_L(8); PG8_BAR; PG8_WAIT_L(0); PG8_MMA(0, 0, At, B0); PG8_BAR; PG8_SCHED;
            PG8_LDB(B1, 1, 1); PG8_STAGE(PG8_SB(1, 0), b3, voffB);
            PG8_BAR; PG8_WAIT_L(0); PG8_MMA(0, 1, At, B1); PG8_BAR;
            PG8_LDA(At, 1, 1); PG8_STAGE(PG8_SA(1, 0), a3, voffA);
            PG8_BAR; PG8_WAIT_L(0); PG8_MMA(1, 0, At, B0); PG8_BAR; PG8_SCHED;
            PG8_STAGE(PG8_SB(1, 1), b3 + hstepB, voffB);
            PG8_WAIT_V(6); PG8_BAR; PG8_MMA(1, 1, At, B1); PG8_BAR;
            }
        }
        if constexpr (ALIGN_EPI) { if (wr == 0) PG8_BAR; }
        if constexpr (!Epi::AFTER_DRAIN) { E(acc, cur, wr, wc, fr, fq); S.done(cur); }
        if (!has_next) break;
#pragma unroll
        for (int a = 0; a < 2; ++a)
#pragma unroll
            for (int b = 0; b < 2; ++b)
#pragma unroll
                for (int m = 0; m < 4; ++m)
#pragma unroll
                    for (int n = 0; n < 2; ++n) acc[a][b][m][n] = (f32x4){0.f, 0.f, 0.f, 0.f};
        cur = nxt; cA = nA; cB = nB; ++ui;
        if constexpr (ALIGN_EPI) { if (wr == 1) PG8_BAR; }
    }
    PG8_WAIT_V(0);
    if constexpr (!ALIGN_EPI) { if (wr == 0) PG8_BAR; }
    PG8_BAR;
    if constexpr (Epi::AFTER_DRAIN) { E.fused(acc, cur, wr, wc, fr, fq, lds, wid, lane); S.done(cur); }
#undef PG8_SA
#undef PG8_SB
#undef PG8_STAGE
#undef PG8_LDA
#undef PG8_LDB
#undef PG8_MMA
#undef PG8_WAIT_V
#undef PG8_WAIT_L
#undef PG8_BAR
#undef PG8_SCHED
}
}

namespace fa {
constexpr int D = 128;
constexpr int NW = 8, QBLK = 32, KVBLK = 64, QB = NW * QBLK;
constexpr int SHM_V = KVBLK * D * 2, SHM_K = KVBLK * D * 2, SHM_KP = KVBLK * 64 * 2;
constexpr int LDS_WS = 2 * SHM_V + 2 * SHM_K;
constexpr int LDS_KP = LDS_WS + NW * 64 * 4;
constexpr int LDS_BYTES = LDS_KP + 2 * SHM_KP;
constexpr float THR = 8.f;

using bf16 = __hip_bfloat16;
typedef short bf16x8 __attribute__((ext_vector_type(8)));
typedef short s16x4 __attribute__((ext_vector_type(4)));
typedef float f32x16 __attribute__((ext_vector_type(16)));
typedef float f32x4 __attribute__((ext_vector_type(4)));
typedef unsigned u32x4 __attribute__((ext_vector_type(4)));

#define KSWZ(row, colB) ((row) * 256 + ((colB) ^ (((row) & 7) << 4)))
#define KPSWZ(row, colB) ((row) * 128 + ((colB) ^ (((row) & 7) << 4)))
#define SBAR() __builtin_amdgcn_sched_barrier(0)
__device__ __forceinline__ int v_st(int k, int c) { const int kk = (k & ~0xC) | ((k & 4) << 1) | ((k & 8) >> 1); return ((kk >> 3) * 4 + (c >> 5)) * 512 + ((kk & 7) * 32 + (c & 31)) * 2; }
__device__ __forceinline__ int v_rd_base(int lane) { return ((lane & 3) << 3) | (((lane >> 2) & 3) << 6) | (((lane >> 4) & 1) << 5) | (((lane >> 5) & 1) << 8); }
constexpr int v_rd_off(int d0, int ks, int half) { return d0 * 512 + ks * 4096 + half * 2048; }
__device__ __forceinline__ int crow(int r, int hi) { return (r & 3) + 8 * (r >> 2) + 4 * hi; }
__device__ __forceinline__ unsigned cvtpk(float lo, float hi) {
    unsigned r; asm volatile("v_cvt_pk_bf16_f32 %0, %1, %2" : "=v"(r) : "v"(lo), "v"(hi)); return r;
}
__device__ __forceinline__ bf16x8 load8(const bf16* p) { return *reinterpret_cast<const bf16x8*>(p); }
__device__ __forceinline__ void mask_tile(f32x16& p0, f32x16& p1, int dq, unsigned W) {
    const float NEG = -__builtin_inff();
#pragma unroll
    for (int r = 0; r < 16; ++r) {
        const int c = (r & 3) + 8 * (r >> 2);
        if ((unsigned)(dq - c) >= W) p0[r] = NEG;
        if ((unsigned)(dq - c - 32) >= W) p1[r] = NEG;
    }
}
template <class C>
__device__ __forceinline__ void partialSM(f32x16& p0, f32x16& p1, float& m_reg, float& mn, float& alpha) {
    float pmax = p0[0]; for (int r = 1; r < 16; ++r) pmax = fmaxf(pmax, p0[r]); for (int r = 0; r < 16; ++r) pmax = fmaxf(pmax, p1[r]);
    { auto rr = __builtin_amdgcn_permlane32_swap(__float_as_uint(pmax), __float_as_uint(pmax), false, false);
      pmax = fmaxf(__uint_as_float(rr[0]), __uint_as_float(rr[1])); }
    constexpr float C2 = 1.4426950408889634f * C::SCALE;
    if (__builtin_expect(__all((pmax - m_reg) * C::SCALE <= THR), 1)) { mn = m_reg; alpha = 1.f; }
    else { mn = fmaxf(m_reg, pmax); alpha = __builtin_amdgcn_exp2f((m_reg - mn) * C2); m_reg = mn; }
    const float mnL = -mn * C2;
    for (int r = 0; r < 16; ++r) p0[r] = fmaf(p0[r], C2, mnL); for (int r = 0; r < 16; ++r) p1[r] = fmaf(p1[r], C2, mnL);
    for (int r = 0; r < 16; ++r) p0[r] = __builtin_amdgcn_exp2f(p0[r]);
}
#define FA_PK4(P, B_, OUT) do { unsigned a0 = cvtpk(P[B_+0], P[B_+1]), a1 = cvtpk(P[B_+2], P[B_+3]);                          \
        unsigned b0 = cvtpk(P[B_+4], P[B_+5]), b1 = cvtpk(P[B_+6], P[B_+7]);                                             \
        auto r0 = __builtin_amdgcn_permlane32_swap(a0, b0, false, false); auto r1 = __builtin_amdgcn_permlane32_swap(a1, b1, false, false); \
        u32x4 w = {r0[0], r1[0], r0[1], r1[1]}; OUT = *reinterpret_cast<bf16x8*>(&w); } while (0)
__device__ __forceinline__ void finishSM(f32x16& p0, f32x16& p1, float alpha, float& l_reg, bf16x8& pa0, bf16x8& pa1, bf16x8& pa2, bf16x8& pa3) {
    for (int r = 0; r < 16; ++r) p1[r] = __builtin_amdgcn_exp2f(p1[r]);
    float ps = 0; for (int r = 0; r < 16; ++r) ps += p0[r]; for (int r = 0; r < 16; ++r) ps += p1[r];
    { auto rr = __builtin_amdgcn_permlane32_swap(__float_as_uint(ps), __float_as_uint(ps), false, false);
      ps = __uint_as_float(rr[0]) + __uint_as_float(rr[1]); }
    l_reg = l_reg * alpha + ps;
    FA_PK4(p0, 0, pa0); FA_PK4(p0, 8, pa1); FA_PK4(p1, 0, pa2); FA_PK4(p1, 8, pa3);
}
__device__ __forceinline__ void packP(f32x16& p0, f32x16& p1, bf16x8& pa0, bf16x8& pa1, bf16x8& pa2, bf16x8& pa3) {
    FA_PK4(p0, 0, pa0); FA_PK4(p0, 8, pa1); FA_PK4(p1, 0, pa2); FA_PK4(p1, 8, pa3);
}
template <int KB, bool SK, bool PE>
__device__ __forceinline__ void qkt(f32x16& p0, f32x16& p1, const char* K_lds, const char* KP_lds, int r32, int hi, const bf16x8* qr, bool act) {
    if (SK && !act) { const float NEG = -__builtin_inff();
#pragma unroll
        for (int r = 0; r < 16; ++r) { p0[r] = NEG; p1[r] = NEG; } return; }
    p0 = f32x16{}; p1 = f32x16{};
    const char* kb[4];
#pragma unroll
    for (int dd = 0; dd < 4; ++dd) kb[dd] = K_lds + KB * SHM_K + KSWZ(r32, (dd * 16 + hi * 8) * 2);
#pragma unroll
    for (int d0 = 0; d0 < 8; ++d0) { const char* a = kb[d0 & 3] + (d0 >> 2) * 128;
        bf16x8 b0 = *reinterpret_cast<const bf16x8*>(a);
        bf16x8 b1 = *reinterpret_cast<const bf16x8*>(a + 32 * 256);
        p0 = __builtin_amdgcn_mfma_f32_32x32x16_bf16(b0, qr[d0], p0, 0, 0, 0);
        p1 = __builtin_amdgcn_mfma_f32_32x32x16_bf16(b1, qr[d0], p1, 0, 0, 0); }
    if constexpr (PE) {
#pragma unroll
        for (int d0 = 0; d0 < 4; ++d0) { const char* a = KP_lds + KB * SHM_KP + KPSWZ(r32, (d0 * 16 + hi * 8) * 2);
            bf16x8 b0 = *reinterpret_cast<const bf16x8*>(a);
            bf16x8 b1 = *reinterpret_cast<const bf16x8*>(a + 32 * 128);
            p0 = __builtin_amdgcn_mfma_f32_32x32x16_bf16(b0, qr[8 + d0], p0, 0, 0, 0);
            p1 = __builtin_amdgcn_mfma_f32_32x32x16_bf16(b1, qr[8 + d0], p1, 0, 0, 0); }
    }
}
template <int VB, bool SK>
__device__ __forceinline__ void pv_tile(f32x16* o, int vb0, bf16x8 pa0, bf16x8 pa1, bf16x8 pa2, bf16x8 pa3, bool act) {
    if (SK && !act) return;
#define TRRD(dst, off) asm volatile("ds_read_b64_tr_b16 %0, %1 offset:%2" : "=&v"(dst) : "v"(vb0), "i"(off) : "memory")
#define PV_D0(d0) do { s16x4 l0, l1, l2, l3, h0, h1, h2, h3; constexpr int b_ = VB * SHM_V + v_rd_off(d0, 0, 0);     \
        TRRD(l0, b_); TRRD(h0, b_ + 2048); TRRD(l1, b_ + 4096); TRRD(h1, b_ + 6144); TRRD(l2, b_ + 8192); TRRD(h2, b_ + 10240); TRRD(l3, b_ + 12288); TRRD(h3, b_ + 14336); \
        asm volatile("s_waitcnt lgkmcnt(0)" ::: "memory"); SBAR();   \
        o[d0] = __builtin_amdgcn_mfma_f32_32x32x16_bf16(pa0, (bf16x8){l0[0], l0[1], l0[2], l0[3], h0[0], h0[1], h0[2], h0[3]}, o[d0], 0, 0, 0);   \
        o[d0] = __builtin_amdgcn_mfma_f32_32x32x16_bf16(pa1, (bf16x8){l1[0], l1[1], l1[2], l1[3], h1[0], h1[1], h1[2], h1[3]}, o[d0], 0, 0, 0);   \
        o[d0] = __builtin_amdgcn_mfma_f32_32x32x16_bf16(pa2, (bf16x8){l2[0], l2[1], l2[2], l2[3], h2[0], h2[1], h2[2], h2[3]}, o[d0], 0, 0, 0);   \
        o[d0] = __builtin_amdgcn_mfma_f32_32x32x16_bf16(pa3, (bf16x8){l3[0], l3[1], l3[2], l3[3], h3[0], h3[1], h3[2], h3[3]}, o[d0], 0, 0, 0); } while (0)
    PV_D0(0); PV_D0(1); PV_D0(2); PV_D0(3);
#undef PV_D0
#undef TRRD
}

template <int QS_, int OS_, bool PE_, bool SK_, int SCALE_NUM> struct Cfg {
    static constexpr int QS = QS_, OS = OS_; static constexpr bool PE = PE_, SK = SK_;
    static constexpr float SCALE = SCALE_NUM == 128 ? 0.08838834764831845f : 0.07216878364870323f;
    static constexpr int NQ = PE_ ? 12 : 8;
};
struct BlockRef { const bf16* Q; const bf16* K; const bf16* V; const bf16* KP; bf16* O; float* L; int P0; };
template <class C> struct Seam { bf16x8 qr[C::NQ]; bf16x8 st_v0, st_v1, st_k0, st_k1, st_p; };
__device__ __forceinline__ int swa_jlo(int P0, int W) { const int lowk = P0 - W + 1; return lowk > 0 ? lowk / KVBLK : 0; }
#define ROW(p, k0, rr) ((p) + (size_t)((k0) + (rr)) * D + sc)
#define VMW() asm volatile("s_waitcnt vmcnt(0)" ::: "memory")
#define VMWN(n) asm volatile("s_waitcnt vmcnt(%0)" :: "i"(n) : "memory")
#define SLOAD_H(Kp, Vp, KPp, k0) do { S.st_v0 = load8(ROW(Vp, k0, sr)); S.st_v1 = load8(ROW(Vp, k0, 32 + sr));              \
                         S.st_k0 = load8(ROW(Kp, k0, sr)); S.st_k1 = load8(ROW(Kp, k0, 32 + sr));                           \
                         if constexpr (C::PE) S.st_p = load8((KPp) + (size_t)((k0) + pr) * 64 + pc); } while (0)
#define SWRITE_HK(bf) do { *(bf16x8*)(K_lds + (bf) * SHM_K + kws) = S.st_k0; *(bf16x8*)(K_lds + (bf) * SHM_K + kws + 32 * 256) = S.st_k1; \
                           if constexpr (C::PE) *(bf16x8*)(KP_lds + (bf) * SHM_KP + pws) = S.st_p; } while (0)
#define SWRITE_HV(bf) do { *(bf16x8*)(V_lds + (bf) * SHM_V + vst0) = S.st_v0; *(bf16x8*)(V_lds + (bf) * SHM_V + vst1) = S.st_v1; } while (0)
#define SWRITE_H(bf) do { SWRITE_HV(bf); SWRITE_HK(bf); } while (0)
#define QLOADS(ref) do { _Pragma("unroll") for (int d0 = 0; d0 < 8; ++d0) S.qr[d0] = load8((ref).Q + (size_t)(wid * QBLK + r32) * C::QS + d0 * 16 + hi * 8); \
        if constexpr (C::PE) { _Pragma("unroll") for (int d0 = 0; d0 < 4; ++d0) S.qr[8 + d0] = load8((ref).Q + (size_t)(wid * QBLK + r32) * C::QS + 128 + d0 * 16 + hi * 8); } } while (0)
template <class C>
__device__ __forceinline__ void prime(const BlockRef& cur, int W, char* lds, Seam<C>& S) {
    int tid_ = threadIdx.x; asm volatile("" : "+v"(tid_)); const int tid = tid_, wid = __builtin_amdgcn_readfirstlane(tid >> 6), lane = tid & 63, r32 = lane & 31, hi = lane >> 5;
    const int sr = tid >> 4, sc = (tid & 15) * 8, kws = KSWZ(sr, sc * 2); char* K_lds = lds + 2 * SHM_V; char* KP_lds = lds + LDS_KP;
    const int pr = tid >> 3, pc = (tid & 7) * 8, pws = KPSWZ(pr, pc * 2);
    const int kb0 = swa_jlo(cur.P0, W) * KVBLK;
    QLOADS(cur);
    SLOAD_H(cur.K, cur.V, cur.KP, kb0); VMW(); SWRITE_HK(0);
    __syncthreads();
}
template <class C>
__device__ __forceinline__ void block(const BlockRef& cur, const BlockRef& nxt, int skv, int W, char* lds, Seam<C>& S) {
    constexpr bool SK = C::SK, PE = C::PE;
    int tid_ = threadIdx.x; asm volatile("" : "+v"(tid_)); const int tid = tid_, wid = __builtin_amdgcn_readfirstlane(tid >> 6), lane = tid & 63, r32 = lane & 31, hi = lane >> 5;
    const int j_lo = swa_jlo(cur.P0, W);
    int j_hi = (cur.P0 + QB - 1) / KVBLK + 1; if (j_hi > skv / KVBLK) j_hi = skv / KVBLK;
    const int NT = j_hi - j_lo;
    const int kbn = swa_jlo(nxt.P0, W) * KVBLK;
    const int qlo = cur.P0 + wid * QBLK, qm = qlo + r32 - 4 * hi;
    char* V_lds = lds; char* K_lds = lds + 2 * SHM_V; char* KP_lds = lds + LDS_KP;
    float* ws = (float*)(lds + LDS_WS) + wid * 64; float* li_l = ws, * al_l = ws + 32;
    float m_reg = -1e30f, l_reg = 0; f32x16 o[4] = {};
    const int sr = tid >> 4, sc = (tid & 15) * 8, vst0 = v_st(sr, sc), vst1 = v_st(32 + sr, sc), kws = KSWZ(sr, sc * 2);
    const int pr = tid >> 3, pc = (tid & 7) * 8, pws = KPSWZ(pr, pc * 2);
    const int vb0 = (int)(uintptr_t)V_lds + v_rd_base(lane);
    const bf16* Kh = cur.K; const bf16* Vh = cur.V; const bf16* KPh = cur.KP;
#define RESC(a) do { if (__any((a) < 1.f)) { if (hi == 0) al_l[r32] = (a); asm volatile("s_waitcnt lgkmcnt(0)" ::: "memory");              \
                     for (int d_ = 0; d_ < 4; ++d_) for (int r = 0; r < 16; ++r) o[d_][r] *= al_l[crow(r, hi)]; } } while (0)
#define KBASE(t) ((j_lo + (t)) * KVBLK)
#define ACT(t) (KBASE(t) <= qlo + QBLK - 1 && KBASE(t) + KVBLK - 1 >= qlo - W + 1)
#define MASKT(P0_, P1_, t) do { const int kb_ = KBASE(t); if ((!SK || ACT(t)) && (kb_ + KVBLK - 1 > qlo || kb_ <= qlo + QBLK - 1 - W)) mask_tile(P0_, P1_, qm - kb_, (unsigned)W); } while (0)
    constexpr int NQL = C::NQ;
#define SEAM_K0() do { VMWN(NQL); SWRITE_HK(0); SBAR(); } while (0)
    f32x16 pA0, pA1, pB0, pB1; float mnA, mnB, alA, alB; bf16x8 pa0, pa1, pa2, pa3;
    SWRITE_HV(0); SBAR();
    if (NT > 1) { SLOAD_H(Kh, Vh, KPh, KBASE(1)); }
    SBAR(); qkt<0, SK, PE>(pA0, pA1, K_lds, KP_lds, r32, hi, S.qr, ACT(0));
    MASKT(pA0, pA1, 0); partialSM<C>(pA0, pA1, m_reg, mnA, alA);
    if (NT > 1) { VMW(); SWRITE_H(1); }
    __syncthreads();
#define HALF_STEP(PX0, PX1, mnX, alX, PY0, PY1, alY, t, KB, VB, SB) do {                                                      \
        SBAR(); qkt<KB, SK, PE>(PX0, PX1, K_lds, KP_lds, r32, hi, S.qr, ACT(t));                                             \
        finishSM(PY0, PY1, alY, l_reg, pa0, pa1, pa2, pa3); SBAR();                                                           \
        if ((t) + 1 < NT) { SLOAD_H(Kh, Vh, KPh, KBASE((t) + 1)); SBAR(); }                                               \
        pv_tile<VB, SK>(o, vb0, pa0, pa1, pa2, pa3, ACT((t) - 1)); MASKT(PX0, PX1, (t)); partialSM<C>(PX0, PX1, m_reg, mnX, alX);                                        \
        __syncthreads();                                                                                                      \
        if ((t) + 1 < NT) { VMW(); SWRITE_H(SB); }                                                                          \
        RESC(alX); __syncthreads(); } while (0)
    for (int t = 1; t + 1 < NT; t += 2) {
        HALF_STEP(pB0, pB1, mnB, alB, pA0, pA1, alA, t, 1, 0, 0);
        HALF_STEP(pA0, pA1, mnA, alA, pB0, pB1, alB, t + 1, 0, 1, 1);
    }
    const bool even = (NT & 1) == 0;
    if (even) { SBAR(); qkt<1, SK, PE>(pB0, pB1, K_lds, KP_lds, r32, hi, S.qr, ACT(NT - 1)); SBAR(); }
    SLOAD_H(nxt.K, nxt.V, nxt.KP, kbn); SBAR();
    QLOADS(nxt);
    SBAR();
    finishSM(pA0, pA1, alA, l_reg, pa0, pa1, pa2, pa3); SBAR();
    pv_tile<0, SK>(o, vb0, pa0, pa1, pa2, pa3, ACT(even ? NT - 2 : NT - 1));
    if (even) { MASKT(pB0, pB1, NT - 1); partialSM<C>(pB0, pB1, m_reg, mnB, alB); __syncthreads(); RESC(alB);
        finishSM(pB0, pB1, alB, l_reg, pa0, pa1, pa2, pa3); SBAR(); pv_tile<1, SK>(o, vb0, pa0, pa1, pa2, pa3, ACT(NT - 1)); }
    SBAR(); SEAM_K0();
    if (hi == 0) li_l[r32] = l_reg; asm volatile("s_waitcnt lgkmcnt(0)" ::: "memory");
    if (cur.L != nullptr && hi == 0) cur.L[wid * QBLK + r32] = m_reg * C::SCALE + __logf(l_reg);
    float rli[16];
#pragma unroll
    for (int r = 0; r < 16; ++r) rli[r] = __builtin_amdgcn_rcpf(li_l[crow(r, hi)]);
    bf16* Ow = cur.O + (size_t)(wid * QBLK) * C::OS;
#pragma unroll
    for (int r = 0; r < 16; ++r) { const int orow = crow(r, hi);
#pragma unroll
        for (int d0 = 0; d0 < 4; ++d0) { const float v = o[d0][r] * rli[r];
            const float vn = __shfl_xor(v, 1);
            if ((r32 & 1) == 0) *(unsigned*)(Ow + (size_t)orow * C::OS + d0 * 32 + r32) = cvtpk(v, vn); } }
    __syncthreads();
#undef RESC
#undef KBASE
#undef ACT
#undef MASKT
#undef SEAM_K0
#undef HALF_STEP
}

template <class C>
__device__ __forceinline__ void block_simple(const BlockRef& cur, int skv, int W, char* lds) {
    constexpr bool SK = C::SK, PE = C::PE;
    Seam<C> S;
    int tid_ = threadIdx.x; asm volatile("" : "+v"(tid_)); const int tid = tid_, wid = __builtin_amdgcn_readfirstlane(tid >> 6), lane = tid & 63, r32 = lane & 31, hi = lane >> 5;
    const int j_lo = swa_jlo(cur.P0, W);
    int j_hi = (cur.P0 + QB - 1) / KVBLK + 1; if (j_hi > skv / KVBLK) j_hi = skv / KVBLK;
    const int NT = j_hi - j_lo;
    const int qlo = cur.P0 + wid * QBLK, qm = qlo + r32 - 4 * hi;
    char* V_lds = lds; char* K_lds = lds + 2 * SHM_V; char* KP_lds = lds + LDS_KP;
    float* ws = (float*)(lds + LDS_WS) + wid * 64; float* li_l = ws, * al_l = ws + 32;
    float m_reg = -1e30f, l_reg = 0; f32x16 o[4] = {};
    const int sr = tid >> 4, sc = (tid & 15) * 8, vst0 = v_st(sr, sc), vst1 = v_st(32 + sr, sc), kws = KSWZ(sr, sc * 2);
    const int pr = tid >> 3, pc = (tid & 7) * 8, pws = KPSWZ(pr, pc * 2);
    const int vb0 = (int)(uintptr_t)V_lds + v_rd_base(lane);
    const bf16* Kh = cur.K; const bf16* Vh = cur.V; const bf16* KPh = cur.KP;
#define KBASE(t) ((j_lo + (t)) * KVBLK)
#define ACT(t) (KBASE(t) <= qlo + QBLK - 1 && KBASE(t) + KVBLK - 1 >= qlo - W + 1)
#define MASKT(P0_, P1_, t) do { const int kb_ = KBASE(t); if ((!SK || ACT(t)) && (kb_ + KVBLK - 1 > qlo || kb_ <= qlo + QBLK - 1 - W)) mask_tile(P0_, P1_, qm - kb_, (unsigned)W); } while (0)
#define RESC(a) do { if (__any((a) < 1.f)) { if (hi == 0) al_l[r32] = (a); asm volatile("s_waitcnt lgkmcnt(0)" ::: "memory");              \
                     for (int d_ = 0; d_ < 4; ++d_) for (int r = 0; r < 16; ++r) o[d_][r] *= al_l[crow(r, hi)]; } } while (0)
    QLOADS(cur);
    SLOAD_H(Kh, Vh, KPh, KBASE(0)); VMW(); SWRITE_H(0);
    __syncthreads();
    f32x16 p0, p1; float mn, al; bf16x8 pa0, pa1, pa2, pa3;
#define STEP(t, BUF) do { \
        if ((t) + 1 < NT) { SLOAD_H(Kh, Vh, KPh, KBASE((t) + 1)); SBAR(); } \
        qkt<BUF, SK, PE>(p0, p1, K_lds, KP_lds, r32, hi, S.qr, ACT(t)); \
        MASKT(p0, p1, (t)); partialSM<C>(p0, p1, m_reg, mn, al); finishSM(p0, p1, al, l_reg, pa0, pa1, pa2, pa3); RESC(al); SBAR(); \
        pv_tile<BUF, SK>(o, vb0, pa0, pa1, pa2, pa3, ACT(t)); \
        if ((t) + 1 < NT) { VMW(); SWRITE_H(1 - BUF); } \
        __syncthreads(); } while (0)
    for (int t = 0; t < NT; t += 2) {
        STEP(t, 0);
        if (t + 1 < NT) STEP(t + 1, 1);
    }
#undef STEP
    if (hi == 0) li_l[r32] = l_reg; asm volatile("s_waitcnt lgkmcnt(0)" ::: "memory");
    if (cur.L != nullptr && hi == 0) cur.L[wid * QBLK + r32] = m_reg * C::SCALE + __logf(l_reg);
    float rli[16];
#pragma unroll
    for (int r = 0; r < 16; ++r) rli[r] = __builtin_amdgcn_rcpf(li_l[crow(r, hi)]);
    bf16* Ow = cur.O + (size_t)(wid * QBLK) * C::OS;
#pragma unroll
    for (int r = 0; r < 16; ++r) { const int orow = crow(r, hi);
#pragma unroll
        for (int d0 = 0; d0 < 4; ++d0) { const float v = o[d0][r] * rli[r];
            const float vn = __shfl_xor(v, 1);
            if ((r32 & 1) == 0) *(unsigned*)(Ow + (size_t)orow * C::OS + d0 * 32 + r32) = cvtpk(v, vn); } }
    __syncthreads();
#undef RESC
#undef KBASE
#undef ACT
#undef MASKT
}

constexpr int SG_K = 3 * SHM_V, SG_WS = SG_K + 2 * SHM_K, SG_KP = SG_WS + NW * 64 * 4, SG_BYTES = SG_KP + 2 * SHM_KP;
#define FA_BAR() do { asm volatile("s_waitcnt lgkmcnt(0)" ::: "memory"); __builtin_amdgcn_s_barrier(); asm volatile("" ::: "memory"); } while (0)
template <class C>
__device__ __forceinline__ void block_stag(const BlockRef& cur, int skv, int W, char* lds, bool desc = false) {
    constexpr bool SK = C::SK, PE = C::PE;
    Seam<C> S;
    int tid_ = threadIdx.x; asm volatile("" : "+v"(tid_)); const int tid = tid_, wid = __builtin_amdgcn_readfirstlane(tid >> 6), lane = tid & 63, r32 = lane & 31, hi = lane >> 5;
    const int j_lo = swa_jlo(cur.P0, W);
    int j_hi = (cur.P0 + QB - 1) / KVBLK + 1; if (j_hi > skv / KVBLK) j_hi = skv / KVBLK;
    const int NT = j_hi - j_lo;
    const int qlo = cur.P0 + wid * QBLK, qm = qlo + r32 - 4 * hi;
    char* V_lds = lds; char* K_lds = lds + SG_K; char* KP_lds = lds + SG_KP;
    float* ws = (float*)(lds + SG_WS) + wid * 64; float* li_l = ws, * al_l = ws + 32;
    float m_reg = -1e30f, l_reg = 0; f32x16 o[4] = {};
    const int sr = tid >> 4, sc = (tid & 15) * 8, vst0 = v_st(sr, sc), vst1 = v_st(32 + sr, sc), kws = KSWZ(sr, sc * 2);
    const int pr = tid >> 3, pc = (tid & 7) * 8, pws = KPSWZ(pr, pc * 2);
    const int vb0 = (int)(uintptr_t)V_lds + v_rd_base(lane);
    const bf16* Kh = cur.K; const bf16* Vh = cur.V; const bf16* KPh = cur.KP;
#define KBASE(t) ((desc ? (j_hi - 1 - (t)) : (j_lo + (t))) * KVBLK)
#define ACT(t) (KBASE(t) <= qlo + QBLK - 1 && KBASE(t) + KVBLK - 1 >= qlo - W + 1)
#define MASKT(P0_, P1_, t) do { const int kb_ = KBASE(t); if ((!SK || ACT(t)) && (kb_ + KVBLK - 1 > qlo || kb_ <= qlo + QBLK - 1 - W)) mask_tile(P0_, P1_, qm - kb_, (unsigned)W); } while (0)
#define RESC(a) do { if (__any((a) < 1.f)) { if (hi == 0) al_l[r32] = (a); asm volatile("s_waitcnt lgkmcnt(0)" ::: "memory");              \
                     for (int d_ = 0; d_ < 4; ++d_) for (int r = 0; r < 16; ++r) o[d_][r] *= al_l[crow(r, hi)]; } } while (0)
#define SWRITE_RT(kb_, vb_) do { *(bf16x8*)(V_lds + (vb_) * SHM_V + vst0) = S.st_v0; *(bf16x8*)(V_lds + (vb_) * SHM_V + vst1) = S.st_v1;                 \
        *(bf16x8*)(K_lds + (kb_) * SHM_K + kws) = S.st_k0; *(bf16x8*)(K_lds + (kb_) * SHM_K + kws + 32 * 256) = S.st_k1;                                \
        if constexpr (C::PE) *(bf16x8*)(KP_lds + (kb_) * SHM_KP + pws) = S.st_p; } while (0)
    QLOADS(cur);
    SLOAD_H(Kh, Vh, KPh, KBASE(0)); VMW(); SWRITE_RT(0, 0);
    FA_BAR();
    if (NT > 1) SLOAD_H(Kh, Vh, KPh, KBASE(1));
    if (wid >= 4) FA_BAR();
    f32x16 p0, p1; float mn, al; bf16x8 pa0, pa1, pa2, pa3;
    int kb = 0, vb = 0;
    for (int t = 0; t < NT; ++t) {
        const int kbn = kb ^ 1, vbn = (vb == 2) ? 0 : vb + 1;
        qkt<0, SK, PE>(p0, p1, K_lds + kb * SHM_K, KP_lds + kb * SHM_KP, r32, hi, S.qr, ACT(t));
        if (t + 1 < NT) { VMW(); SWRITE_RT(kbn, vbn); }
        FA_BAR();
        if (t + 2 < NT) { SLOAD_H(Kh, Vh, KPh, KBASE(t + 2)); SBAR(); }
        MASKT(p0, p1, t); partialSM<C>(p0, p1, m_reg, mn, al); finishSM(p0, p1, al, l_reg, pa0, pa1, pa2, pa3); RESC(al); SBAR();
        pv_tile<0, SK>(o, vb0 + vb * SHM_V, pa0, pa1, pa2, pa3, ACT(t));
        FA_BAR();
        kb = kbn; vb = vbn;
    }
    if (wid < 4) FA_BAR();
    if (hi == 0) li_l[r32] = l_reg; asm volatile("s_waitcnt lgkmcnt(0)" ::: "memory");
    if (cur.L != nullptr && hi == 0) cur.L[wid * QBLK + r32] = m_reg * C::SCALE + __logf(l_reg);
    float rli[16];
#pragma unroll
    for (int r = 0; r < 16; ++r) rli[r] = __builtin_amdgcn_rcpf(li_l[crow(r, hi)]);
    bf16* Ow = cur.O + (size_t)(wid * QBLK) * C::OS;
#pragma unroll
    for (int r = 0; r < 16; ++r) { const int orow = crow(r, hi);
#pragma unroll
        for (int d0 = 0; d0 < 4; ++d0) { const float v = o[d0][r] * rli[r];
            const float vn = __shfl_xor(v, 1);
            if ((r32 & 1) == 0) *(unsigned*)(Ow + (size_t)orow * C::OS + d0 * 32 + r32) = cvtpk(v, vn); } }
    FA_BAR();
#undef SWRITE_RT
#undef RESC
#undef KBASE
#undef ACT
#undef MASKT
}
#undef ROW
#undef VMW
#undef VMWN
#undef SLOAD_H
#undef SWRITE_HK
#undef SWRITE_HV
#undef SWRITE_H
#undef QLOADS
}
constexpr int BATCH = 2, SEQ = 16384, DM = 2048, MTOK = BATCH * SEQ, DFF = 8192;
constexpr float EPS = 1e-6f;
constexpr int NWAVES = 8, NTHREADS = 512;
constexpr int LDS_BAR_ST = 159744 - 64;
constexpr int LDS_BYTES = 159744;
constexpr size_t MiB = 1u << 20;
typedef unsigned short bf16_t;
typedef float f32x4 __attribute__((ext_vector_type(4)));
typedef unsigned u32x4 __attribute__((ext_vector_type(4)));
typedef unsigned u32x2 __attribute__((ext_vector_type(2)));

constexpr size_t W_L1_WIN = 0;
constexpr size_t W_L1_WOUT = W_L1_WIN + (size_t)9216 * 2048 * 2;
constexpr size_t W_L1_FF1 = W_L1_WOUT + (size_t)2048 * 1024 * 2;
constexpr size_t W_L1_FF2 = W_L1_FF1 + (size_t)8192 * 2048 * 2;
constexpr size_t W_L0_WIN = W_L1_FF2 + (size_t)2048 * 8192 * 2;
constexpr size_t W_L0_WOUT = W_L0_WIN + (size_t)3584 * 2048 * 2;
constexpr size_t W_L0_FF1 = W_L0_WOUT + (size_t)2048 * 2048 * 2;
constexpr size_t W_L0_FF2 = W_L0_FF1 + (size_t)8192 * 2048 * 2;
constexpr size_t W_UQ = W_L0_FF2 + (size_t)2048 * 8192 * 2;
constexpr size_t W_UKV = W_UQ + (size_t)1536 * 512 * 2;
constexpr size_t W_C1 = W_UKV + (size_t)2048 * 256 * 2;
constexpr size_t W_C2 = W_C1 + (size_t)256 * 4096 * 2;
constexpr size_t W_END = W_C2 + (size_t)256 * 256 * 2;
constexpr size_t SM_BASE = 196 * MiB;
static_assert(W_END <= SM_BASE, "weights");
constexpr size_t SM_ROPE_C = SM_BASE;
constexpr size_t SM_ROPE_S = SM_ROPE_C + (size_t)SEQ * 64 * 4;
constexpr size_t SM_ROPE2_C = SM_ROPE_S + (size_t)SEQ * 64 * 4;
constexpr size_t SM_ROPE2_S = SM_ROPE2_C + (size_t)SEQ * 32 * 4;
constexpr size_t SM_ROWSQ = SM_ROPE2_S + (size_t)SEQ * 32 * 4;
enum { RS_X = 0, RS_H1, RS_H2, RS_H3, RS_CQ = 4  , RS_CKV = 6  , RS_N = 8 };
constexpr size_t SM_CBIAS = SM_ROWSQ + (size_t)RS_N * MTOK * 4;
constexpr size_t SM_GATE = SM_CBIAS + 1024;
constexpr size_t SM_LSE = SM_GATE + (size_t)MTOK * 24 * 4;
constexpr size_t SM_END = SM_LSE + (size_t)3 * MTOK * 8 * 4;
constexpr size_t SM_BAR = (SM_END + 255) / 256 * 256;
constexpr size_t ACT_BASE = 216 * MiB;
static_assert(SM_BAR + 16384 <= ACT_BASE, "barrier words");
static_assert(SM_END <= ACT_BASE, "small");
constexpr size_t A_HB = ACT_BASE;
constexpr size_t A_QN = A_HB + 128 * MiB;
constexpr size_t A_KV = A_QN + 64 * MiB;
constexpr size_t A_KVPAD = A_KV + 96 * MiB;
constexpr size_t A_VST = A_KVPAD + 1 * MiB;
constexpr size_t A_CQ = A_VST + 16 * MiB;
constexpr size_t A_CKV = A_CQ + 32 * MiB;
constexpr size_t A_KPE = A_CKV + 16 * MiB;
constexpr size_t A_HC = A_KPE + 4 * MiB;
constexpr size_t A_KCMP = A_HC + 4 * MiB;
constexpr size_t A_VCMP = A_KCMP + 1 * MiB;
constexpr size_t A_OW = A_VCMP + 1 * MiB;
constexpr size_t A_O = A_OW + 64 * MiB;
constexpr size_t A_MM = A_O + 128 * MiB;
constexpr size_t A_OP = A_MM + 128 * MiB;
constexpr size_t A_KST = A_OP + 64 * MiB;
constexpr size_t A_L0_END = A_KST + 16 * MiB;
static_assert(A_L0_END <= 1024 * MiB, "layer-0 map");
constexpr size_t DO_MQ = 0, DO_MK = 96 * MiB, DO_MV = 160 * MiB;
constexpr size_t A_F = A_HB + 128 * MiB;
constexpr size_t A_HID = A_F + 128 * MiB;
static_assert(A_HID + 512 * MiB <= 1024 * MiB, "ffn map");
constexpr size_t A_Z1 = A_HB + 128 * MiB;
constexpr size_t A_OG0 = A_Z1 + 576 * MiB;
constexpr size_t A_OG1 = W_L0_WIN;
constexpr size_t A_OG2 = A_HB;
static_assert(A_OG0 + 64 * MiB <= 1024 * MiB && A_OG1 + 64 * MiB <= SM_BASE, "OG map");
constexpr size_t A_O1 = A_HB + 64 * MiB;
constexpr size_t A_MM1 = A_Z1;
static_assert(A_Z1 + 576 * MiB <= 1024 * MiB, "layer-1 map");
#ifndef NSA_REP_CMP
#define NSA_REP_CMP 1
#endif
#ifndef NSA_REP_TOPK
#define NSA_REP_TOPK 1
#endif
#ifndef NSA_REP_SLC
#define NSA_REP_SLC 1
#endif
namespace nsa {
using namespace fa;
constexpr int IMP_STRIDE = 257;
constexpr int LDS_IMP = 84992;
constexpr int LDS_SEL = LDS_IMP + 64 * IMP_STRIDE * 4;
constexpr int LDS_CNT = LDS_SEL + 64 * 16 * 2;
constexpr int LDS_END = LDS_CNT + 64 * 4;
constexpr float C2 = 1.4426950408889634f * 0.08838834764831845f;
typedef float f32x4v __attribute__((ext_vector_type(4)));
using CN = Cfg<128, 128, false, false, 128>;

struct Tensors {
    const bf16* QN;
    const bf16* KC;
    const bf16* VC;
    const bf16* KST;
    const bf16* VST;
    const bf16* OW;
    bf16* OP;
    const float* GATE;
    bf16* O;
};

__device__ __forceinline__ unsigned long long wave_max_u64(unsigned long long v) {
#pragma unroll
    for (int o = 1; o < 64; o <<= 1) { const unsigned long long w = __shfl_xor(v, o); v = w > v ? w : v; }
    return v;
}

__device__ __forceinline__ void slc_row(const Tensors& T, int b, int g, int t, const short* selrow, int cnt, int lane) {
    constexpr int S = 16384;
    const int col = lane & 15, q4 = lane >> 4;
    const size_t bg = (size_t)(b * 2 + g);
    bf16x8 Bq[4];
    { const bf16* qp = T.QN + (((size_t)(b * 8 + 4 * g + (col & 3)) * S + t) * 128) + 8 * q4;
#pragma unroll
      for (int ks = 0; ks < 4; ++ks) { bf16x8 v = load8(qp + 32 * ks); if (col >= 4) v = (bf16x8){0, 0, 0, 0, 0, 0, 0, 0}; Bq[ks] = v; } }
    float m_run = -1e30f, l_run = 0.f;
    f32x4v oacc[8];
#pragma unroll
    for (int i = 0; i < 8; ++i) oacc[i] = (f32x4v){0.f, 0.f, 0.f, 0.f};
    const bf16* Kbase = T.KST + bg * 256 * 8192 + (size_t)lane * 8;
    const bf16* Vbase = T.VST + bg * 256 * 8192 + (size_t)lane * 8;
    bf16x8 Kf[16];
    int jb = __builtin_amdgcn_readfirstlane((int)selrow[0]);
    { const bf16* Kb = Kbase + (size_t)jb * 8192;
#pragma unroll
      for (int c = 0; c < 16; ++c) Kf[c] = load8(Kb + c * 512); }
    for (int i = 0; i < cnt; ++i) {
        const bf16* Vb = Vbase + (size_t)jb * 8192;
        bf16x8 Va[16];
#pragma unroll
        for (int c = 0; c < 16; ++c) Va[c] = load8(Vb + c * 512);
        f32x4v sacc[4];
#pragma unroll
        for (int kg = 0; kg < 4; ++kg) { sacc[kg] = (f32x4v){0.f, 0.f, 0.f, 0.f};
#pragma unroll
            for (int ks = 0; ks < 4; ++ks) sacc[kg] = __builtin_amdgcn_mfma_f32_16x16x32_bf16(Kf[kg * 4 + ks], Bq[ks], sacc[kg], 0, 0, 0); }
        const int kbase = 64 * jb + 4 * q4;
        if (i + 1 < cnt) {
            jb = __builtin_amdgcn_readfirstlane((int)selrow[i + 1]);
            const bf16* Kb = Kbase + (size_t)jb * 8192;
#pragma unroll
            for (int c = 0; c < 16; ++c) Kf[c] = load8(Kb + c * 512);
        }
        float mx = -__builtin_inff();
#pragma unroll
        for (int kg = 0; kg < 4; ++kg)
#pragma unroll
            for (int r = 0; r < 4; ++r) { if (kbase + 16 * kg + r > t) sacc[kg][r] = -__builtin_inff(); mx = fmaxf(mx, sacc[kg][r]); }
        mx = fmaxf(mx, __shfl_xor(mx, 16)); mx = fmaxf(mx, __shfl_xor(mx, 32));
        const float m_new = fmaxf(m_run, mx);
        const float alpha = __builtin_amdgcn_exp2f((m_run - m_new) * C2);
        m_run = m_new;
        const float mL = -m_new * C2;
        float ps = 0.f;
#pragma unroll
        for (int kg = 0; kg < 4; ++kg)
#pragma unroll
            for (int r = 0; r < 4; ++r) { const float p = __builtin_amdgcn_exp2f(fmaf(sacc[kg][r], C2, mL)); sacc[kg][r] = p; ps += p; }
        l_run = l_run * alpha + ps;
#pragma unroll
        for (int dg = 0; dg < 8; ++dg) oacc[dg] = oacc[dg] * alpha;
        bf16x8 Bp[2];
#pragma unroll
        for (int kp = 0; kp < 2; ++kp) { u32x4 w = {cvtpk(sacc[2 * kp][0], sacc[2 * kp][1]), cvtpk(sacc[2 * kp][2], sacc[2 * kp][3]),
                                                    cvtpk(sacc[2 * kp + 1][0], sacc[2 * kp + 1][1]), cvtpk(sacc[2 * kp + 1][2], sacc[2 * kp + 1][3])};
            Bp[kp] = *reinterpret_cast<bf16x8*>(&w); }
#pragma unroll
        for (int dg = 0; dg < 8; ++dg)
#pragma unroll
            for (int kp = 0; kp < 2; ++kp) oacc[dg] = __builtin_amdgcn_mfma_f32_16x16x32_bf16(Va[dg * 2 + kp], Bp[kp], oacc[dg], 0, 0, 0);
    }
    l_run += __shfl_xor(l_run, 16); l_run += __shfl_xor(l_run, 32);
    if (col < 4) {
        const int head = 4 * g + col;
        const size_t m = (size_t)b * S + t;
        const float g1 = T.GATE[m * 24 + head * 3 + 1];
        const float sc = l_run > 0.f ? g1 / l_run : 0.f;
        const bf16* pre = T.OP + (((size_t)(b * 8 + head) * S + t) * 128) + 4 * q4;
        bf16* out = T.O + m * 2048 + head * 128 + 4 * q4;
#pragma unroll
        for (int dg = 0; dg < 8; ++dg) {
            const unsigned long long pv64 = __hip_atomic_load(reinterpret_cast<const unsigned long long*>(pre + 16 * dg), __ATOMIC_RELAXED, __HIP_MEMORY_SCOPE_AGENT);
            uint2 pv; pv.x = (unsigned)pv64; pv.y = (unsigned)(pv64 >> 32);
            const float a0 = __uint_as_float(pv.x << 16), a1 = __uint_as_float(pv.x & 0xffff0000u), a2 = __uint_as_float(pv.y << 16), a3 = __uint_as_float(pv.y & 0xffff0000u);
            uint2 w; w.x = cvtpk(a0 + sc * oacc[dg][0], a1 + sc * oacc[dg][1]); w.y = cvtpk(a2 + sc * oacc[dg][2], a3 + sc * oacc[dg][3]);
            *reinterpret_cast<uint2*>(out + 16 * dg) = w;
        }
    }
}

__device__ __forceinline__ void nsa_block(const Tensors& T, int b, int g, int c, char* lds) {
    constexpr int S = 16384;
    int tid_ = threadIdx.x; asm volatile("" : "+v"(tid_)); const int tid = tid_, wid = __builtin_amdgcn_readfirstlane(tid >> 6), lane = tid & 63, r32 = lane & 31, hi = lane >> 5;
    const int hh = wid & 3, rh = wid >> 2, head = 4 * g + hh;
    unsigned* imp = (unsigned*)(lds + LDS_IMP);
    short* sel = (short*)(lds + LDS_SEL);
    int* cntp = (int*)(lds + LDS_CNT);
    const int t0 = 64 * c;
    const int n_vis = 4 * c + 3;
    const int NT = (n_vis + 63) >> 6;
    bf16x8 qr[8];
    { const bf16* qp = T.QN + (((size_t)(b * 8 + head) * S + t0 + 32 * rh + r32) * 128) + hi * 8;
#pragma unroll
      for (int d0 = 0; d0 < 8; ++d0) qr[d0] = load8(qp + d0 * 16); }
    const int trow = t0 + 32 * rh + r32;
    const int vp = (trow - 31) >> 4;
    char* V_lds = lds; char* K_lds = lds + 2 * SHM_V;
    const int sr = tid >> 4, sc = (tid & 15) * 8, vst0 = v_st(sr, sc), vst1 = v_st(32 + sr, sc), kws = KSWZ(sr, sc * 2);
    const int vb0 = (int)(uintptr_t)V_lds + v_rd_base(lane);
    const bf16* Kh = T.KC + (size_t)(b * 2 + g) * 1024 * 128;
    const bf16* Vh = T.VC + (size_t)(b * 2 + g) * 1024 * 128;
    float* ws = (float*)(lds + LDS_WS) + wid * 64; float* li_l = ws, * al_l = ws + 32;
    bf16x8 st_k0, st_k1, st_v0, st_v1;
#define ROWP(p, k0, rr) ((p) + (size_t)((k0) + (rr)) * 128 + sc)
    f32x16 o[4];
    for (int repc_ = 0; repc_ < NSA_REP_CMP; ++repc_) {
    for (int i = tid; i < 64 * IMP_STRIDE; i += 512) imp[i] = 0u;
    __syncthreads();
    float m_reg = -1e30f, l_reg = 0.f;
    {
        st_k0 = load8(ROWP(Kh, 0, sr)); st_k1 = load8(ROWP(Kh, 0, 32 + sr));
        asm volatile("s_waitcnt vmcnt(0)" ::: "memory");
        *(bf16x8*)(K_lds + kws) = st_k0; *(bf16x8*)(K_lds + kws + 32 * 256) = st_k1;
        __syncthreads();
        f32x16 p0, p1; float mn, al; bf16x8 pa0, pa1, pa2, pa3;
#define STEP1(t, BUF) do { \
            if ((t) + 1 < NT) { st_k0 = load8(ROWP(Kh, 64 * ((t) + 1), sr)); st_k1 = load8(ROWP(Kh, 64 * ((t) + 1), 32 + sr)); SBAR(); } \
            qkt<BUF, false, false>(p0, p1, K_lds, nullptr, r32, hi, qr, true); \
            mask_tile(p0, p1, vp - 64 * (t) - 4 * hi, 0x7fffffffu); \
            partialSM<CN>(p0, p1, m_reg, mn, al); finishSM(p0, p1, al, l_reg, pa0, pa1, pa2, pa3); \
            if ((t) + 1 < NT) { asm volatile("s_waitcnt vmcnt(0)" ::: "memory"); *(bf16x8*)(K_lds + (1 - BUF) * SHM_K + kws) = st_k0; *(bf16x8*)(K_lds + (1 - BUF) * SHM_K + kws + 32 * 256) = st_k1; } \
            __syncthreads(); } while (0)
        for (int t = 0; t < NT; t += 2) { STEP1(t, 0); if (t + 1 < NT) STEP1(t + 1, 1); }
#undef STEP1
    }
    const float rl = l_reg > 0.f ? 1.f / l_reg : 0.f;
    const float mL = -m_reg * C2;
    o[0] = f32x16{}; o[1] = f32x16{}; o[2] = f32x16{}; o[3] = f32x16{};
    {
        st_k0 = load8(ROWP(Kh, 0, sr)); st_k1 = load8(ROWP(Kh, 0, 32 + sr)); st_v0 = load8(ROWP(Vh, 0, sr)); st_v1 = load8(ROWP(Vh, 0, 32 + sr));
        asm volatile("s_waitcnt vmcnt(0)" ::: "memory");
        *(bf16x8*)(K_lds + kws) = st_k0; *(bf16x8*)(K_lds + kws + 32 * 256) = st_k1; *(bf16x8*)(V_lds + vst0) = st_v0; *(bf16x8*)(V_lds + vst1) = st_v1;
        __syncthreads();
        f32x16 p0, p1; bf16x8 pa0, pa1, pa2, pa3;
        unsigned* improw = imp + (32 * rh + r32) * IMP_STRIDE;
#define STEP2(t, BUF) do { \
            if ((t) + 1 < NT) { st_k0 = load8(ROWP(Kh, 64 * ((t) + 1), sr)); st_k1 = load8(ROWP(Kh, 64 * ((t) + 1), 32 + sr)); \
                                st_v0 = load8(ROWP(Vh, 64 * ((t) + 1), sr)); st_v1 = load8(ROWP(Vh, 64 * ((t) + 1), 32 + sr)); SBAR(); } \
            qkt<BUF, false, false>(p0, p1, K_lds, nullptr, r32, hi, qr, true); \
            mask_tile(p0, p1, vp - 64 * (t) - 4 * hi, 0x7fffffffu); \
            _Pragma("unroll") for (int r = 0; r < 16; ++r) { p0[r] = __builtin_amdgcn_exp2f(fmaf(p0[r], C2, mL)) * rl; p1[r] = __builtin_amdgcn_exp2f(fmaf(p1[r], C2, mL)) * rl; } \
            _Pragma("unroll") for (int G = 0; G < 4; ++G) { \
                const int j0 = 16 * (t) + 2 * G + hi; \
                const float s4 = (p0[4 * G] + p0[4 * G + 1]) + (p0[4 * G + 2] + p0[4 * G + 3]); \
                const float s4b = (p1[4 * G] + p1[4 * G + 1]) + (p1[4 * G + 2] + p1[4 * G + 3]); \
                atomicAdd(improw + j0, (unsigned)(s4 * 536870912.f)); atomicAdd(improw + j0 + 1, (unsigned)(p0[4 * G + 3] * 536870912.f)); \
                atomicAdd(improw + j0 + 8, (unsigned)(s4b * 536870912.f)); atomicAdd(improw + j0 + 9, (unsigned)(p1[4 * G + 3] * 536870912.f)); } \
            packP(p0, p1, pa0, pa1, pa2, pa3); SBAR(); \
            pv_tile<BUF, false>(o, vb0, pa0, pa1, pa2, pa3, true); \
            if ((t) + 1 < NT) { asm volatile("s_waitcnt vmcnt(0)" ::: "memory"); *(bf16x8*)(K_lds + (1 - BUF) * SHM_K + kws) = st_k0; *(bf16x8*)(K_lds + (1 - BUF) * SHM_K + kws + 32 * 256) = st_k1; \
                                *(bf16x8*)(V_lds + (1 - BUF) * SHM_V + vst0) = st_v0; *(bf16x8*)(V_lds + (1 - BUF) * SHM_V + vst1) = st_v1; } \
            __syncthreads(); } while (0)
        for (int t = 0; t < NT; t += 2) { STEP2(t, 0); if (t + 1 < NT) STEP2(t + 1, 1); }
#undef STEP2
    }
    }
#undef ROWP
    {
#pragma unroll
        for (int r = 0; r < 16; ++r) {
            const int orow = crow(r, hi); const int t = t0 + 32 * rh + orow; const size_t m = (size_t)b * S + t;
            const float g0 = T.GATE[m * 24 + head * 3 + 0], g2 = T.GATE[m * 24 + head * 3 + 2];
            const bf16* owp = T.OW + (((size_t)(b * 8 + head) * S + t) * 128); bf16* opp = T.OP + (((size_t)(b * 8 + head) * S + t) * 128);
#pragma unroll
            for (int d0 = 0; d0 < 4; ++d0) {
                const float v = o[d0][r]; const float vn = __shfl_xor(v, 1);
                if ((r32 & 1) == 0) { const unsigned w = *(const unsigned*)(owp + d0 * 32 + r32);
                    const float w0 = __uint_as_float(w << 16), w1 = __uint_as_float(w & 0xffff0000u);
                    *(unsigned*)(opp + d0 * 32 + r32) = cvtpk(g0 * v + g2 * w0, g0 * vn + g2 * w1); }
            }
        }
    }
    __threadfence_block();
    __syncthreads();
    for (int rept_ = 0; rept_ < NSA_REP_TOPK; ++rept_)
    for (int qi = 0; qi < 8; ++qi) {
        const int q = wid * 8 + qi;
        short* srow = sel + q * 16;
        if (c <= 15) { if (lane <= c) srow[lane] = (short)lane; if (lane == 0) cntp[q] = c + 1; }
        else {
            unsigned long long key[4];
#pragma unroll
            for (int i = 0; i < 4; ++i) { const int j = lane + 64 * i; const bool ok = (j >= 1) && (j <= c - 2);
                key[i] = ok ? (((unsigned long long)imp[q * IMP_STRIDE + j] << 8) | (unsigned long long)(255 - j)) | (1ull << 40) : 0ull; }
            unsigned long long thr = 0ull;
            for (int bit = 40; bit >= 0; --bit) {
                const unsigned long long cand = thr | (1ull << bit);
                int cntge = 0;
#pragma unroll
                for (int i = 0; i < 4; ++i) cntge += __popcll(__ballot(key[i] >= cand));
                if (cntge >= 13) thr = cand;
            }
            if (lane == 0) { srow[0] = 0; srow[1] = (short)(c - 1); srow[2] = (short)c; cntp[q] = 16; }
            int base = 3;
#pragma unroll
            for (int i = 0; i < 4; ++i) { const bool s_ = key[i] >= thr; const unsigned long long mk = __ballot(s_);
                const int pos = base + __popcll(mk & ((1ull << lane) - 1ull));
                if (s_ && pos < 16) srow[pos] = (short)(lane + 64 * i);
                base += __popcll(mk); }
        }
    }
    __syncthreads();
    for (int reps_ = 0; reps_ < NSA_REP_SLC; ++reps_)
    for (int qi = 0; qi < 8; ++qi) {
        const int q = wid + 8 * qi;
        const int cnt = __builtin_amdgcn_readfirstlane(cntp[q]);
        slc_row(T, b, g, t0 + q, sel + q * 16, cnt, lane);
    }
    __syncthreads();
}
}
#define LAS __attribute__((address_space(3)))
__device__ __forceinline__ unsigned f2bf(float f) { unsigned u = __builtin_bit_cast(unsigned, f); return (u + 0x7fffu + ((u >> 16) & 1u)) >> 16; }
__device__ __forceinline__ unsigned pk2(float lo, float hi) { unsigned r; asm volatile("v_cvt_pk_bf16_f32 %0, %1, %2" : "=v"(r) : "v"(lo), "v"(hi)); return r; }
__device__ __forceinline__ float bflo(unsigned w) { return __uint_as_float(w << 16); }
__device__ __forceinline__ float bfhi(unsigned w) { return __uint_as_float(w & 0xffff0000u); }
__device__ __forceinline__ float wave_sum(float v) {
#pragma unroll
    for (int o = 1; o < 64; o <<= 1) v += __shfl_xor(v, o);
    return v;
}
struct Ctx {
    float* out; unsigned char* ws; unsigned char* lds;
    int tid, lane, wave, vcu, G;
};
__device__ __forceinline__ void ctx_refresh(Ctx& C) { int t = threadIdx.x; asm volatile("" : "+v"(t)); C.tid = t; C.lane = t & 63; C.wave = __builtin_amdgcn_readfirstlane(t >> 6); }
#define WSP(T, off) ((T*)(C.ws + (off)))
#define ROWSQ(i) (WSP(float, SM_ROWSQ) + (size_t)(i) * MTOK)

enum { MAP_ID = 0, MAP_L0_WIN, MAP_UQ, MAP_L1_WIN };
__device__ __forceinline__ int wmap(int kind, int n) {
    if (kind == MAP_ID) return n;
    if (kind == MAP_L0_WIN) {
        if (n < 1024) { const int p = n & 127; return (n - p) + (p >> 1) + 64 * (p & 1); }
        if (n < 2560) { const int n2 = n - 1024, seg = n2 >> 7, p = n2 & 127; const int kv = (seg >> 1) & 1;
            return kv == 0 ? 1024 + seg * 128 + (p >> 1) + 64 * (p & 1) : 1024 + n2; }
        if (n < 3072) return 2584 + (n - 2560);
        if (n < 3328) return 3096 + (n - 3072);
        if (n < 3392) { const int p = n - 3328; return 3352 + (p >> 1) + 32 * (p & 1); }
        if (n < 3416) return 2560 + (n - 3392);
        return -1;
    }
    if (kind == MAP_UQ) {
        if (n < 1024) { const int h = n >> 7, d = n & 127; return h * 192 + d; }
        const int n2 = n - 1024, h = n2 >> 6, p = n2 & 63; return h * 192 + 128 + (p >> 1) + 32 * (p & 1);
    }
    { const int p = n & 127, base = n - p, qkv = (n >> 10) % 3; return qkv < 2 ? base + (p >> 1) + 64 * (p & 1) : n; }
}
__device__ __forceinline__ void transpose_item(const float* W, int Nsrc, const float* gain, bf16_t* WT, int Kdst, int row_off, int kind, int nblk, LAS float* scr, int item, int lane) {
    const int kb = item / nblk, nb = item % nblk, k0 = 64 * kb, n0 = 32 * nb;
    const int src = wmap(kind, n0 + (lane & 31));
    float wv[32];
    const float* wp = W + (size_t)(k0 + (lane >> 5)) * Nsrc + (src >= 0 ? src : 0);
#pragma unroll
    for (int i = 0; i < 32; ++i) wv[i] = wp[(size_t)(2 * i) * Nsrc];
    if (gain) {
#pragma unroll
        for (int i = 0; i < 32; ++i) wv[i] *= gain[k0 + 2 * i + (lane >> 5)]; }
#pragma unroll
    for (int i = 0; i < 32; ++i) { const int kk = 2 * i + (lane >> 5); scr[kk * 33 + (lane & 31)] = src >= 0 ? wv[i] : 0.f; }
    asm volatile("s_waitcnt lgkmcnt(0)" ::: "memory");
    const int c = lane & 7;
#pragma unroll
    for (int j = 0; j < 4; ++j) { const int n = (lane >> 3) + 8 * j; const LAS float* s = scr + (8 * c) * 33 + n;
        u32x4 o; o.x = pk2(s[0 * 33], s[1 * 33]); o.y = pk2(s[2 * 33], s[3 * 33]); o.z = pk2(s[4 * 33], s[5 * 33]); o.w = pk2(s[6 * 33], s[7 * 33]);
        *(u32x4*)(WT + (size_t)(row_off + n0 + n) * Kdst + k0 + 8 * c) = o; }
    asm volatile("s_waitcnt lgkmcnt(0)" ::: "memory");
}
struct Args { const float* in[27]; float* out; unsigned char* ws; int phase_hi; int pad; };
__device__ __forceinline__ void prologue(Ctx& C, const Args& args) {
    ctx_refresh(C);
    LAS float* scr = (LAS float*)(C.lds) + C.wave * 4096;
    const int gw = C.vcu * NWAVES + C.wave, NGW = C.G * NWAVES;
    int it = gw;
#define WJOB(in_idx, gain_idx, K, Nsrc, Ndst, Kdst, row_off, kind, dst) do { constexpr int nblk_ = (Ndst) / 32, nitems_ = ((K) / 64) * nblk_; \
        for (; it < nitems_; it += NGW) transpose_item(args.in[in_idx], Nsrc, (gain_idx) >= 0 ? args.in[(gain_idx) >= 0 ? (gain_idx) : 0] : nullptr, WSP(bf16_t, dst), Kdst, row_off, kind, nblk_, scr, it, C.lane); \
        it -= nitems_; } while (0)
    WJOB(2, 1, 2048, 3416, 3584, 2048, 0, MAP_L0_WIN, W_L0_WIN);
    WJOB(10, 9, 512, 1536, 1536, 512, 0, MAP_UQ, W_UQ);
    WJOB(12, 11, 256, 2048, 2048, 256, 0, MAP_ID, W_UKV);
    WJOB(4, -1, 4096, 128, 128, 4096, 0, MAP_ID, W_C1);
    WJOB(7, -1, 4096, 128, 128, 4096, 128, MAP_ID, W_C1);
    WJOB(13, -1, 2048, 2048, 2048, 2048, 0, MAP_ID, W_L0_WOUT);
    WJOB(16, 15, 2048, 8192, 8192, 2048, 0, MAP_ID, W_L0_FF1);
    WJOB(17, -1, 8192, 2048, 2048, 8192, 0, MAP_ID, W_L0_FF2);
    WJOB(20, 19, 2048, 9216, 9216, 2048, 0, MAP_L1_WIN, W_L1_WIN);
    WJOB(21, -1, 1024, 2048, 2048, 1024, 0, MAP_ID, W_L1_WOUT);
    WJOB(24, 23, 2048, 8192, 8192, 2048, 0, MAP_ID, W_L1_FF1);
    WJOB(25, -1, 8192, 2048, 2048, 8192, 0, MAP_ID, W_L1_FF2);
    WJOB(5, -1, 128, 128, 128, 256, 0, MAP_ID, W_C2);
    WJOB(8, -1, 128, 128, 128, 256, 128, MAP_ID, W_C2);
#undef WJOB
    for (int i = gw * 64 + C.lane; i < 256 * 16; i += NGW * 64) { const int n = i >> 4, c = i & 15; *(u32x4*)(WSP(bf16_t, W_C2) + (size_t)n * 256 + 128 + 8 * c) = (u32x4){0u, 0u, 0u, 0u}; }
    for (int i = gw * 64 + C.lane; i < 4096; i += NGW * 64) WSP(unsigned, SM_BAR)[i] = 0u;
    for (int i = gw * 64 + C.lane; i < SEQ * 64; i += NGW * 64) {
        const int t = i >> 6, j = i & 63;
        double inv = 1.0; { double cbase = 0.86596432336006535; for (int q = 0; q < j; ++q) inv *= cbase; }
        const float ang = (float)t * (float)inv;
        double r = (double)ang * 0.15915494309189535; r -= __builtin_rint(r);
        const float rf = (float)r;
        WSP(float, SM_ROPE_C)[i] = __builtin_amdgcn_cosf(rf); WSP(float, SM_ROPE_S)[i] = __builtin_amdgcn_sinf(rf);
    }
    for (int i = gw * 64 + C.lane; i < SEQ * 32; i += NGW * 64) {
        const int t = i >> 5, j = i & 31;
        double inv = 1.0; { double cbase = 0.74989420933245582; for (int q = 0; q < j; ++q) inv *= cbase; }
        const float ang = (float)t * (float)inv;
        double r = (double)ang * 0.15915494309189535; r -= __builtin_rint(r);
        const float rf = (float)r;
        WSP(float, SM_ROPE2_C)[i] = __builtin_amdgcn_cosf(rf); WSP(float, SM_ROPE2_S)[i] = __builtin_amdgcn_sinf(rf);
    }
    for (int i = RS_CQ * MTOK + gw * 64 + C.lane; i < RS_N * MTOK; i += NGW * 64) WSP(float, SM_ROWSQ)[i] = 0.f;
    if (gw < 256) {
        const float* pe = args.in[gw < 128 ? 3 : 6]; const float* w1 = args.in[gw < 128 ? 4 : 7]; const int c = gw & 127;
        float s = 0.f; for (int i = C.lane; i < 4096; i += 64) s += pe[i] * w1[(size_t)i * 128 + c];
        s = wave_sum(s); if (C.lane == 0) WSP(float, SM_CBIAS)[gw] = s;
    }
    for (int m = gw; m < MTOK; m += NGW) {
        const f32x4* xr = (const f32x4*)(args.in[0] + (size_t)m * DM) + C.lane; u32x2* o = (u32x2*)(WSP(bf16_t, A_HB) + (size_t)m * DM) + C.lane;
        float s = 0.f;
#pragma unroll
        for (int j = 0; j < 8; ++j) { const f32x4 v = xr[64 * j]; s += (v.x * v.x + v.y * v.y) + (v.z * v.z + v.w * v.w); o[64 * j] = (u32x2){pk2(v.x, v.y), pk2(v.z, v.w)}; }
        s = wave_sum(s); if (C.lane == 0) ROWSQ(RS_X)[m] = s;
    }
}

__device__ __forceinline__ void postnorm_phase(Ctx& C, const float* hold, const bf16_t* mm, const float* g, float* rsq_out, bool write_hb) {
    ctx_refresh(C);
    const int gw = C.vcu * NWAVES + C.wave, NGW = C.G * NWAVES;
    f32x4 gv[8];
#pragma unroll
    for (int j = 0; j < 8; ++j) gv[j] = ((const f32x4*)g)[C.lane + 64 * j];
    for (int m = gw; m < MTOK; m += NGW) {
        const f32x4* hr = (const f32x4*)(hold + (size_t)m * DM) + C.lane; const u32x2* mr = (const u32x2*)(mm + (size_t)m * DM) + C.lane;
        f32x4* orow = (f32x4*)(C.out + (size_t)m * DM) + C.lane; u32x2* hb = (u32x2*)(WSP(bf16_t, A_HB) + (size_t)m * DM) + C.lane;
        u32x2 w[8]; float q = 0.f;
#pragma unroll
        for (int j = 0; j < 8; ++j) { w[j] = mr[64 * j]; const float a = bflo(w[j].x), b = bfhi(w[j].x), c = bflo(w[j].y), d = bfhi(w[j].y); q += (a * a + b * b) + (c * c + d * d); }
        q = wave_sum(q);
        const float rstd = __builtin_amdgcn_rsqf(q * (1.f / DM) + EPS);
        float s = 0.f;
#pragma unroll
        for (int j = 0; j < 8; ++j) { const f32x4 h = hr[64 * j];
            f32x4 v; v.x = h.x + bflo(w[j].x) * rstd * gv[j].x; v.y = h.y + bfhi(w[j].x) * rstd * gv[j].y; v.z = h.z + bflo(w[j].y) * rstd * gv[j].z; v.w = h.w + bfhi(w[j].y) * rstd * gv[j].w;
            orow[64 * j] = v; s += (v.x * v.x + v.y * v.y) + (v.z * v.z + v.w * v.w);
            if (write_hb) hb[64 * j] = (u32x2){pk2(v.x, v.y), pk2(v.z, v.w)}; }
        if (write_hb) { s = wave_sum(s); if (C.lane == 0) rsq_out[m] = s; }
    }
}

__device__ __forceinline__ void vst_phase(Ctx& C) {
    ctx_refresh(C);
    const int gw = C.vcu * NWAVES + C.wave, NGW = C.G * NWAVES;
    const bf16_t* KS = WSP(bf16_t, A_KV + 2 * 16 * MiB); const bf16_t* VS = WSP(bf16_t, A_KV + 3 * 16 * MiB); bf16_t* KST = WSP(bf16_t, A_KST); bf16_t* VST = WSP(bf16_t, A_VST);
    const int col = C.lane & 15, q4 = C.lane >> 4;
    for (int it = gw; it < 4 * 256 * 16; it += NGW) {
        const int ch = it & 15, blk = (it >> 4) & 255, bg = it >> 12; const int kg = ch >> 2, ks = ch & 3;
        const u32x4 v = *(const u32x4*)(KS + ((size_t)bg * SEQ + 64 * blk + 16 * kg + col) * 128 + 32 * ks + 8 * q4);
        *(u32x4*)(KST + (((size_t)bg * 256 + blk) * 16 + ch) * 512 + C.lane * 8) = v;
    }
    for (int it = gw; it < 4 * 256 * 16; it += NGW) {
        const int ch = it & 15, blk = (it >> 4) & 255, bg = it >> 12; const int dg = ch >> 1, kp = ch & 1;
        const bf16_t* src = VS + ((size_t)bg * SEQ + 64 * blk) * 128 + 16 * dg + col;
        unsigned short e[8];
#pragma unroll
        for (int j = 0; j < 8; ++j) { const int key = 32 * kp + (j < 4 ? 4 * q4 + j : 16 + 4 * q4 + (j - 4)); e[j] = src[(size_t)key * 128]; }
        u32x4 o; o.x = e[0] | ((unsigned)e[1] << 16); o.y = e[2] | ((unsigned)e[3] << 16); o.z = e[4] | ((unsigned)e[5] << 16); o.w = e[6] | ((unsigned)e[7] << 16);
        *(u32x4*)(VST + (((size_t)bg * 256 + blk) * 16 + ch) * 512 + C.lane * 8) = o;
    }
}

__device__ __forceinline__ void dil_merge_phase(Ctx& C) {
    ctx_refresh(C);
    const int gw = C.vcu * NWAVES + C.wave, NGW = C.G * NWAVES;
    const float* LSE = WSP(float, SM_LSE);
    const bf16_t* OG[3] = {WSP(bf16_t, A_OG0), WSP(bf16_t, A_OG1), WSP(bf16_t, A_OG2)};
    bf16_t* O1 = WSP(bf16_t, A_O1);
    for (int it = gw; it < MTOK * 2; it += NGW) {
        const int m = it >> 1, half = it & 1; const int b = m / SEQ, t = m % SEQ;
        const int h = 4 * half + (C.lane >> 4), d0 = (C.lane & 15) * 8;
        float l[3]; size_t idx[3];
#pragma unroll
        for (int g = 0; g < 3; ++g) { const int sh = 2 * g, r = 1 << sh; const int tp = (t & (r - 1)) * (SEQ >> sh) + (t >> sh);
            idx[g] = (size_t)(b * 8 + h) * SEQ + tp; l[g] = LSE[(size_t)g * MTOK * 8 + idx[g]]; }
        const float mx = fmaxf(l[0], fmaxf(l[1], l[2]));
        float e0 = __expf(l[0] - mx), e1 = __expf(l[1] - mx), e2 = __expf(l[2] - mx); const float inv = 1.f / (e0 + e1 + e2);
        const float a[3] = {e0 * inv, e1 * inv, e2 * inv};
        float acc[8] = {0, 0, 0, 0, 0, 0, 0, 0};
#pragma unroll
        for (int g = 0; g < 3; ++g) { const u32x4 w = *(const u32x4*)(OG[g] + idx[g] * 128 + d0);
            acc[0] += a[g] * bflo(w.x); acc[1] += a[g] * bfhi(w.x); acc[2] += a[g] * bflo(w.y); acc[3] += a[g] * bfhi(w.y);
            acc[4] += a[g] * bflo(w.z); acc[5] += a[g] * bfhi(w.z); acc[6] += a[g] * bflo(w.w); acc[7] += a[g] * bfhi(w.w); }
        *(u32x4*)(O1 + (size_t)m * 1024 + h * 128 + d0) = (u32x4){pk2(acc[0], acc[1]), pk2(acc[2], acc[3]), pk2(acc[4], acc[5]), pk2(acc[6], acc[7])};
    }
}
typedef __attribute__((address_space(1))) unsigned gu32;
#define XB_TMO      128
#define XB_XCNT(j)  (256  + 64 * (j))
#define XB_XSUB(j)  (1280 + 64 * (j))
#define XB_XGEN(j)  (2304 + 64 * (j))
#define XB_TOP      3328
#define XB_TOPGEN   3392
#define XCD_BAR_WORDS 3456
#define XB_SPIN_CAP (1u << 18)

__device__ __forceinline__ unsigned xb_ld(unsigned* p)              { return __hip_atomic_load(p, __ATOMIC_RELAXED, __HIP_MEMORY_SCOPE_AGENT); }
__device__ __forceinline__ unsigned xb_add(unsigned* p, unsigned v) { return __hip_atomic_fetch_add(p, v, __ATOMIC_RELAXED, __HIP_MEMORY_SCOPE_AGENT); }
__device__ __forceinline__ unsigned xb_xcc_id() { return (unsigned)__builtin_amdgcn_s_getreg((3 << 11) | 20) & 0xFu; }
#define XB_SPIN(cond, bar) do { unsigned _sp = 0; while (cond) { __builtin_amdgcn_s_sleep(1); \
    if ((++_sp & 255u) == 0u) { if (xb_ld(&(bar)[XB_TMO])) break; if (_sp > XB_SPIN_CAP) { atomicAdd(&(bar)[XB_TMO], 1u); break; } } } } while (0)

struct XcdBarrier {
    unsigned* bar; unsigned x;
    volatile LAS unsigned* st;
};

__device__ __forceinline__ XcdBarrier xcd_barrier_post(unsigned* bar, volatile LAS unsigned* st) {
    XcdBarrier b; b.bar = bar; b.x = xb_xcc_id(); b.st = st;
    if (threadIdx.x == 0) (void)xb_add(&bar[XB_XCNT(b.x)], 1u);
    return b;
}
__device__ __forceinline__ void xcd_barrier_complete(unsigned* bar, unsigned x, unsigned& nloc, unsigned& nx) {
    const unsigned G = gridDim.x * gridDim.y * gridDim.z;
    unsigned sum, cnt, mine, sp = 0u;
    for (;;) {
        sum = 0u; cnt = 0u; mine = 0u;
#pragma unroll
        for (unsigned j = 0; j < 16; ++j) { const unsigned c = xb_ld(&bar[XB_XCNT(j)]); sum += c; cnt += (c > 0u) ? 1u : 0u; mine = (j == x) ? c : mine; }
        if (sum == G) break;
        __builtin_amdgcn_s_sleep(1);
        if ((++sp & 255u) == 0u) { if (xb_ld(&bar[XB_TMO])) break; if (sp > XB_SPIN_CAP) { atomicAdd(&bar[XB_TMO], 1u); break; } }
    }
    nloc = mine > 0u ? mine : 1u; nx = cnt > 0u ? cnt : 1u;
}

__device__ __forceinline__ void xcd_barrier(const XcdBarrier& b) {
    asm volatile("s_waitcnt vmcnt(0)" ::: "memory");
    __syncthreads();
    if (threadIdx.x == 0) {
        unsigned* bar = b.bar;
        __builtin_amdgcn_s_waitcnt(0);
        unsigned nloc = b.st[0], nx = b.st[1];
        if (nloc == 0u) { xcd_barrier_complete(bar, b.x, nloc, nx); b.st[0] = nloc; b.st[1] = nx; }
        const unsigned old = xb_add(&bar[XB_XSUB(b.x)], 1u);
        const unsigned gen = old / nloc;
        if (old + 1u == (gen + 1u) * nloc) {
            __builtin_amdgcn_fence(__ATOMIC_RELEASE, "agent");
            asm volatile("s_waitcnt vmcnt(0)" ::: "memory");
            const unsigned og = xb_add(&bar[XB_TOP], 1u);
            const unsigned tg = og / nx;
            if (og + 1u == (tg + 1u) * nx) xb_add(&bar[XB_TOPGEN], 1u);
            else XB_SPIN(xb_ld(&bar[XB_TOPGEN]) == tg, bar);
            __builtin_amdgcn_fence(__ATOMIC_ACQUIRE, "agent");
            xb_add(&bar[XB_XGEN(b.x)], 1u);
            asm volatile("s_waitcnt vmcnt(0)" ::: "memory");
        } else {
            XB_SPIN(xb_ld(&bar[XB_XGEN(b.x)]) == gen, bar);
            __builtin_amdgcn_fence(__ATOMIC_ACQUIRE, "agent");
            asm volatile("s_waitcnt vmcnt(0)" ::: "memory");
        }
    }
    __syncthreads();
}

typedef pg8::f32x4 accv;
#define EPI_FOR_ROWS _Pragma("unroll") for (int ai = 0; ai < 2; ++ai) _Pragma("unroll") for (int m = 0; m < 4; ++m)
#define EPI_ROW (u.pm * 256 + ai * 128 + wr * 64 + m * 16 + fr)
__device__ __forceinline__ void store8(bf16_t* p, accv a, accv b) { *(u32x4*)p = (u32x4){pk2(a[0], a[1]), pk2(a[2], a[3]), pk2(b[0], b[1]), pk2(b[2], b[3])}; }
__device__ __forceinline__ void rope_store(bf16_t* dst, int pc, int half, accv a, accv b, const float* ct, const float* st) {
    const int i0 = pc >> 1; const f32x4 c = *(const f32x4*)(ct + i0), s = *(const f32x4*)(st + i0);
    const float o1a = a[0] * c.x - a[1] * s.x, o2a = a[0] * s.x + a[1] * c.x;
    const float o1b = a[2] * c.y - a[3] * s.y, o2b = a[2] * s.y + a[3] * c.y;
    const float o1c = b[0] * c.z - b[1] * s.z, o2c = b[0] * s.z + b[1] * c.z;
    const float o1d = b[2] * c.w - b[3] * s.w, o2d = b[2] * s.w + b[3] * c.w;
    *(u32x2*)(dst + i0) = (u32x2){pk2(o1a, o1b), pk2(o1c, o1d)};
    *(u32x2*)(dst + half + i0) = (u32x2){pk2(o2a, o2b), pk2(o2c, o2d)};
}
__device__ __forceinline__ float sumsq8(accv a, accv b) { return (a[0] * a[0] + a[1] * a[1]) + (a[2] * a[2] + a[3] * a[3]) + (b[0] * b[0] + b[1] * b[1]) + (b[2] * b[2] + b[3] * b[3]); }
__device__ __forceinline__ void rowsq_add(unsigned long long* p, float s, int fq) { s += __shfl_xor(s, 16); s += __shfl_xor(s, 32); if (fq == 0) atomicAdd(p, (unsigned long long)(s * 1099511627776.f)); }
__device__ __forceinline__ float rowsq_fx(const unsigned long long* p) { return (float)(*p) * 9.094947017729282e-13f; }

struct EpiL0In {
    static constexpr bool PERM = true, AFTER_DRAIN = false;
    unsigned char* ws; const float* rsq_x;
    __device__ __forceinline__ void operator()(const accv (&acc)[2][2][4][2], const pg8::Unit& u, int wr, int wc, int fr, int fq) const {
        const int pn = u.pn, pc = wc * 32 + 8 * fq;
        EPI_FOR_ROWS { const int row = EPI_ROW; const float rstd = __builtin_amdgcn_rsqf(rsq_x[row] * (1.f / DM) + EPS);
            const int b = row / SEQ, t = row % SEQ; float ssq = 0.f;
#pragma unroll
            for (int bj = 0; bj < 2; ++bj) { const accv v0 = acc[ai][bj][m][0] * rstd, v1 = acc[ai][bj][m][1] * rstd;
                if (pn < 4) { const int head = 2 * pn + bj;
                    rope_store((bf16_t*)(ws + A_QN) + ((size_t)(b * 8 + head) * SEQ + t) * 128, pc, 64, v0, v1, (const float*)(ws + SM_ROPE_C) + t * 64, (const float*)(ws + SM_ROPE_S) + t * 64); }
                else if (pn < 10) { const int q = pn - 4, kv = q & 1;
                    bf16_t* dst = (bf16_t*)(ws + A_KV + (size_t)q * 16 * MiB) + ((size_t)(b * 2 + bj) * SEQ + t) * 128;
                    if (kv == 0) rope_store(dst, pc, 64, v0, v1, (const float*)(ws + SM_ROPE_C) + t * 64, (const float*)(ws + SM_ROPE_S) + t * 64);
                    else store8(dst + pc, v0, v1); }
                else if (pn < 12) { store8((bf16_t*)(ws + A_CQ) + (size_t)row * 512 + (pn - 10) * 256 + bj * 128 + pc, v0, v1); ssq += sumsq8(v0, v1); }
                else if (pn == 12) { store8((bf16_t*)(ws + A_CKV) + (size_t)row * 256 + bj * 128 + pc, v0, v1); ssq += sumsq8(v0, v1); }
                else if (bj == 0) {
                    if (pc < 64) rope_store((bf16_t*)(ws + A_KPE) + ((size_t)b * SEQ + t) * 64, pc, 32, v0, v1, (const float*)(ws + SM_ROPE2_C) + t * 32, (const float*)(ws + SM_ROPE2_S) + t * 32);
                    else if (pc < 88) { float* gp = (float*)(ws + SM_GATE) + (size_t)row * 24 + (pc - 64);
                        f32x4 g0, g1;
                        g0.x = 1.f / (1.f + __expf(-v0[0])); g0.y = 1.f / (1.f + __expf(-v0[1])); g0.z = 1.f / (1.f + __expf(-v0[2])); g0.w = 1.f / (1.f + __expf(-v0[3]));
                        g1.x = 1.f / (1.f + __expf(-v1[0])); g1.y = 1.f / (1.f + __expf(-v1[1])); g1.z = 1.f / (1.f + __expf(-v1[2])); g1.w = 1.f / (1.f + __expf(-v1[3]));
                        *(f32x4*)gp = g0; *(f32x4*)(gp + 4) = g1; }
                }
            }
            if (pn >= 10 && pn < 12) rowsq_add((unsigned long long*)((float*)(ws + SM_ROWSQ) + (size_t)RS_CQ * MTOK) + row, ssq, fq);
            if (pn == 12) rowsq_add((unsigned long long*)((float*)(ws + SM_ROWSQ) + (size_t)RS_CKV * MTOK) + row, ssq, fq);
        }
    }
};
struct EpiUQ {
    static constexpr bool PERM = true, AFTER_DRAIN = false;
    unsigned char* ws; bf16_t* MQ; const unsigned long long* rsq;
    __device__ __forceinline__ void operator()(const accv (&acc)[2][2][4][2], const pg8::Unit& u, int wr, int wc, int fr, int fq) const {
        const int pn = u.pn, pc = wc * 32 + 8 * fq;
        EPI_FOR_ROWS { const int row = EPI_ROW; const float rstd = __builtin_amdgcn_rsqf(rowsq_fx(rsq + row) * (1.f / 512.f) + EPS);
            const int b = row / SEQ, t = row % SEQ;
#pragma unroll
            for (int bj = 0; bj < 2; ++bj) { const accv v0 = acc[ai][bj][m][0] * rstd, v1 = acc[ai][bj][m][1] * rstd;
                if (pn < 4) { const int head = 2 * pn + bj; store8(MQ + ((size_t)(b * 8 + head) * SEQ + t) * 192 + pc, v0, v1); }
                else { const int head = 4 * (pn - 4) + 2 * bj + (pc >> 6);
                    rope_store(MQ + ((size_t)(b * 8 + head) * SEQ + t) * 192 + 128, pc & 63, 32, v0, v1, (const float*)(ws + SM_ROPE2_C) + t * 32, (const float*)(ws + SM_ROPE2_S) + t * 32); }
            }
        }
    }
};
struct EpiUKV {
    static constexpr bool PERM = true, AFTER_DRAIN = false;
    bf16_t* MK; bf16_t* MV; const unsigned long long* rsq;
    __device__ __forceinline__ void operator()(const accv (&acc)[2][2][4][2], const pg8::Unit& u, int wr, int wc, int fr, int fq) const {
        const int pc = wc * 32 + 8 * fq;
        EPI_FOR_ROWS { const int row = EPI_ROW; const float rstd = __builtin_amdgcn_rsqf(rowsq_fx(rsq + row) * (1.f / 256.f) + EPS);
            const int b = row / SEQ, t = row % SEQ; const size_t off = ((size_t)(b * 8 + u.pn) * SEQ + t) * 128 + pc;
            store8(MK + off, acc[ai][0][m][0] * rstd, acc[ai][0][m][1] * rstd);
            store8(MV + off, acc[ai][1][m][0] * rstd, acc[ai][1][m][1] * rstd);
        }
    }
};
__device__ __forceinline__ float gelu_tanh(float x) { const float u = 0.7978845608028654f * (x + 0.044715f * x * x * x); const float e = __expf(2.f * u); const float th = 1.f - 2.f / (e + 1.f); return 0.5f * x * (1.f + th); }
struct EpiC1 {
    static constexpr bool PERM = true, AFTER_DRAIN = false;
    bf16_t* HC; const float* cb;
    template <int SEL> __device__ __forceinline__ void body(const accv (&acc)[2][2][4][2], const pg8::Unit& u, int wr, int wc, int fr, int fq) const {
        const int pc = wc * 32 + 8 * fq;
        const f32x4 b0 = *(const f32x4*)(cb + SEL * 128 + pc), b1 = *(const f32x4*)(cb + SEL * 128 + pc + 4);
        EPI_FOR_ROWS { const int row = EPI_ROW;
            accv v0 = acc[ai][SEL][m][0], v1 = acc[ai][SEL][m][1];
            v0 += (accv){b0.x, b0.y, b0.z, b0.w}; v1 += (accv){b1.x, b1.y, b1.z, b1.w};
#pragma unroll
            for (int e = 0; e < 4; ++e) { v0[e] = gelu_tanh(v0[e]); v1[e] = gelu_tanh(v1[e]); }
            store8(HC + (size_t)row * 256 + pc, v0, v1);
            *(u32x4*)(HC + (size_t)row * 256 + 128 + pc) = (u32x4){0u, 0u, 0u, 0u};
            asm volatile("" ::: "memory");
        }
    }
    __device__ __forceinline__ void operator()(const accv (&acc)[2][2][4][2], const pg8::Unit& u, int wr, int wc, int fr, int fq) const {
        if (u.pm >= 16) body<1>(acc, u, wr, wc, fr, fq); else body<0>(acc, u, wr, wc, fr, fq);
    }
};
struct EpiC2 {
    static constexpr bool PERM = true, AFTER_DRAIN = false;
    bf16_t* KC; bf16_t* VC;
    template <int SEL> __device__ __forceinline__ void body(const accv (&acc)[2][2][4][2], const pg8::Unit& u, int wr, int wc, int fr, int fq) const {
        const int pc = wc * 32 + 8 * fq;
        EPI_FOR_ROWS { const int row = EPI_ROW;
            accv v0 = acc[ai][SEL][m][0], v1 = acc[ai][SEL][m][1];
            if ((row & 1023) == 1023) { v0 = (accv){0.f, 0.f, 0.f, 0.f}; v1 = v0; }
            bf16_t* dst = (SEL ? VC : KC) + (size_t)(row & 4095) * 128 + pc;
            store8(dst, v0, v1);
            asm volatile("" ::: "memory");
        }
    }
    __device__ __forceinline__ void operator()(const accv (&acc)[2][2][4][2], const pg8::Unit& u, int wr, int wc, int fr, int fq) const {
        if (u.pm >= 16) body<1>(acc, u, wr, wc, fr, fq); else body<0>(acc, u, wr, wc, fr, fq);
    }
};
template <int ACT> struct EpiOut {
    static constexpr bool PERM = true, AFTER_DRAIN = false;
    bf16_t* O; int ldc; float* rsq_out; const float* rsq_in;
    __device__ __forceinline__ void operator()(const accv (&acc)[2][2][4][2], const pg8::Unit& u, int wr, int wc, int fr, int fq) const {
        const int pc = wc * 32 + 8 * fq;
        EPI_FOR_ROWS { const int row = EPI_ROW;
            float rstd = 1.f; if (ACT == 1) rstd = __builtin_amdgcn_rsqf(rsq_in[row] * (1.f / DM) + EPS);
#pragma unroll
            for (int bj = 0; bj < 2; ++bj) { accv v0 = acc[ai][bj][m][0], v1 = acc[ai][bj][m][1];
                if (ACT == 1) {
#pragma unroll
                    for (int e = 0; e < 4; ++e) { float a = fmaxf(v0[e] * rstd, 0.f); v0[e] = a * a; float c = fmaxf(v1[e] * rstd, 0.f); v1[e] = c * c; } }
                store8(O + (size_t)row * ldc + u.pn * 256 + bj * 128 + pc, v0, v1); }
        }
    }
};
struct EpiL1In {
    static constexpr bool PERM = true, AFTER_DRAIN = false;
    unsigned char* ws; const float* rsq;
    __device__ __forceinline__ void operator()(const accv (&acc)[2][2][4][2], const pg8::Unit& u, int wr, int wc, int fr, int fq) const {
        const int pn = u.pn, pc = wc * 32 + 8 * fq; const int g = pn / 12, qkv = (pn % 12) >> 2, sh = 2 * g;
        EPI_FOR_ROWS { const int row = EPI_ROW; const float rstd = __builtin_amdgcn_rsqf(rsq[row] * (1.f / DM) + EPS);
            const int b = row / SEQ, t = row % SEQ; const int tp = (t & ((1 << sh) - 1)) * (SEQ >> sh) + (t >> sh);
#pragma unroll
            for (int bj = 0; bj < 2; ++bj) { const accv v0 = acc[ai][bj][m][0] * rstd, v1 = acc[ai][bj][m][1] * rstd;
                const int head = 2 * (pn & 3) + bj;
                bf16_t* dst = (bf16_t*)(ws + A_Z1 + (size_t)(g * 3 + qkv) * 64 * MiB) + ((size_t)(b * 8 + head) * SEQ + tp) * 128;
                if (qkv < 2) rope_store(dst, pc, 64, v0, v1, (const float*)(ws + SM_ROPE_C) + t * 64, (const float*)(ws + SM_ROPE_S) + t * 64);
                else store8(dst + pc, v0, v1); }
        }
    }
};

#ifndef REP_PRO
#define REP_PRO 1
#endif
#ifndef REP_G1
#define REP_G1 1
#endif
#ifndef REP_WIN
#define REP_WIN 1
#endif
#ifndef REP_MLA
#define REP_MLA 1
#endif
#ifndef REP_NSA
#define REP_NSA 1
#endif
#ifndef REP_DIL
#define REP_DIL 1
#endif
#ifndef REP_FF1
#define REP_FF1 1
#endif
#ifndef REP_FF2
#define REP_FF2 1
#endif
#ifndef ATT_BLOCK
#define ATT_BLOCK block_stag
#endif
#ifndef ONLY_G
#define ONLY_G -1
#endif
#ifndef MK_PHASE_HI
#define MK_PHASE_HI 99
#endif
#define CG_SYNC() do { __threadfence(); grid.sync(); __builtin_amdgcn_fence(__ATOMIC_ACQUIRE, "agent"); asm volatile("s_waitcnt vmcnt(0)" ::: "memory"); __syncthreads(); } while (0)
#ifdef USE_CG_SYNC
#define GRID_SYNC() CG_SYNC()
#else
#define GRID_SYNC() xcd_barrier(xbar)
#endif
template <class Epi> __device__ __forceinline__ void run_gemm(Ctx& C, const bf16_t* A, const bf16_t* Bt, int Mr, int N, int K, int lda, const Epi& E) {
    asm volatile("" : "+s"(K), "+s"(lda), "+s"(N), "+s"(Mr));
    pg8::Gemm g{A, Bt, Mr, N, K, lda}; pg8::StaticOrder S; S.init(Mr, N, C.G, (int)blockIdx.x);
    pg8::gemm_phase<Epi, pg8::StaticOrder, true, true>((LAS unsigned char*)C.lds, g, S, E);
}
using CfgW = fa::Cfg<128, 128, false, true, 128>;
using CfgM = fa::Cfg<192, 2048, true, false, 192>;

__global__ void __launch_bounds__(NTHREADS, 2) mega_fwd(Args args) {
    extern __shared__ __attribute__((aligned(16))) unsigned char lds[];
    cg::grid_group grid = cg::this_grid();
    Ctx C;
    C.out = args.out; C.ws = args.ws; C.lds = lds;
    ctx_refresh(C);
    C.G = gridDim.x; { const int bx = blockIdx.x; C.vcu = (C.G % 8 == 0) ? (bx % 8) * (C.G / 8) + bx / 8 : bx; }
    const int phase_hi = args.phase_hi;
    unsigned char* dout = (unsigned char*)args.out;
    using fa::bf16;

    if (threadIdx.x < 2) ((volatile LAS unsigned*)((LAS unsigned char*)lds + LDS_BAR_ST))[threadIdx.x] = 0u;
    for (int rep_ = 0; rep_ < REP_PRO; ++rep_) prologue(C, args);
    CG_SYNC();
    XcdBarrier xbar = xcd_barrier_post(WSP(unsigned, SM_BAR), (volatile LAS unsigned*)((LAS unsigned char*)lds + LDS_BAR_ST));
    for (int rep_ = 0; rep_ < REP_G1; ++rep_) { EpiL0In E{C.ws, ROWSQ(RS_X)}; if constexpr (ONLY_G < 0 || ONLY_G == 0) run_gemm(C, WSP(bf16_t, A_HB), WSP(bf16_t, W_L0_WIN), MTOK, 3584, 2048, 2048, E); }
    GRID_SYNC();
    { EpiC1 E{WSP(bf16_t, A_HC), WSP(float, SM_CBIAS)}; if constexpr (ONLY_G < 0 || ONLY_G == 1) run_gemm(C, WSP(bf16_t, A_KV), WSP(bf16_t, W_C1), 8192, 256, 4096, 2048, E); }
    { EpiUQ E{C.ws, (bf16_t*)(dout + DO_MQ), (const unsigned long long*)ROWSQ(RS_CQ)}; if constexpr (ONLY_G < 0 || ONLY_G == 2) run_gemm(C, WSP(bf16_t, A_CQ), WSP(bf16_t, W_UQ), MTOK, 1536, 512, 512, E); }
    { EpiUKV E{(bf16_t*)(dout + DO_MK), (bf16_t*)(dout + DO_MV), (const unsigned long long*)ROWSQ(RS_CKV)}; if constexpr (ONLY_G < 0 || ONLY_G == 3) run_gemm(C, WSP(bf16_t, A_CKV), WSP(bf16_t, W_UKV), MTOK, 2048, 256, 256, E); }
    vst_phase(C);
#ifndef NO_WIN
    for (int rep_ = 0; rep_ < REP_WIN; ++rep_) {
        const bf16* QN = WSP(bf16, A_QN); const bf16* KW = WSP(bf16, A_KV + 4 * 16 * MiB); const bf16* VW = WSP(bf16, A_KV + 5 * 16 * MiB); bf16* OW = WSP(bf16, A_OW);
        for (int L = C.vcu * 4; L < C.vcu * 4 + 4 && L < 1024; ++L) {
            const int bh = L >> 6, qb = L & 63, b = bh >> 3, h = bh & 7;
            fa::BlockRef r; r.Q = QN + ((size_t)bh * SEQ + qb * 256) * 128; r.K = KW + (size_t)(b * 2 + (h >> 2)) * SEQ * 128; r.V = VW + (size_t)(b * 2 + (h >> 2)) * SEQ * 128;
            r.KP = nullptr; r.O = OW + ((size_t)bh * SEQ + qb * 256) * 128; r.L = nullptr; r.P0 = qb * 256;
            fa::ATT_BLOCK<CfgW>(r, SEQ, 512, (char*)lds);
        }
    }
#endif
    GRID_SYNC();
    { EpiC2 E{WSP(bf16_t, A_KCMP), WSP(bf16_t, A_VCMP)}; if constexpr (ONLY_G < 0 || ONLY_G == 4) run_gemm(C, WSP(bf16_t, A_HC), WSP(bf16_t, W_C2), 8192, 256, 256, 256, E); }
#ifndef NO_MLA
    for (int rep_ = 0; rep_ < REP_MLA; ++rep_) {
        const bf16* MQ = (const bf16*)(dout + DO_MQ); const bf16* MK = (const bf16*)(dout + DO_MK); const bf16* MV = (const bf16*)(dout + DO_MV);
        const bf16* KPE = WSP(bf16, A_KPE); bf16* O = WSP(bf16, A_O);
        const int xcd = C.vcu >> 5, c = C.vcu & 31;
        if (xcd < 8) for (int hs = 0; hs < 2; ++hs) {
            const int bh = 2 * xcd + hs, b = bh >> 3, h = bh & 7;
            for (int pass = 0; pass < 2; ++pass) { const int qb = pass ? 63 - c : c;
                fa::BlockRef r; r.Q = MQ + ((size_t)bh * SEQ + qb * 256) * 192; r.K = MK + (size_t)bh * SEQ * 128; r.V = MV + (size_t)bh * SEQ * 128;
                r.KP = KPE + (size_t)b * SEQ * 64; r.O = O + ((size_t)b * SEQ + qb * 256) * 2048 + 1024 + h * 128; r.L = nullptr; r.P0 = qb * 256;
                fa::block_stag<CfgM>(r, SEQ, 1 << 30, (char*)lds, pass == 1);
            }
        }
    }
#endif
    GRID_SYNC();
#ifndef NO_NSA
    for (int rep_ = 0; rep_ < REP_NSA; ++rep_) {
        nsa::Tensors T; T.QN = WSP(bf16, A_QN); T.KC = WSP(bf16, A_KCMP); T.VC = WSP(bf16, A_VCMP); T.KST = WSP(bf16, A_KST); T.VST = WSP(bf16, A_VST);
        T.OW = WSP(bf16, A_OW); T.OP = WSP(bf16, A_OP); T.GATE = WSP(float, SM_GATE); T.O = WSP(bf16, A_O);
        const int bg = C.vcu >> 6, k = C.vcu & 63;
        if (bg < 4) {
            for (int i = 0; i < 4; ++i) { const int c = (i == 0) ? k : (i == 1) ? 127 - k : (i == 2) ? 128 + k : 255 - k;
                nsa::nsa_block(T, bg >> 1, bg & 1, c, (char*)lds); }
        }
    }
#endif
    GRID_SYNC();
    { EpiOut<0> E{WSP(bf16_t, A_MM), 2048, nullptr, nullptr}; if constexpr (ONLY_G < 0 || ONLY_G == 5) run_gemm(C, WSP(bf16_t, A_O), WSP(bf16_t, W_L0_WOUT), MTOK, 2048, 2048, 2048, E); }
    GRID_SYNC();
    postnorm_phase(C, args.in[0], WSP(bf16_t, A_MM), args.in[14], ROWSQ(RS_H1), true);
    GRID_SYNC();
    if (phase_hi <= 6) return;
    for (int rep_ = 0; rep_ < REP_FF1; ++rep_) { EpiOut<1> E{WSP(bf16_t, A_HID), 8192, nullptr, ROWSQ(RS_H1)}; if constexpr (ONLY_G < 0 || ONLY_G == 6) run_gemm(C, WSP(bf16_t, A_HB), WSP(bf16_t, W_L0_FF1), MTOK, 8192, 2048, 2048, E); }
    GRID_SYNC();
    for (int rep_ = 0; rep_ < REP_FF2; ++rep_) { EpiOut<0> E{WSP(bf16_t, A_F), 2048, nullptr, nullptr}; if constexpr (ONLY_G < 0 || ONLY_G == 7) run_gemm(C, WSP(bf16_t, A_HID), WSP(bf16_t, W_L0_FF2), MTOK, 2048, 8192, 8192, E); }
    GRID_SYNC();
    postnorm_phase(C, C.out, WSP(bf16_t, A_F), args.in[18], ROWSQ(RS_H2), true);
    GRID_SYNC();
    if (phase_hi <= 9) return;
    { EpiL1In E{C.ws, ROWSQ(RS_H2)}; if constexpr (ONLY_G < 0 || ONLY_G == 8) run_gemm(C, WSP(bf16_t, A_HB), WSP(bf16_t, W_L1_WIN), MTOK, 9216, 2048, 2048, E); }
    GRID_SYNC();
#ifndef NO_DIL
    for (int rep_ = 0; rep_ < REP_DIL; ++rep_) {
        for (int g = 0; g < 3; ++g) {
            const int sh = 2 * g, slen = SEQ >> sh, nqb = slen >> 8;
            const bf16* Qg = WSP(bf16, A_Z1 + (size_t)(g * 3 + 0) * 64 * MiB); const bf16* Kg = WSP(bf16, A_Z1 + (size_t)(g * 3 + 1) * 64 * MiB); const bf16* Vg = WSP(bf16, A_Z1 + (size_t)(g * 3 + 2) * 64 * MiB);
            bf16* Og = (g == 0) ? WSP(bf16, A_OG0) : (g == 1) ? WSP(bf16, A_OG1) : WSP(bf16, A_OG2);
            float* Lg = WSP(float, SM_LSE) + (size_t)g * MTOK * 8;
            for (int L = C.vcu * 4; L < C.vcu * 4 + 4 && L < 1024; ++L) {
                const int bh = L >> 6, rest = L & 63, res = rest / nqb, qb = rest % nqb;
                const size_t seq0 = (size_t)bh * SEQ + (size_t)res * slen;
                fa::BlockRef r; r.Q = Qg + (seq0 + qb * 256) * 128; r.K = Kg + seq0 * 128; r.V = Vg + seq0 * 128; r.KP = nullptr;
                r.O = Og + (seq0 + qb * 256) * 128; r.L = Lg + seq0 + qb * 256; r.P0 = qb * 256;
                fa::ATT_BLOCK<CfgW>(r, slen, 129, (char*)lds);
            }
        }
    }
#endif
    GRID_SYNC();
    dil_merge_phase(C);
    GRID_SYNC();
    { EpiOut<0> E{WSP(bf16_t, A_MM1), 2048, nullptr, nullptr}; if constexpr (ONLY_G < 0 || ONLY_G == 9) run_gemm(C, WSP(bf16_t, A_O1), WSP(bf16_t, W_L1_WOUT), MTOK, 2048, 1024, 1024, E); }
    GRID_SYNC();
    postnorm_phase(C, C.out, WSP(bf16_t, A_MM1), args.in[22], ROWSQ(RS_H3), true);
    GRID_SYNC();
    if (phase_hi <= 14) return;
    { EpiOut<1> E{WSP(bf16_t, A_HID), 8192, nullptr, ROWSQ(RS_H3)}; if constexpr (ONLY_G < 0 || ONLY_G == 10) run_gemm(C, WSP(bf16_t, A_HB), WSP(bf16_t, W_L1_FF1), MTOK, 8192, 2048, 2048, E); }
    GRID_SYNC();
    { EpiOut<0> E{WSP(bf16_t, A_F), 2048, nullptr, nullptr}; if constexpr (ONLY_G < 0 || ONLY_G == 11) run_gemm(C, WSP(bf16_t, A_HID), WSP(bf16_t, W_L1_FF2), MTOK, 2048, 8192, 8192, E); }
    GRID_SYNC();
    postnorm_phase(C, C.out, WSP(bf16_t, A_F), args.in[26], nullptr, false);
}

extern "C" void kernel_launch(void* const* d_in, const int* in_sizes, int n_in, void* d_out, int out_size, void* d_ws, size_t ws_size, hipStream_t stream) {
    static int grid = 0;
    if (grid == 0) {
        if (n_in != 27 || out_size != MTOK * DM || ws_size < 1024 * MiB) { fprintf(stderr, "kernel_launch: unexpected shapes (n_in %d out %d ws %zu)\n", n_in, out_size, ws_size); grid = -1; return; }
        int dev = 0, cus = 0, per_cu = 0;
        if (hipGetDevice(&dev) != hipSuccess || hipDeviceGetAttribute(&cus, hipDeviceAttributeMultiprocessorCount, dev) != hipSuccess) { grid = -1; return; }
        if (hipFuncSetAttribute((const void*)mega_fwd, hipFuncAttributeMaxDynamicSharedMemorySize, LDS_BYTES) != hipSuccess) { fprintf(stderr, "kernel_launch: hipFuncSetAttribute failed\n"); grid = -1; return; }
        if (hipOccupancyMaxActiveBlocksPerMultiprocessor(&per_cu, (const void*)mega_fwd, NTHREADS, LDS_BYTES) != hipSuccess || per_cu < 1) { fprintf(stderr, "kernel_launch: occupancy query says %d\n", per_cu); (void)hipGetLastError(); grid = -1; return; }
        grid = cus;
        if (grid != 256) fprintf(stderr, "kernel_launch: note: %d CUs\n", grid);
    }
    if (grid < 0) return;
    Args a{};
    for (int i = 0; i < 27; ++i) a.in[i] = (const float*)d_in[i];
    a.out = (float*)d_out; a.ws = (unsigned char*)d_ws; a.phase_hi = MK_PHASE_HI; a.pad = 0;
    void* kargs[] = {&a};
    hipError_t e = hipLaunchCooperativeKernel((const void*)mega_fwd, dim3(grid), dim3(NTHREADS), kargs, LDS_BYTES, stream);
    if (e != hipSuccess) fprintf(stderr, "kernel_launch: cooperative launch failed: %s\n", hipGetErrorString(e));
}
```
